# Optimizing an MI355X kernel written in HIP

```python
import math
import jax, jax.numpy as jnp
from jax import lax
import numpy as np


D_MODEL = 2048
BATCH = 4
SEQ = 2048
DEPTH = 1
DEC_BATCH = 8
DEC_SEQ = 8
PAST_LEN = 16384
PAGE_SIZE = 128

MIX_WIDTH = D_MODEL
A_WIDTH = MIX_WIDTH // 2
B_WIDTH = MIX_WIDTH - A_WIDTH
A_QK_DIM = 64
A_V_DIM = 2 * A_QK_DIM
A_HEADS = A_WIDTH // A_V_DIM
B_K_DIM = 128
B_V_DIM = 128
B_HEADS = B_WIDTH // B_V_DIM
B_CONV_DIM = B_HEADS * (2 * B_K_DIM + B_V_DIM)
CONV_W = 4
CHUNK = 64
Q_BLOCK = 128
IN_WIDTH = 2 * A_HEADS * 2 * A_QK_DIM + A_WIDTH + B_CONV_DIM + B_WIDTH + 2 * B_HEADS
D_FF = ((8 * D_MODEL // 3 + 255) // 256) * 256
EPS = 1e-6

kernel_name = 'hymba_diffattn_gdn_macaron_step'


def rmsnorm(x, w):
    xf = x.astype(jnp.float32)
    y = xf * lax.rsqrt(jnp.mean(xf * xf, axis=-1, keepdims=True) + EPS)
    return (y * w.astype(jnp.float32)).astype(x.dtype)


def l2norm(x):
    return x * lax.rsqrt(jnp.sum(x * x, axis=-1, keepdims=True) + 1e-6)


def half_ffn(x, pre_w, post_w, w_gate, w_up, w_down):
    h = rmsnorm(x, pre_w)
    f = (jax.nn.silu(h @ w_gate) * (h @ w_up)) @ w_down
    return x + 0.5 * rmsnorm(f, post_w)


def alibi_slopes():
    return jnp.exp2(-8.0 * jnp.arange(1, A_HEADS + 1, dtype=jnp.float32) / A_HEADS)


def split_in(h):
    sizes = (A_HEADS * 2 * A_QK_DIM, A_HEADS * 2 * A_QK_DIM, A_WIDTH, B_CONV_DIM, B_WIDTH, B_HEADS, B_HEADS)
    offs = [int(o) for o in np.cumsum(sizes)[:-1]]
    return jnp.split(h, offs, axis=-1)


def diff_attn_block(q, k, v, q_pos, k_pos, lam, slopes):
    bsz, tq = q.shape[:2]
    tk = k.shape[1]
    qf = q.astype(jnp.float32).reshape(bsz, tq, A_HEADS, 2, A_QK_DIM)
    kf = k.astype(jnp.float32).reshape(bsz, tk, A_HEADS, 2, A_QK_DIM)
    s = jnp.einsum('bqhmd,bkhmd->bhmqk', qf, kf) * (A_QK_DIM ** -0.5)
    dist = (q_pos[:, None] - k_pos[None, :]).astype(jnp.float32)
    s = s - (slopes[:, None, None] * dist)[None, :, None]
    s = jnp.where(dist >= 0, s, -jnp.inf)
    p = jax.nn.softmax(s, axis=-1)
    pd = p[:, :, 0] - lam * p[:, :, 1]
    return jnp.einsum('bhqk,bkhd->bqhd', pd, v.astype(jnp.float32))


def diff_attn_prompt(q, k, v, lam, slopes):
    bsz, t = q.shape[:2]
    nb = t // Q_BLOCK
    qb = jnp.swapaxes(q.reshape(bsz, nb, Q_BLOCK, A_HEADS, 2 * A_QK_DIM), 0, 1)
    pos = jnp.arange(t, dtype=jnp.int32)
    pb = pos.reshape(nb, Q_BLOCK)
    ob = lax.map(lambda a: diff_attn_block(a[0], k, v, a[1], pos, lam, slopes), (qb, pb))
    return jnp.swapaxes(ob, 0, 1).reshape(bsz, t, A_HEADS, A_V_DIM)


def gated_delta_chunked(q, k, v, g, beta, s0):
    bsz, t, nh, _ = q.shape
    n = -(-t // CHUNK)
    pad = n * CHUNK - t

    def blocks(x):
        x = jnp.pad(x, [(0, 0), (0, pad)] + [(0, 0)] * (x.ndim - 2))
        x = x.reshape((bsz, n, CHUNK) + x.shape[2:])
        x = jnp.moveaxis(x, 3, 2)
        return jnp.moveaxis(x, 1, 0)

    qc, kc, vc, gc, bc = blocks(q), blocks(k), blocks(v), blocks(g), blocks(beta)
    G = jnp.cumsum(gc, axis=-1)
    idx = jnp.arange(CHUNK)
    causal = idx[:, None] >= idx[None, :]
    strict = idx[:, None] > idx[None, :]
    decay = jnp.exp(jnp.where(causal, G[..., :, None] - G[..., None, :], -jnp.inf))
    kbeta = kc * bc[..., None]
    L = jnp.where(strict, jnp.einsum('nbhid,nbhjd->nbhij', kbeta, kc) * decay, 0.0)
    eye = jnp.eye(CHUNK, dtype=jnp.float32)
    tinv = lax.linalg.triangular_solve(L + eye, jnp.broadcast_to(eye, L.shape), left_side=True,
                                       lower=True, unit_diagonal=True)
    u = tinv @ (vc * bc[..., None])
    w = tinv @ (kbeta * jnp.exp(G)[..., None])
    qk = jnp.einsum('nbhid,nbhjd->nbhij', qc, kc) * decay

    def step(S, xs):
        q_i, k_i, u_i, w_i, qk_i, G_i = xs
        v_new = u_i - w_i @ S
        o_i = (q_i * jnp.exp(G_i)[..., None]) @ S + qk_i @ v_new
        g_last = G_i[..., -1:]
        S = S * jnp.exp(g_last)[..., None] + jnp.einsum('bhck,bhcv->bhkv', k_i * jnp.exp(g_last - G_i)[..., None], v_new)
        return S, o_i

    S, o = lax.scan(step, s0, (qc, kc, u, w, qk, G))
    o = jnp.moveaxis(jnp.moveaxis(o, 0, 1), 2, 3).reshape(bsz, n * CHUNK, nh, -1)[:, :t]
    return o, S


def token_mix(x, attend, conv_buf, s0, pre_w, post_w, w_in, conv_w, a_log, dt_bias, delta_norm_w,
              subln_w, w_out, lam_init):
    bsz, t, _ = x.shape
    h = rmsnorm(x, pre_w) @ w_in
    qa, ka, va, qkv_b, z, b_raw, a_raw = split_in(h)
    ka = ka.reshape(bsz, t, A_HEADS, 2 * A_QK_DIM)
    va = va.reshape(bsz, t, A_HEADS, A_V_DIM)
    oa = attend(qa.reshape(bsz, t, A_HEADS, 2 * A_QK_DIM), ka, va)
    oa = (rmsnorm(oa, subln_w) * (1.0 - lam_init)).astype(x.dtype).reshape(bsz, t, A_WIDTH)
    xp = jnp.concatenate([conv_buf.astype(x.dtype), qkv_b], axis=1)
    conv = xp[:, 0:t] * conv_w[0]
    for j in range(1, CONV_W):
        conv = conv + xp[:, j:j + t] * conv_w[j]
    new_buf = xp[:, t:]
    act = jax.nn.silu(conv).astype(jnp.float32)
    qb, kb, vb = jnp.split(act, [B_HEADS * B_K_DIM, 2 * B_HEADS * B_K_DIM], axis=-1)
    qb = l2norm(qb.reshape(bsz, t, B_HEADS, B_K_DIM)) * (B_K_DIM ** -0.5)
    kb = l2norm(kb.reshape(bsz, t, B_HEADS, B_K_DIM))
    vb = vb.reshape(bsz, t, B_HEADS, B_V_DIM)
    beta = jax.nn.sigmoid(b_raw.astype(jnp.float32))
    g = -jnp.exp(a_log.astype(jnp.float32)) * jax.nn.softplus(a_raw.astype(jnp.float32) + dt_bias.astype(jnp.float32))
    ob, s_new = gated_delta_chunked(qb, kb, vb, g, beta, s0.astype(jnp.float32))
    ob = rmsnorm(ob, delta_norm_w) * jax.nn.silu(z.astype(jnp.float32).reshape(bsz, t, B_HEADS, B_V_DIM))
    ob = ob.astype(x.dtype).reshape(bsz, t, B_WIDTH)
    y = jnp.concatenate([oa, ob], axis=-1) @ w_out
    return x + rmsnorm(y, post_w), ka, va, s_new, new_buf


def setup_inputs(seed: int = 0) -> dict:
    key = jax.random.key(seed)
    ks = jax.random.split(key, 32)
    f32 = jnp.float32
    n_pages = PAST_LEN // PAGE_SIZE
    n_used = DEC_BATCH * n_pages
    n_pool = n_used + max(1, n_used // 4)
    perm = jax.random.permutation(ks[0], n_pool)
    page_table = perm[:n_used].reshape(DEC_BATCH, n_pages).astype(jnp.int32)

    def nrm(k, shape, scale):
        return jax.random.normal(k, shape, f32) * scale

    def gain(k, n):
        return 1.0 + 0.02 * jax.random.normal(k, (DEPTH, n), f32)

    dt = jnp.exp(jax.random.uniform(ks[1], (DEPTH, B_HEADS), f32, math.log(1e-3), math.log(1e-1)))
    return {
        'x_prompt': nrm(ks[2], (BATCH, SEQ, D_MODEL), 1.0),
        'x_sample': nrm(ks[3], (DEC_BATCH, DEC_SEQ, D_MODEL), 1.0),
        'cache_k': nrm(ks[4], (DEPTH, n_pool, PAGE_SIZE, A_HEADS, 2 * A_QK_DIM), 1.0),
        'cache_v': nrm(ks[5], (DEPTH, n_pool, PAGE_SIZE, A_HEADS, A_V_DIM), 1.0),
        'state_ssm': nrm(ks[6], (DEPTH, DEC_BATCH, B_HEADS, B_K_DIM, B_V_DIM), 0.1),
        'state_conv': nrm(ks[7], (DEPTH, DEC_BATCH, CONV_W - 1, B_CONV_DIM), 1.0),
        'page_table': page_table,
        'ffn1_pre_w': gain(ks[8], D_MODEL),
        'ffn1_post_w': gain(ks[9], D_MODEL),
        'ffn1_gate': nrm(ks[10], (DEPTH, D_MODEL, D_FF), D_MODEL ** -0.5),
        'ffn1_up': nrm(ks[11], (DEPTH, D_MODEL, D_FF), D_MODEL ** -0.5),
        'ffn1_down': nrm(ks[12], (DEPTH, D_FF, D_MODEL), D_FF ** -0.5),
        'mix_pre_w': gain(ks[13], D_MODEL),
        'mix_post_w': gain(ks[14], D_MODEL),
        'w_in': nrm(ks[15], (DEPTH, D_MODEL, IN_WIDTH), D_MODEL ** -0.5),
        'conv_w': nrm(ks[16], (DEPTH, CONV_W, B_CONV_DIM), CONV_W ** -0.5),
        'a_log': jnp.log(jax.random.uniform(ks[17], (DEPTH, B_HEADS), f32, 1.0, 16.0)),
        'dt_bias': dt + jnp.log(-jnp.expm1(-dt)),
        'delta_norm_w': gain(ks[18], B_V_DIM),
        'lambda_q1': nrm(ks[19], (DEPTH, A_QK_DIM), 0.1),
        'lambda_k1': nrm(ks[20], (DEPTH, A_QK_DIM), 0.1),
        'lambda_q2': nrm(ks[21], (DEPTH, A_QK_DIM), 0.1),
        'lambda_k2': nrm(ks[22], (DEPTH, A_QK_DIM), 0.1),
        'subln_w': gain(ks[23], A_V_DIM),
        'w_out': nrm(ks[24], (DEPTH, MIX_WIDTH, D_MODEL), MIX_WIDTH ** -0.5),
        'ffn2_pre_w': gain(ks[25], D_MODEL),
        'ffn2_post_w': gain(ks[26], D_MODEL),
        'ffn2_gate': nrm(ks[27], (DEPTH, D_MODEL, D_FF), D_MODEL ** -0.5),
        'ffn2_up': nrm(ks[28], (DEPTH, D_MODEL, D_FF), D_MODEL ** -0.5),
        'ffn2_down': nrm(ks[29], (DEPTH, D_FF, D_MODEL), D_FF ** -0.5),
    }


def reference(x_prompt, x_sample, cache_k, cache_v, state_ssm, state_conv, page_table,
              ffn1_pre_w, ffn1_post_w, ffn1_gate, ffn1_up, ffn1_down,
              mix_pre_w, mix_post_w, w_in, conv_w, a_log, dt_bias, delta_norm_w,
              lambda_q1, lambda_k1, lambda_q2, lambda_k2, subln_w, w_out,
              ffn2_pre_w, ffn2_post_w, ffn2_gate, ffn2_up, ffn2_down):
    f32 = jnp.float32
    slopes = alibi_slopes()
    dbsz, tn = x_sample.shape[:2]
    past = page_table.shape[1] * cache_k.shape[2]
    yp, ys = x_prompt, x_sample
    kp_l, vp_l, sp_l, cp_l, ks_l, vs_l, ss_l, cs_l = [], [], [], [], [], [], [], []
    for l in range(DEPTH):
        lam_init = 0.8 - 0.6 * math.exp(-0.3 * l)
        lam = (jnp.exp(jnp.sum(lambda_q1[l].astype(f32) * lambda_k1[l].astype(f32)))
               - jnp.exp(jnp.sum(lambda_q2[l].astype(f32) * lambda_k2[l].astype(f32))) + lam_init)
        ck, cv = cache_k[l], cache_v[l]

        yp = half_ffn(yp, ffn1_pre_w[l], ffn1_post_w[l], ffn1_gate[l], ffn1_up[l], ffn1_down[l])
        ys = half_ffn(ys, ffn1_pre_w[l], ffn1_post_w[l], ffn1_gate[l], ffn1_up[l], ffn1_down[l])

        def attend_prompt(q, k, v):
            return diff_attn_prompt(q, k, v, lam, slopes)

        zero_buf = jnp.zeros((yp.shape[0], CONV_W - 1, B_CONV_DIM), yp.dtype)
        zero_s = jnp.zeros((yp.shape[0], B_HEADS, B_K_DIM, B_V_DIM), f32)
        yp, kp, vp, sp, cp = token_mix(yp, attend_prompt, zero_buf, zero_s, mix_pre_w[l], mix_post_w[l],
                                       w_in[l], conv_w[l], a_log[l], dt_bias[l], delta_norm_w[l],
                                       subln_w[l], w_out[l], lam_init)

        def attend_sample(q, k, v):
            k_past = ck[page_table].reshape(dbsz, past, A_HEADS, 2 * A_QK_DIM)
            v_past = cv[page_table].reshape(dbsz, past, A_HEADS, A_V_DIM)
            k_all = jnp.concatenate([k_past.astype(k.dtype), k], axis=1)
            v_all = jnp.concatenate([v_past.astype(v.dtype), v], axis=1)
            q_pos = past + jnp.arange(tn, dtype=jnp.int32)
            k_pos = jnp.arange(past + tn, dtype=jnp.int32)
            return diff_attn_block(q, k_all, v_all, q_pos, k_pos, lam, slopes)

        ys, ksm, vsm, ssm, csm = token_mix(ys, attend_sample, state_conv[l], state_ssm[l], mix_pre_w[l],
                                           mix_post_w[l], w_in[l], conv_w[l], a_log[l], dt_bias[l],
                                           delta_norm_w[l], subln_w[l], w_out[l], lam_init)

        yp = half_ffn(yp, ffn2_pre_w[l], ffn2_post_w[l], ffn2_gate[l], ffn2_up[l], ffn2_down[l])
        ys = half_ffn(ys, ffn2_pre_w[l], ffn2_post_w[l], ffn2_gate[l], ffn2_up[l], ffn2_down[l])

        kp_l.append(kp)
        vp_l.append(vp)
        sp_l.append(sp.astype(state_ssm.dtype))
        cp_l.append(cp)
        ks_l.append(ksm)
        vs_l.append(vsm)
        ss_l.append(ssm.astype(state_ssm.dtype))
        cs_l.append(csm)

    return (yp, ys, jnp.stack(kp_l), jnp.stack(vp_l), jnp.stack(sp_l), jnp.stack(cp_l),
            jnp.stack(ks_l), jnp.stack(vs_l), jnp.stack(ss_l), jnp.stack(cs_l))
```

```cpp
#include <hip/hip_runtime.h>
#include <cstdio>
#include <cstdint>
namespace pg8 {
#define PG8_LAS __attribute__((address_space(3)))
typedef unsigned short bf16_t;
typedef short bf16x8 __attribute__((ext_vector_type(8)));
typedef float f32x4 __attribute__((ext_vector_type(4)));
typedef unsigned u32x4 __attribute__((ext_vector_type(4)));
constexpr int BM = 256, BK = 64, HALF = 128, HTB = HALF * BK * 2  , STAGE_BYTES = 8 * HTB, NXCD = 8, WGM = 8;

__host__ __device__ __forceinline__ int lds_byte(int r, int c) { const int st = (r >> 4) * 2 + (c >> 5), rr = r & 15, cc = c & 31, ob = rr * 64 + cc * 2; return st * 1024 + (ob ^ (((ob >> 9) & 1) << 5)); }
__host__ __device__ __forceinline__ void stage_rc(int b, int& R, int& C) { const int st = b / 1024, sb = b % 1024, swz = sb ^ (((sb >> 9) & 1) << 5); R = (st >> 1) * 16 + swz / 64; C = (st & 1) * 32 + (swz % 64) / 2; }
__host__ __device__ __forceinline__ int perm32(int rho) { const int n = rho >> 4, i = rho & 15; return 8 * (i >> 2) + 4 * n + (i & 3); }

struct Unit { int pm, pn; };
struct Gemm { const bf16_t* A; const bf16_t* Bt; int M, N, K; };

struct StaticOrder {
    int nM, nN, nwg, G, c;
    __host__ __device__ void init(int M, int N, int G_, int c_) { nM = M / BM; nN = N / BM; nwg = nM * nN; G = G_; c = c_; }
    __host__ __device__ bool next(int i, Unit& u) const {
        const long L = (long)i * G + c; if (L >= nwg) return false;
        int wgid = (int)L; { const int q = nwg / NXCD, r = nwg % NXCD, xcd = wgid % NXCD, off = wgid / NXCD; wgid = (xcd < r ? xcd * (q + 1) : r * (q + 1) + (xcd - r) * q) + off; }
        const int nig = WGM * nN, gid = wgid / nig, fm = gid * WGM, gsz = (nM - fm) < WGM ? (nM - fm) : WGM;
        u.pm = fm + ((wgid % nig) % gsz); u.pn = (wgid % nig) / gsz; return true;
    }
    __device__ __forceinline__ void a_ready(const Unit&) const {}
    __device__ __forceinline__ void done(const Unit&) const {}
};

__device__ __forceinline__ unsigned cvt_pk_bf16(float lo, float hi) { unsigned r; asm volatile("v_cvt_pk_bf16_f32 %0, %1, %2" : "=v"(r) : "v"(lo), "v"(hi)); return r; }
typedef float f32x2 __attribute__((ext_vector_type(2)));
__device__ __forceinline__ f32x2 gelu_pk(f32x2 v) {
    const f32x2 av = __builtin_elementwise_abs(v), d = av * 0.2316418882f + 1.0f;
    f32x2 t; t.x = __builtin_amdgcn_rcpf(d.x); t.y = __builtin_amdgcn_rcpf(d.y);
    f32x2 q = t * 0.5307027145f + (-0.7265760135f); q = q * t + 0.7107068705f; q = q * t + (-0.142248368f); q = q * t + 0.127414796f; q = q * t;
    const f32x2 s = (v * v) * (-0.72134752044f);
    f32x2 e; e.x = __builtin_amdgcn_exp2f(s.x); e.y = __builtin_amdgcn_exp2f(s.y);
    const f32x2 m = v * (q * e), r = v - m;
    f32x2 o; o.x = v.x < 0.f ? m.x : r.x; o.y = v.y < 0.f ? m.y : r.y; return o;
}

template <int ACT  > struct EpiBf16 {
    static constexpr bool PERM = true, AFTER_DRAIN = false; static_assert(ACT == 0 || ACT == 1, "EpiBf16: ACT is 0 (none) or 1 (gelu_pk)");
    bf16_t* O; int ldc; const float* bias; int split_cols; size_t split_stride; float scale0;
    __device__ __forceinline__ void operator()(const f32x4 (&acc)[2][2][4][2], const Unit& u, int wr, int wc, int fr, int fq) const {
        const int row0 = u.pm * BM + wr * 64 + fr; int colt = u.pn * BM; bf16_t* base = O;
        float sc = 1.f; if (split_cols) { const int t = colt / split_cols; base += (size_t)t * split_stride; colt -= t * split_cols; if (t == 0) sc = scale0; }
        const int col0 = colt + wc * 32 + 8 * fq, bcol0 = u.pn * BM + wc * 32 + 8 * fq;
        f32x4 bv[2][2];
#pragma unroll
        for (int bj = 0; bj < 2; ++bj)
#pragma unroll
            for (int n = 0; n < 2; ++n) bv[bj][n] = bias ? *(const f32x4*)(bias + bcol0 + bj * HALF + 4 * n) : (f32x4){0.f, 0.f, 0.f, 0.f};
#pragma unroll
        for (int ai = 0; ai < 2; ++ai)
#pragma unroll
            for (int m = 0; m < 4; ++m) { bf16_t* rowp = base + (size_t)(row0 + ai * HALF + m * 16) * ldc + col0;
#pragma unroll
                for (int bj = 0; bj < 2; ++bj) { f32x4 v0 = acc[ai][bj][m][0] + bv[bj][0], v1 = acc[ai][bj][m][1] + bv[bj][1];
                    if (ACT == 1) { f32x2 a = gelu_pk((f32x2){v0[0], v0[1]}), b = gelu_pk((f32x2){v0[2], v0[3]}), c = gelu_pk((f32x2){v1[0], v1[1]}), d = gelu_pk((f32x2){v1[2], v1[3]});
                        v0 = (f32x4){a.x, a.y, b.x, b.y}; v1 = (f32x4){c.x, c.y, d.x, d.y}; }
                    v0 = v0 * sc; v1 = v1 * sc; u32x4 w; w.x = cvt_pk_bf16(v0[0], v0[1]); w.y = cvt_pk_bf16(v0[2], v0[3]); w.z = cvt_pk_bf16(v1[0], v1[1]); w.w = cvt_pk_bf16(v1[2], v1[3]);
                    *(u32x4*)(rowp + bj * HALF) = w; } }
    }
};

struct PanelStats {
    unsigned* xbuf;
    unsigned* cnt;
    unsigned* tmo;
    int ntn; float eps;
    unsigned code;
    __device__ __forceinline__ bool run(const f32x4 (&v)[2][2][4][2], const Unit& u, int wr, int wc, int fr, int fq, PG8_LAS unsigned char* lds, int wid, int lane) const {
        typedef float f32x2v __attribute__((ext_vector_type(2)));
        PG8_LAS f32x2v* P = (PG8_LAS f32x2v*)lds;
        PG8_LAS f32x2v* S = (PG8_LAS f32x2v*)(lds + 8192);
        PG8_LAS unsigned* flag = (PG8_LAS unsigned*)(lds + 8192 + 2048);
#pragma unroll
        for (int ai = 0; ai < 2; ++ai)
#pragma unroll
            for (int m = 0; m < 4; ++m) {
                float s = 0.f;
#pragma unroll
                for (int bj = 0; bj < 2; ++bj)
#pragma unroll
                    for (int n = 0; n < 2; ++n) { const f32x4 x = v[ai][bj][m][n]; s += (x[0] + x[1]) + (x[2] + x[3]); }
                s += __shfl_xor(s, 16); s += __shfl_xor(s, 32);
                const float mw = s * (1.0f / 64.0f); float q = 0.f;
#pragma unroll
                for (int bj = 0; bj < 2; ++bj)
#pragma unroll
                    for (int n = 0; n < 2; ++n) { const f32x4 d = v[ai][bj][m][n] - mw; q += (d[0] * d[0] + d[1] * d[1]) + (d[2] * d[2] + d[3] * d[3]); }
                q += __shfl_xor(q, 16); q += __shfl_xor(q, 32);
                if (fq == 0) P[(ai * HALF + wr * 64 + m * 16 + fr) * 4 + wc] = (f32x2v){mw, q};
            }
        asm volatile("s_waitcnt lgkmcnt(0)" ::: "memory"); __builtin_amdgcn_s_barrier(); asm volatile("" ::: "memory");
#if defined(BROKEN_EXCHANGE_NO_WAIT)
#warning BROKEN CONTROL BUILD: the row-statistics exchange does not wait; results are wrong by design
        if (blockIdx.x >= 64) { const long long t0_ = clock64(); while (clock64() - t0_ < 60000) __builtin_amdgcn_s_sleep(8); }
#endif
        const int row = wid * 32 + (lane & 31);
        if (lane < 32) {
            const f32x2v a = P[row * 4 + 0], b = P[row * 4 + 1], c = P[row * 4 + 2], d = P[row * 4 + 3];
            const float mt = (a.x + b.x + c.x + d.x) * 0.25f;
            const float da = a.x - mt, db = b.x - mt, dc = c.x - mt, dd = d.x - mt;
            const float m2 = (a.y + b.y) + (c.y + d.y) + 64.0f * ((da * da + db * db) + (dc * dc + dd * dd));
            unsigned long long* slot = (unsigned long long*)xbuf + ((size_t)(u.pm * BM + row) * 4 + u.pn);
            __hip_atomic_store(slot, ((unsigned long long)__float_as_uint(m2) << 32) | __float_as_uint(mt), __ATOMIC_RELAXED, __HIP_MEMORY_SCOPE_AGENT);
        }
        asm volatile("s_waitcnt vmcnt(0)" ::: "memory");
        if (lane == 0) __hip_atomic_fetch_add(cnt + 64 * u.pm, 1u, __ATOMIC_RELAXED, __HIP_MEMORY_SCOPE_AGENT);
        if (wid == 0) {
            bool dead = false; const unsigned long long t0 = __builtin_amdgcn_s_memrealtime(); const unsigned want = 8u * (unsigned)ntn;
            for (;;) {
#if defined(BROKEN_EXCHANGE_NO_WAIT)
                break;
#endif
                if ((unsigned)__builtin_amdgcn_readfirstlane(__hip_atomic_load(cnt + 64 * u.pm, __ATOMIC_RELAXED, __HIP_MEMORY_SCOPE_AGENT)) >= want) break;
                if (__builtin_amdgcn_s_memrealtime() - t0 > 2000000ull) {
                    if (lane == 0) { unsigned expect = 0u; __hip_atomic_compare_exchange_strong(tmo + 1, &expect, code | (unsigned)(u.pm & 0xff), __ATOMIC_RELAXED, __ATOMIC_RELAXED, __HIP_MEMORY_SCOPE_AGENT);
                                     __hip_atomic_store(tmo, 1u, __ATOMIC_RELAXED, __HIP_MEMORY_SCOPE_AGENT); }
                    dead = true; break; }
                __builtin_amdgcn_s_sleep(2);
            }
            __builtin_amdgcn_fence(__ATOMIC_ACQUIRE, "agent");
            if (lane == 0) flag[0] = dead ? 1u : 0u;
        }
        asm volatile("s_waitcnt vmcnt(0) lgkmcnt(0)" ::: "memory"); __builtin_amdgcn_s_barrier(); asm volatile("" ::: "memory");
        const bool bad = flag[0] != 0u;
        if (lane < 32) {
            const unsigned long long* slot = (const unsigned long long*)xbuf + (size_t)(u.pm * BM + row) * 4; float mt[4], m2[4]; float ms = 0.f;
#pragma unroll
            for (int t = 0; t < 4; ++t) { if (t < ntn) { const unsigned long long w = __hip_atomic_load(slot + t, __ATOMIC_RELAXED, __HIP_MEMORY_SCOPE_AGENT); mt[t] = __uint_as_float((unsigned)w); m2[t] = __uint_as_float((unsigned)(w >> 32)); } else { mt[t] = 0.f; m2[t] = 0.f; } ms += mt[t]; }
            const float mean = ms / (float)ntn; float q = 0.f;
#pragma unroll
            for (int t = 0; t < 4; ++t) if (t < ntn) { const float dm = mt[t] - mean; q += m2[t] + 256.0f * dm * dm; }
            S[row] = (f32x2v){mean, 1.0f / sqrtf(q / (256.0f * (float)ntn) + eps)};
        }
        asm volatile("s_waitcnt lgkmcnt(0)" ::: "memory"); __builtin_amdgcn_s_barrier(); asm volatile("" ::: "memory");
        return bad;
    }
};
struct EpiLnRes {
    static constexpr bool PERM = false, AFTER_DRAIN = true;
    const float* base; float* out; int ldc; const float* bias; PanelStats st; unsigned poison;
    __device__ __forceinline__ void fused(f32x4 (&acc)[2][2][4][2], const Unit& u, int wr, int wc, int fr, int fq, PG8_LAS unsigned char* lds, int wid, int lane) const {
        typedef float f32x2v __attribute__((ext_vector_type(2)));
        const PG8_LAS f32x2v* S = (const PG8_LAS f32x2v*)(lds + 8192);
        const int col0 = u.pn * BM + wc * 32 + 4 * fq;
#pragma unroll
        for (int bj = 0; bj < 2; ++bj)
#pragma unroll
            for (int n = 0; n < 2; ++n) { const f32x4 bv = bias ? *(const f32x4*)(bias + col0 + bj * HALF + n * 16) : (f32x4){0.f, 0.f, 0.f, 0.f};
#pragma unroll
                for (int ai = 0; ai < 2; ++ai)
#pragma unroll
                    for (int m = 0; m < 4; ++m) acc[ai][bj][m][n] += bv; }
        f32x4 pre[4][2][2];
#pragma unroll
        for (int m = 0; m < 4; ++m) { const size_t off = (size_t)(u.pm * BM + wr * 64 + m * 16 + fr) * ldc + col0;
#pragma unroll
            for (int bj = 0; bj < 2; ++bj)
#pragma unroll
                for (int n = 0; n < 2; ++n) pre[m][bj][n] = *(const f32x4*)(base + off + bj * HALF + n * 16); }
        const bool bad = st.run(acc, u, wr, wc, fr, fq, lds, wid, lane) || poison != 0u;
        const float qnan = __builtin_nanf("");
#pragma unroll
        for (int ai = 0; ai < 2; ++ai)
#pragma unroll
            for (int m = 0; m < 4; ++m) { const int r = ai * HALF + wr * 64 + m * 16 + fr; const f32x2v sr = S[r]; const size_t off = (size_t)(u.pm * BM + r) * ldc + col0;
#pragma unroll
                for (int bj = 0; bj < 2; ++bj)
#pragma unroll
                    for (int n = 0; n < 2; ++n) { const f32x4 bs = ai == 0 ? pre[m][bj][n] : *(const f32x4*)(base + off + bj * HALF + n * 16); f32x4 o = bs + (acc[ai][bj][m][n] - sr.x) * sr.y;
                        if (bad) o = (f32x4){qnan, qnan, qnan, qnan}; *(f32x4*)(out + off + bj * HALF + n * 16) = o; }
                if (m & 1) asm volatile("" ::: "memory"); }
    }
};
struct EpiLnResLn {
    static constexpr bool PERM = false, AFTER_DRAIN = true;
    const float* base; float* out; bf16_t* xn; int ldc; const float* bias; PanelStats st1, st2; unsigned poison;
    __device__ __forceinline__ void fused(f32x4 (&acc)[2][2][4][2], const Unit& u, int wr, int wc, int fr, int fq, PG8_LAS unsigned char* lds, int wid, int lane) const {
        typedef float f32x2v __attribute__((ext_vector_type(2))); typedef unsigned u32x2v __attribute__((ext_vector_type(2)));
        const PG8_LAS f32x2v* S = (const PG8_LAS f32x2v*)(lds + 8192);
        const int col0 = u.pn * BM + wc * 32 + 4 * fq;
#pragma unroll
        for (int bj = 0; bj < 2; ++bj)
#pragma unroll
            for (int n = 0; n < 2; ++n) { const f32x4 bv = bias ? *(const f32x4*)(bias + col0 + bj * HALF + n * 16) : (f32x4){0.f, 0.f, 0.f, 0.f};
#pragma unroll
                for (int ai = 0; ai < 2; ++ai)
#pragma unroll
                    for (int m = 0; m < 4; ++m) acc[ai][bj][m][n] += bv; }
        bool bad = st1.run(acc, u, wr, wc, fr, fq, lds, wid, lane) || poison != 0u;
        const float qnan = __builtin_nanf("");
#pragma unroll
        for (int ai = 0; ai < 2; ++ai)
#pragma unroll
            for (int m = 0; m < 4; ++m) { const int r = ai * HALF + wr * 64 + m * 16 + fr; const f32x2v sr = S[r]; const size_t off = (size_t)(u.pm * BM + r) * ldc + col0;
#pragma unroll
                for (int bj = 0; bj < 2; ++bj)
#pragma unroll
                    for (int n = 0; n < 2; ++n) { const f32x4 bs = *(const f32x4*)(base + off + bj * HALF + n * 16); acc[ai][bj][m][n] = bs + (acc[ai][bj][m][n] - sr.x) * sr.y; }
                asm volatile("" : "+v"(acc[ai][0][m][0]), "+v"(acc[ai][0][m][1]), "+v"(acc[ai][1][m][0]), "+v"(acc[ai][1][m][1]));
                if (m & 1) asm volatile("" ::: "memory"); }
        const bool bad1 = bad;
        bad = st2.run(acc, u, wr, wc, fr, fq, lds, wid, lane) || bad;
#pragma unroll
        for (int ai = 0; ai < 2; ++ai)
#pragma unroll
            for (int m = 0; m < 4; ++m) { const int r = ai * HALF + wr * 64 + m * 16 + fr; const f32x2v sr = S[r]; const size_t off = (size_t)(u.pm * BM + r) * ldc + col0;
#pragma unroll
                for (int bj = 0; bj < 2; ++bj)
#pragma unroll
                    for (int n = 0; n < 2; ++n) { const f32x4 x1 = acc[ai][bj][m][n]; *(f32x4*)(out + off + bj * HALF + n * 16) = bad1 ? (f32x4){qnan, qnan, qnan, qnan} : x1;
                        const f32x4 o = (x1 - sr.x) * sr.y; u32x2v w; w.x = cvt_pk_bf16(o[0], o[1]); w.y = cvt_pk_bf16(o[2], o[3]);
                        if (bad) { w.x = 0x7fc07fc0u; w.y = 0x7fc07fc0u; } *(u32x2v*)(xn + off + bj * HALF + n * 16) = w; }
                asm volatile("" ::: "memory"); }
    }
};

template <class Epi, class Sched, bool ALIGN_EPI = false, bool SP2 = false>
__device__ __forceinline__ void gemm_phase(PG8_LAS unsigned char* lds, const Gemm g, const Sched& S, const Epi& E) {
    const int tid = threadIdx.x, wid = __builtin_amdgcn_readfirstlane(tid >> 6), lane = tid & 63, wr = wid >> 2, wc = wid & 3, fr = lane & 15, fq = lane >> 4;
    const int K = g.K, nt = K / BK;
    unsigned voffA[2], voffB[2];
#pragma unroll
    for (int i = 0; i < 2; ++i) { int R, C; stage_rc(tid * 16 + i * 8192, R, C); const int Rb = Epi::PERM ? ((R & ~31) + perm32(R & 31)) : R;
        voffA[i] = (unsigned)(R * K + C) * 2u; voffB[i] = (unsigned)(Rb * K + C) * 2u; }
    const size_t kstep = (size_t)(BK * 2);
    const size_t hstep = (size_t)HALF * K * 2;
    const size_t tstep = 2 * hstep;
    const unsigned ldsw = (unsigned)wid * 1024u;
    const int aoff = lds_byte(wr * 64 + fr, fq * 8), boff = lds_byte(wc * 32 + fr, fq * 8);
#define PG8_SA(b, h) (((b) * 2 + (h)) * HTB)
#define PG8_SB(b, h) ((4 + (b) * 2 + (h)) * HTB)
#define PG8_STAGE(bufoff, gbase, voff) do { _Pragma("unroll") for (int _i = 0; _i < 2; ++_i) \
        __builtin_amdgcn_global_load_lds((const unsigned*)((const char*)(gbase) + (voff)[_i]), (PG8_LAS unsigned*)(lds + (bufoff) + ldsw + _i * 8192), 16, 0, 0); } while (0)
#define PG8_LDA(dst, b, h) do { _Pragma("unroll") for (int m = 0; m < 4; ++m) _Pragma("unroll") for (int k = 0; k < 2; ++k) dst[m][k] = *(const PG8_LAS bf16x8*)(lds + PG8_SA(b, h) + aoff + m * 2048 + k * 1024); } while (0)
#define PG8_LDB(dst, b, h) do { _Pragma("unroll") for (int n = 0; n < 2; ++n) _Pragma("unroll") for (int k = 0; k < 2; ++k) dst[n][k] = *(const PG8_LAS bf16x8*)(lds + PG8_SB(b, h) + boff + n * 2048 + k * 1024); } while (0)
#define PG8_MMA(ai, bj, At, Bt) do { __builtin_amdgcn_s_setprio(1); _Pragma("unroll") for (int m = 0; m < 4; ++m) _Pragma("unroll") for (int n = 0; n < 2; ++n) _Pragma("unroll") for (int k = 0; k < 2; ++k) \
        acc[ai][bj][m][n] = __builtin_amdgcn_mfma_f32_16x16x32_bf16(Bt[n][k], At[m][k], acc[ai][bj][m][n], 0, 0, 0); __builtin_amdgcn_s_setprio(0); } while (0)
#define PG8_WAIT_V(n) asm volatile("s_waitcnt vmcnt(" #n ")" ::: "memory")
#define PG8_WAIT_L(n) asm volatile("s_waitcnt lgkmcnt(" #n ")" ::: "memory")
#define PG8_BAR __builtin_amdgcn_s_barrier()
#define PG8_SCHED __builtin_amdgcn_sched_barrier(0)
    Unit cur, nxt; int ui = 0;
    if (!S.next(0, cur)) return;
    f32x4 acc[2][2][4][2];
#pragma unroll
    for (int a = 0; a < 2; ++a)
#pragma unroll
        for (int b = 0; b < 2; ++b)
#pragma unroll
            for (int m = 0; m < 4; ++m)
#pragma unroll
                for (int n = 0; n < 2; ++n) acc[a][b][m][n] = (f32x4){0.f, 0.f, 0.f, 0.f};
    bf16x8 At[4][2], B0[2][2], B1[2][2];
    const char* cA = (const char*)g.A + (size_t)cur.pm * tstep; const char* cB = (const char*)g.Bt + (size_t)cur.pn * tstep;
    S.a_ready(cur);
    if constexpr (SP2) {
        PG8_STAGE(PG8_SB(0, 0), cB, voffB); PG8_STAGE(PG8_SB(0, 1), cB + hstep, voffB); PG8_STAGE(PG8_SA(0, 0), cA, voffA); PG8_STAGE(PG8_SA(0, 1), cA + hstep, voffA);
        if (wr == 1) PG8_BAR;
        PG8_WAIT_V(2); PG8_BAR;
        PG8_STAGE(PG8_SB(1, 0), cB + kstep, voffB); PG8_STAGE(PG8_SA(1, 0), cA + kstep, voffA); PG8_STAGE(PG8_SB(1, 1), cB + hstep + kstep, voffB);
        PG8_WAIT_V(6); PG8_BAR;
    } else {
        PG8_STAGE(PG8_SB(0, 0), cB, voffB); PG8_STAGE(PG8_SA(0, 0), cA, voffA); PG8_STAGE(PG8_SB(0, 1), cB + hstep, voffB); PG8_STAGE(PG8_SA(0, 1), cA + hstep, voffA);
        if (wr == 1) PG8_BAR;
        PG8_WAIT_V(4); PG8_BAR;
        PG8_STAGE(PG8_SB(1, 0), cB + kstep, voffB); PG8_STAGE(PG8_SA(1, 0), cA + kstep, voffA); PG8_STAGE(PG8_SB(1, 1), cB + hstep + kstep, voffB);
        PG8_WAIT_V(6); PG8_BAR;
    }
    for (;;) {
        const bool has_next = S.next(ui + 1, nxt);
        const char* nA = has_next ? (const char*)g.A + (size_t)nxt.pm * tstep : cA; const char* nB = has_next ? (const char*)g.Bt + (size_t)nxt.pn * tstep : cB;
        for (int t = 0; t < nt; t += 2) {
            const bool last = (t == nt - 2);
            const char* a1 = cA + (size_t)(t + 1) * kstep;
            const char* a2 = last ? nA : cA + (size_t)(t + 2) * kstep; const char* b2 = last ? nB : cB + (size_t)(t + 2) * kstep;
            const char* a3 = a2 + kstep; const char* b3 = b2 + kstep;
            if (last && has_next) S.a_ready(nxt);
            if constexpr (SP2) {
            PG8_LDB(B0, 0, 0); PG8_LDB(B1, 0, 1); PG8_SCHED; PG8_LDA(At, 0, 0); PG8_STAGE(PG8_SA(1, 1), a1 + hstep, voffA);
            PG8_WAIT_V(8); PG8_WAIT_L(0); PG8_BAR; PG8_MMA(0, 0, At, B0); PG8_MMA(0, 1, At, B1); PG8_BAR; PG8_SCHED;
            PG8_LDA(At, 0, 1); PG8_STAGE(PG8_SB(0, 0), b2, voffB); PG8_STAGE(PG8_SB(0, 1), b2 + hstep, voffB); PG8_STAGE(PG8_SA(0, 0), a2, voffA);
            PG8_WAIT_V(8); PG8_WAIT_L(0); PG8_BAR; PG8_MMA(1, 0, At, B0); PG8_MMA(1, 1, At, B1); PG8_BAR; PG8_SCHED;
            PG8_LDB(B0, 1, 0); PG8_LDB(B1, 1, 1); PG8_SCHED; PG8_LDA(At, 1, 0); PG8_STAGE(PG8_SA(0, 1), a2 + hstep, voffA);
            PG8_WAIT_V(8); PG8_WAIT_L(0); PG8_BAR; PG8_MMA(0, 0, At, B0); PG8_MMA(0, 1, At, B1); PG8_BAR; PG8_SCHED;
            PG8_LDA(At, 1, 1); PG8_STAGE(PG8_SB(1, 0), b3, voffB); PG8_STAGE(PG8_SB(1, 1), b3 + hstep, voffB); PG8_STAGE(PG8_SA(1, 0), a3, voffA);
            PG8_WAIT_V(8); PG8_WAIT_L(0); PG8_BAR; PG8_MMA(1, 0, At, B0); PG8_MMA(1, 1, At, B1); PG8_BAR; PG8_SCHED;
            } else {
            PG8_LDB(B0, 0, 0); PG8_SCHED; PG8_LDA(At, 0, 0); PG8_STAGE(PG8_SA(1, 1), a1 + hstep, voffA);
            PG8_WAIT_L(8); PG8_BAR; PG8_WAIT_L(0); PG8_MMA(0, 0, At, B0); PG8_BAR; PG8_SCHED;
            PG8_LDB(B1, 0, 1); PG8_STAGE(PG8_SB(0, 0), b2, voffB);
            PG8_BAR; PG8_WAIT_L(0); PG8_MMA(0, 1, At, B1); PG8_BAR;
            PG8_LDA(At, 0, 1); PG8_STAGE(PG8_SA(0, 0), a2, voffA);
            PG8_BAR; PG8_WAIT_L(0); PG8_MMA(1, 0, At, B0); PG8_BAR; PG8_SCHED;
            PG8_STAGE(PG8_SB(0, 1), b2 + hstep, voffB);
            PG8_WAIT_V(6); PG8_BAR; PG8_MMA(1, 1, At, B1); PG8_BAR;
            PG8_LDB(B0, 1, 0); PG8_SCHED; PG8_LDA(At, 1, 0); PG8_STAGE(PG8_SA(0, 1), a2 + hstep, voffA);
            PG8_WAIT_L(8); PG8_BAR; PG8_WAIT_L(0); PG8_MMA(0, 0, At, B0); PG8_BAR; PG8_SCHED;
            PG8_LDB(B1, 1, 1); PG8_STAGE(PG8_SB(1, 0), b3, voffB);
            PG8_BAR; PG8_WAIT_L(0); PG8_MMA(0, 1, At, B1); PG8_BAR;
            PG8_LDA(At, 1, 1); PG8_STAGE(PG8_SA(1, 0), a3, voffA);
            PG8_BAR; PG8_WAIT_L(0); PG8_MMA(1, 0, At, B0); PG8_BAR; PG8_SCHED;
            PG8_STAGE(PG8_SB(1, 1), b3 + hstep, voffB);
            PG8_WAIT_V(6); PG8_BAR; PG8_MMA(1, 1, At, B1); PG8_BAR;
            }
        }
        if constexpr (ALIGN_EPI) { if (wr == 0) PG8_BAR; }
        if constexpr (!Epi::AFTER_DRAIN) { E(acc, cur, wr, wc, fr, fq); S.done(cur); }
        if (!has_next) break;
#pragma unroll
        for (int a = 0; a < 2; ++a)
#pragma unroll
            for (int b = 0; b < 2; ++b)
#pragma unroll
                for (int m = 0; m < 4; ++m)
#pragma unroll
                    for (int n = 0; n < 2; ++n) acc[a][b][m][n] = (f32x4){0.f, 0.f, 0.f, 0.f};
        cur = nxt; cA = nA; cB = nB; ++ui;
        if constexpr (ALIGN_EPI) { if (wr == 1) PG8_BAR; }
    }
    PG8_WAIT_V(0);
    if constexpr (!ALIGN_EPI) { if (wr == 0) PG8_BAR; }
    PG8_BAR;
    if constexpr (Epi::AFTER_DRAIN) { E.fused(acc, cur, wr, wc, fr, fq, lds, wid, lane); S.done(cur); }
#undef PG8_SA
#undef PG8_SB
#undef PG8_STAGE
#undef PG8_LDA
#undef PG8_LDB
#undef PG8_MMA
#undef PG8_WAIT_V
#undef PG8_WAIT_L
#undef PG8_BAR
#undef PG8_SCHED
}
}

#ifndef PG8_SP2
#define PG8_SP2 true
#endif
#ifndef PG8_ALIGN
#define PG8_ALIGN true
#endif
#define GAS __attribute__((address_space(1)))
#define LAS __attribute__((address_space(3)))
typedef unsigned short bf16;
typedef unsigned v4u __attribute__((ext_vector_type(4)));
typedef float f32x4 __attribute__((ext_vector_type(4)));
typedef short bf16x8 __attribute__((ext_vector_type(8)));
typedef GAS unsigned gu32;
typedef GAS unsigned long long gu64;
#define RLX_AGENT __ATOMIC_RELAXED, __HIP_MEMORY_SCOPE_AGENT
#define LDS_WAIT() asm volatile("s_waitcnt lgkmcnt(0)" ::: "memory")
#define VM_WAIT() asm volatile("s_waitcnt vmcnt(0)" ::: "memory")
__device__ __forceinline__ unsigned long long rt() { return __builtin_amdgcn_s_memrealtime(); }
__device__ __forceinline__ unsigned f2bf(float f) { unsigned u = __builtin_bit_cast(unsigned, f); return (u + 0x7fffu + ((u >> 16) & 1u)) >> 16; }
__device__ __forceinline__ unsigned pk2(float lo, float hi) { return f2bf(lo) | (f2bf(hi) << 16); }

#define XB_TMO      128
#define XB_XCNT(j)  (256  + 64 * (j))
#define XB_XSUB(j)  (1280 + 64 * (j))
#define XB_XGEN(j)  (2304 + 64 * (j))
#define XB_TOP      3328
#define XB_TOPGEN   3392
#define XCD_BAR_WORDS 3456
#define XB_SPIN_CAP (1u << 18)

__device__ __forceinline__ unsigned xb_ld(unsigned* p)              { return __hip_atomic_load(p, __ATOMIC_RELAXED, __HIP_MEMORY_SCOPE_AGENT); }
__device__ __forceinline__ unsigned xb_add(unsigned* p, unsigned v) { return __hip_atomic_fetch_add(p, v, __ATOMIC_RELAXED, __HIP_MEMORY_SCOPE_AGENT); }
__device__ __forceinline__ unsigned xb_xcc_id() { return (unsigned)__builtin_amdgcn_s_getreg((3 << 11) | 20) & 0xFu; }
#define XB_SPIN(cond, bar) do { unsigned _sp = 0; while (cond) { __builtin_amdgcn_s_sleep(1); \
    if ((++_sp & 255u) == 0u) { if (xb_ld(&(bar)[XB_TMO])) break; if (_sp > XB_SPIN_CAP) { atomicAdd(&(bar)[XB_TMO], 1u); break; } } } } while (0)

struct XcdBarrier {
    unsigned* bar; unsigned x;
    volatile LAS unsigned* st;
};

__device__ __forceinline__ XcdBarrier xcd_barrier_post(unsigned* bar, volatile LAS unsigned* st) {
    XcdBarrier b; b.bar = bar; b.x = xb_xcc_id(); b.st = st;
    if (threadIdx.x == 0) (void)xb_add(&bar[XB_XCNT(b.x)], 1u);
    return b;
}
__device__ __forceinline__ void xcd_barrier_complete(unsigned* bar, unsigned x, unsigned& nloc, unsigned& nx) {
    const unsigned G = gridDim.x * gridDim.y * gridDim.z;
    unsigned sum, cnt, mine, sp = 0u;
    for (;;) {
        sum = 0u; cnt = 0u; mine = 0u;
#pragma unroll
        for (unsigned j = 0; j < 16; ++j) { const unsigned c = xb_ld(&bar[XB_XCNT(j)]); sum += c; cnt += (c > 0u) ? 1u : 0u; mine = (j == x) ? c : mine; }
        if (sum == G) break;
        __builtin_amdgcn_s_sleep(1);
        if ((++sp & 255u) == 0u) { if (xb_ld(&bar[XB_TMO])) break; if (sp > XB_SPIN_CAP) { atomicAdd(&bar[XB_TMO], 1u); break; } }
    }
    nloc = mine > 0u ? mine : 1u; nx = cnt > 0u ? cnt : 1u;
}

__device__ __forceinline__ void xcd_barrier(const XcdBarrier& b) {
    asm volatile("s_waitcnt vmcnt(0)" ::: "memory");
    __syncthreads();
    if (threadIdx.x == 0) {
        unsigned* bar = b.bar;
        __builtin_amdgcn_s_waitcnt(0);
        unsigned nloc = b.st[0], nx = b.st[1];
        if (nloc == 0u) { xcd_barrier_complete(bar, b.x, nloc, nx); b.st[0] = nloc; b.st[1] = nx; }
        const unsigned old = xb_add(&bar[XB_XSUB(b.x)], 1u);
        const unsigned gen = old / nloc;
        if (old + 1u == (gen + 1u) * nloc) {
            __builtin_amdgcn_fence(__ATOMIC_RELEASE, "agent");
            asm volatile("s_waitcnt vmcnt(0)" ::: "memory");
            const unsigned og = xb_add(&bar[XB_TOP], 1u);
            const unsigned tg = og / nx;
            if (og + 1u == (tg + 1u) * nx) xb_add(&bar[XB_TOPGEN], 1u);
            else XB_SPIN(xb_ld(&bar[XB_TOPGEN]) == tg, bar);
            __builtin_amdgcn_fence(__ATOMIC_ACQUIRE, "agent");
            xb_add(&bar[XB_XGEN(b.x)], 1u);
            asm volatile("s_waitcnt vmcnt(0)" ::: "memory");
        } else {
            XB_SPIN(xb_ld(&bar[XB_XGEN(b.x)]) == gen, bar);
            __builtin_amdgcn_fence(__ATOMIC_ACQUIRE, "agent");
            asm volatile("s_waitcnt vmcnt(0)" ::: "memory");
        }
    }
    __syncthreads();
}
constexpr int DM = 2048, SEQ = 2048, NBP = 4, MP = NBP * SEQ, NBS = 8, TS = 8, MS = NBS * TS, M_ALL = MP + MS, M_PAD = 8448;
constexpr int PAST = 16384, PAGE = 128, NPAGES = PAST / PAGE;
constexpr int NH = 8, HD = 128;
constexpr int CONVD = 3072, INW = 7184, INW_PAD = 7424, FF = 5632, GU = 2 * FF;
constexpr int C_K = 1024, C_V = 2048, C_QKVB = 3072, C_Z = 6144, C_B = 7168, C_A = 7176;
constexpr float EPS = 1e-6f, LOG2E = 1.4426950408889634f, C2 = 0.125f * LOG2E;
constexpr int NWAVES = 8, NTHREADS = NWAVES * 64;
constexpr size_t OUT_Y = 0, OUT_KP = (size_t)M_ALL * DM, OUT_VP = OUT_KP + (size_t)MP * 1024, OUT_SSMP = OUT_VP + (size_t)MP * 1024,
                 OUT_CONVP = OUT_SSMP + (size_t)NBP * NH * 16384, OUT_KS = OUT_CONVP + (size_t)NBP * 3 * CONVD, OUT_VS = OUT_KS + (size_t)MS * 1024,
                 OUT_SSMS = OUT_VS + (size_t)MS * 1024, OUT_CONVS = OUT_SSMS + (size_t)NBS * NH * 16384, OUT_END = OUT_CONVS + (size_t)NBS * 3 * CONVD;
constexpr size_t MiB = 1u << 20;
constexpr size_t WS_CTL = 0, CTL_ZERO_BYTES = 1 * MiB;
constexpr size_t WS_W1GU = 16 * MiB, WS_W1D = 60 * MiB, WS_WIN = 82 * MiB, WS_WOUT = 111 * MiB, WS_W2GU = 119 * MiB, WS_W2D = 163 * MiB;
constexpr size_t WS_XN = 192 * MiB, WS_ACT = 226 * MiB, WS_F = 320 * MiB, WS_X1 = 388 * MiB, WS_X2 = 456 * MiB, WS_C1 = 528 * MiB, WS_H = 896 * MiB;
constexpr size_t WS_QB = 1136 * MiB, WS_KB = 1153 * MiB, WS_VB = 1170 * MiB;
constexpr size_t WS_QN = 1322 * MiB, WS_KN = 1355 * MiB, WS_VN = 1388 * MiB, WS_BETA = 1421 * MiB, WS_GG = 1422 * MiB, WS_OG = 1424 * MiB, WS_O1 = 1458 * MiB, WS_O2 = 1491 * MiB, WS_MIX = 1526 * MiB, WS_END = 1560 * MiB;
static_assert(WS_W1GU + (size_t)GU * DM * 2 <= WS_W1D && WS_W1D + (size_t)DM * FF * 2 <= WS_WIN && WS_WIN + (size_t)INW_PAD * DM * 2 <= WS_WOUT && WS_WOUT + (size_t)DM * DM * 2 <= WS_W2GU &&
              WS_W2GU + (size_t)GU * DM * 2 <= WS_W2D && WS_W2D + (size_t)DM * FF * 2 <= WS_XN && WS_XN + (size_t)M_PAD * DM * 2 <= WS_ACT && WS_ACT + (size_t)M_PAD * FF * 2 <= WS_F &&
              WS_F + (size_t)M_PAD * DM * 4 <= WS_X1 && WS_X1 + (size_t)M_ALL * DM * 4 <= WS_X2 && WS_X2 + (size_t)M_ALL * DM * 4 <= WS_C1 && WS_C1 + (size_t)M_PAD * GU * 4 <= WS_H &&
              WS_H + (size_t)M_PAD * INW_PAD * 4 <= WS_QB && WS_QB + (size_t)M_PAD * 1024 * 2 <= WS_KB && WS_VB + (size_t)M_PAD * 1024 * 2 <= WS_QN && WS_QN + (size_t)M_ALL * 1024 * 4 <= WS_KN &&
              WS_VN + (size_t)M_ALL * 1024 * 4 <= WS_BETA && WS_OG + (size_t)M_ALL * 1024 * 4 <= WS_O1 && WS_O1 + (size_t)M_ALL * 1024 * 4 <= WS_O2 && WS_O2 + (size_t)M_ALL * 1024 * 4 <= WS_MIX &&
              WS_MIX + (size_t)M_PAD * DM * 2 <= WS_END, "d_ws map");
constexpr int CW_QCTR = 64;
constexpr int CW_BAR = 4096;
constexpr int RING_OFF = 0, RING_BYTES = 131072, LDSCTL_OFF = RING_BYTES, MISC_OFF = LDSCTL_OFF + 320, LDS_BYTES = 147456;

#ifndef MK_N_LAUNCHES
#define MK_N_LAUNCHES 15
#endif
constexpr int NPHASE = 15;

struct Frame {
    LAS unsigned char* lds; volatile LAS unsigned* MISC; gu32* ctl;
    int tid, lane, wave, G, gw, NGW;
    const float *xp, *xs, *cache_k, *cache_v, *state_ssm, *state_conv; const int* page_table;
    const float *ffn1_pre, *ffn1_post, *gate1, *up1, *down1, *mix_pre, *mix_post, *w_in, *conv_w, *a_log, *dt_bias, *dnorm_w, *lq1, *lk1, *lq2, *lk2, *subln_w, *w_out, *ffn2_pre, *ffn2_post, *gate2, *up2, *down2;
    float* out;
    bf16 *W1GU, *W1D, *WIN, *WOUT, *W2GU, *W2D, *XN, *ACT, *QB, *KB, *VB, *MIX;
    float *Fb, *X1, *X2, *C1, *H, *QN, *KN, *VN, *BETA, *GG, *OG, *O1, *O2;
};

__device__ __forceinline__ float wave_sum(float v) {
#pragma unroll
    for (int o = 1; o < 64; o <<= 1) v += __shfl_xor(v, o);
    return v;
}
__device__ __forceinline__ float wave_max(float v) {
#pragma unroll
    for (int o = 1; o < 64; o <<= 1) v = fmaxf(v, __shfl_xor(v, o));
    return v;
}
__device__ __forceinline__ float bf2f(unsigned short b) { return __uint_as_float(((unsigned)b) << 16); }
__device__ __forceinline__ float silu_f(float x) { return x / (1.f + __expf(-x)); }
__device__ __forceinline__ float sigmoid_f(float x) { return 1.f / (1.f + __expf(-x)); }
__device__ __forceinline__ float softplus_f(float x) { return x > 20.f ? x : log1pf(__expf(x)); }

struct EpiF32 {
    static constexpr bool PERM = false, AFTER_DRAIN = false;
    float* C; int ldc;
    __device__ __forceinline__ void operator()(const pg8::f32x4 (&acc)[2][2][4][2], const pg8::Unit& u, int wr, int wc, int fr, int fq) const {
        const int col0 = u.pn * pg8::BM + wc * 32 + 4 * fq;
#pragma unroll
        for (int ai = 0; ai < 2; ++ai)
#pragma unroll
            for (int m = 0; m < 4; ++m) {
                const int r = u.pm * pg8::BM + ai * pg8::HALF + wr * 64 + m * 16 + fr;
                float* rowp = C + (size_t)r * ldc + col0;
#pragma unroll
                for (int bj = 0; bj < 2; ++bj)
#pragma unroll
                    for (int n = 0; n < 2; ++n) *(pg8::f32x4*)(rowp + bj * pg8::HALF + n * 16) = acc[ai][bj][m][n];
            }
    }
};

__device__ __forceinline__ void transpose_item(const float* W, int N, int k0, int n0, bf16* WT, int K, int drow0, LAS float* scr, int lane) {
    const int cc = n0 + (lane & 31);
#pragma unroll 8
    for (int i = 0; i < 32; ++i) { const int kk = 2 * i + (lane >> 5); scr[kk * 33 + (lane & 31)] = (cc < N) ? W[(size_t)(k0 + kk) * N + cc] : 0.f; }
    LDS_WAIT(); asm volatile("" ::: "memory");
    const int c = lane & 7;
#pragma unroll
    for (int j = 0; j < 4; ++j) { const int n = (lane >> 3) + 8 * j; const LAS float* s = scr + (8 * c) * 33 + n;
        v4u o; o.x = pk2(s[0 * 33], s[1 * 33]); o.y = pk2(s[2 * 33], s[3 * 33]); o.z = pk2(s[4 * 33], s[5 * 33]); o.w = pk2(s[6 * 33], s[7 * 33]);
        *(GAS v4u*)(WT + (size_t)(drow0 + n) * K + k0 + 8 * c) = o; }
    LDS_WAIT(); asm volatile("" ::: "memory");
}
__device__ __forceinline__ void tr_gu(const float* W, bf16* WT, int half, int r, LAS float* scr, int lane) {
    constexpr int nblk = FF / 32; const int kb = r / nblk, nb = r % nblk, n0 = 32 * nb;
    transpose_item(W, FF, 64 * kb, n0, WT, DM, 256 * (n0 >> 7) + 128 * half + (n0 & 127), scr, lane);
}
__device__ __forceinline__ void tr_plain(const float* W, int K, int N, int nblk, bf16* WT, int r, LAS float* scr, int lane) {
    const int kb = r / nblk, nb = r % nblk;
    transpose_item(W, N, 64 * kb, 32 * nb, WT, K, 32 * nb, scr, lane);
}
__device__ __forceinline__ void thin_rows(Frame& F, const float* xin, const float* f, float scale, const float* post_w, float* xout, const float* pre_w, bf16* xn) {
    for (int m = F.gw; m < M_ALL; m += F.NGW) {
        const float* xr = xin ? xin + (size_t)m * DM : (m < MP ? F.xp + (size_t)m * DM : F.xs + (size_t)(m - MP) * DM);
        const GAS f32x4* x4 = (const GAS f32x4*)xr + F.lane;
        f32x4 v[8];
#pragma unroll
        for (int j = 0; j < 8; ++j) v[j] = x4[64 * j];
        if (f) {
            const GAS f32x4* f4 = (const GAS f32x4*)(f + (size_t)m * DM) + F.lane; f32x4 g[8]; float ss = 0.f;
#pragma unroll
            for (int j = 0; j < 8; ++j) { g[j] = f4[64 * j]; ss += (g[j].x * g[j].x + g[j].y * g[j].y) + (g[j].z * g[j].z + g[j].w * g[j].w); }
            const float rs = scale * rsqrtf(wave_sum(ss) * (1.f / DM) + EPS);
            const GAS f32x4* w4 = (const GAS f32x4*)post_w + F.lane;
#pragma unroll
            for (int j = 0; j < 8; ++j) { const f32x4 w = w4[64 * j]; v[j] = v[j] + g[j] * w * rs; }
        }
        if (xout) { GAS f32x4* o4 = (GAS f32x4*)(xout + (size_t)m * DM) + F.lane;
#pragma unroll
            for (int j = 0; j < 8; ++j) o4[64 * j] = v[j]; }
        if (pre_w) {
            float ss = 0.f;
#pragma unroll
            for (int j = 0; j < 8; ++j) ss += (v[j].x * v[j].x + v[j].y * v[j].y) + (v[j].z * v[j].z + v[j].w * v[j].w);
            const float rs = rsqrtf(wave_sum(ss) * (1.f / DM) + EPS);
            const GAS f32x4* w4 = (const GAS f32x4*)pre_w + F.lane;
            GAS unsigned long long* o8 = (GAS unsigned long long*)(xn + (size_t)m * DM) + F.lane;
#pragma unroll
            for (int j = 0; j < 8; ++j) { const f32x4 w = w4[64 * j];
                o8[64 * j] = (unsigned long long)pk2(v[j].x * rs * w.x, v[j].y * rs * w.y) | ((unsigned long long)pk2(v[j].z * rs * w.z, v[j].w * rs * w.w) << 32); }
        }
    }
}
__device__ __forceinline__ void p0_prologue(Frame& F) {
    LAS float* scr = (LAS float*)(F.lds + RING_OFF + F.wave * 16384);
    constexpr int I_GU = (DM / 64) * (FF / 32), I_D = (FF / 64) * (DM / 32), I_IN = (DM / 64) * (INW_PAD / 32), I_OUT = (DM / 64) * (DM / 32);
    constexpr int NITEMS = 4 * I_GU + 2 * I_D + I_IN + I_OUT;
    for (int it = F.gw; it < NITEMS; it += F.NGW) {
        int r = it;
        if (r < I_GU) { tr_gu(F.gate1, F.W1GU, 0, r, scr, F.lane); continue; } r -= I_GU;
        if (r < I_GU) { tr_gu(F.up1, F.W1GU, 1, r, scr, F.lane); continue; } r -= I_GU;
        if (r < I_D) { tr_plain(F.down1, FF, DM, DM / 32, F.W1D, r, scr, F.lane); continue; } r -= I_D;
        if (r < I_IN) { tr_plain(F.w_in, DM, INW, INW_PAD / 32, F.WIN, r, scr, F.lane); continue; } r -= I_IN;
        if (r < I_OUT) { tr_plain(F.w_out, DM, DM, DM / 32, F.WOUT, r, scr, F.lane); continue; } r -= I_OUT;
        if (r < I_GU) { tr_gu(F.gate2, F.W2GU, 0, r, scr, F.lane); continue; } r -= I_GU;
        if (r < I_GU) { tr_gu(F.up2, F.W2GU, 1, r, scr, F.lane); continue; } r -= I_GU;
        tr_plain(F.down2, FF, DM, DM / 32, F.W2D, r, scr, F.lane);
    }
    thin_rows(F, nullptr, nullptr, 0.f, nullptr, nullptr, F.ffn1_pre, F.XN);
    { const int gt = (int)blockIdx.x * NTHREADS + F.tid, NT = F.G * NTHREADS; constexpr int NPADV = (M_PAD - M_ALL) * DM * 2 / 16;
      GAS v4u* a = (GAS v4u*)(F.XN + (size_t)M_ALL * DM); GAS v4u* b = (GAS v4u*)(F.MIX + (size_t)M_ALL * DM);
      for (int i = gt; i < NPADV; i += NT) { a[i] = (v4u){0u, 0u, 0u, 0u}; b[i] = (v4u){0u, 0u, 0u, 0u}; } }
}
__device__ __forceinline__ void act_phase(Frame& F) {
    const int gt = (int)blockIdx.x * NTHREADS + F.tid, NT = F.G * NTHREADS; constexpr int PER_ROW = FF / 4, TOT = M_ALL * PER_ROW;
    for (int i = gt; i < TOT; i += NT) {
        const int m = i / PER_ROW, col = 4 * (i % PER_ROW), pn = col >> 7, j = col & 127;
        const f32x4 g = *(const GAS f32x4*)(F.C1 + (size_t)m * GU + 256 * pn + j), u = *(const GAS f32x4*)(F.C1 + (size_t)m * GU + 256 * pn + 128 + j);
        const unsigned lo = pk2(silu_f(g.x) * u.x, silu_f(g.y) * u.y), hi = pk2(silu_f(g.z) * u.z, silu_f(g.w) * u.w);
        *(GAS unsigned long long*)(F.ACT + (size_t)m * FF + col) = (unsigned long long)lo | ((unsigned long long)hi << 32);
    }
}
__device__ __forceinline__ void split_phase(Frame& F) {
    const int gt = (int)blockIdx.x * NTHREADS + F.tid, NT = F.G * NTHREADS; constexpr int PER_ROW = 3072 / 4, TOT = M_ALL * PER_ROW;
    for (int i = gt; i < TOT; i += NT) {
        const int m = i / PER_ROW, c = 4 * (i % PER_ROW);
        const f32x4 h = *(const GAS f32x4*)(F.H + (size_t)m * INW_PAD + c);
        if (c < C_K) { *(GAS unsigned long long*)(F.QB + (size_t)m * 1024 + c) = (unsigned long long)pk2(h.x * C2, h.y * C2) | ((unsigned long long)pk2(h.z * C2, h.w * C2) << 32); }
        else {
            const bool isk = c < C_V; const int cc = c - (isk ? C_K : C_V);
            bf16* dst = (isk ? F.KB : F.VB) + (size_t)m * 1024 + cc;
            *(GAS unsigned long long*)dst = (unsigned long long)pk2(h.x, h.y) | ((unsigned long long)pk2(h.z, h.w) << 32);
            float* o = F.out + (m < MP ? (isk ? OUT_KP : OUT_VP) + (size_t)m * 1024 : (isk ? OUT_KS : OUT_VS) + (size_t)(m - MP) * 1024) + cc;
            *(GAS f32x4*)o = h;
        }
    }
    constexpr int CPR = CONVD / 4;
    for (int i = gt; i < (NBP + NBS) * 3 * CPR; i += NT) {
        const int c = 4 * (i % CPR), rj = i / CPR, j = rj % 3, b = rj / 3;
        if (b < NBP) *(GAS f32x4*)(F.out + OUT_CONVP + (size_t)(b * 3 + j) * CONVD + c) = *(const GAS f32x4*)(F.H + (size_t)(b * SEQ + SEQ - 3 + j) * INW_PAD + C_QKVB + c);
        else { const int bs = b - NBP; *(GAS f32x4*)(F.out + OUT_CONVS + (size_t)(bs * 3 + j) * CONVD + c) = *(const GAS f32x4*)(F.H + (size_t)(MP + bs * TS + TS - 3 + j) * INW_PAD + C_QKVB + c); }
    }
}
__device__ __forceinline__ void gdn_prep_phase(Frame& F) {
    typedef float f32x2 __attribute__((ext_vector_type(2)));
    for (int item = F.gw; item < M_ALL * NH; item += F.NGW) {
        const int m = item >> 3, h = item & 7;
        int t, row0; const float* cs = nullptr;
        if (m < MP) { t = m & (SEQ - 1); row0 = m - t; } else { const int ms = m - MP, b = ms / TS; t = ms % TS; row0 = MP + b * TS; cs = F.state_conv + (size_t)b * 3 * CONVD; }
        f32x2 a[3];
#pragma unroll
        for (int p = 0; p < 3; ++p) {
            const int ch = p * 1024 + h * 128 + 2 * F.lane; f32x2 acc = {0.f, 0.f};
#pragma unroll
            for (int j = 0; j < 4; ++j) {
                const int tt = t + j - 3; f32x2 xv = {0.f, 0.f};
                if (tt >= 0) xv = *(const GAS f32x2*)(F.H + (size_t)(row0 + tt) * INW_PAD + C_QKVB + ch);
                else if (cs) xv = *(const GAS f32x2*)(cs + (size_t)(tt + 3) * CONVD + ch);
                const f32x2 w = *(const GAS f32x2*)(F.conv_w + (size_t)j * CONVD + ch);
                acc = acc + xv * w;
            }
            a[p].x = silu_f(acc.x); a[p].y = silu_f(acc.y);
        }
        const float rq = rsqrtf(wave_sum(a[0].x * a[0].x + a[0].y * a[0].y) + 1e-6f) * 0.08838834764831845f;
        const float rk = rsqrtf(wave_sum(a[1].x * a[1].x + a[1].y * a[1].y) + 1e-6f);
        const size_t o = (size_t)m * 1024 + h * 128 + 2 * F.lane;
        *(GAS f32x2*)(F.QN + o) = a[0] * rq; *(GAS f32x2*)(F.KN + o) = a[1] * rk; *(GAS f32x2*)(F.VN + o) = a[2];
        if (F.lane == 0) {
            const float braw = F.H[(size_t)m * INW_PAD + C_B + h], araw = F.H[(size_t)m * INW_PAD + C_A + h];
            F.BETA[(size_t)m * NH + h] = sigmoid_f(braw);
            F.GG[(size_t)m * NH + h] = -__expf(F.a_log[h]) * softplus_f(araw + F.dt_bias[h]);
        }
    }
}
__device__ __forceinline__ void gdn_rec_item(Frame& F, int item, LAS float* wl) {
    typedef float f32x2 __attribute__((ext_vector_type(2)));
    const int qt = item & 3, sh = item >> 2, h = sh & 7, seq = sh >> 3;
    int T, row0; const float* s0 = nullptr; float* sout;
    if (seq < NBP) { T = SEQ; row0 = seq * SEQ; sout = F.out + OUT_SSMP + (size_t)(seq * NH + h) * 16384; }
    else { const int b = seq - NBP; T = TS; row0 = MP + b * TS; s0 = F.state_ssm + (size_t)(b * NH + h) * 16384; sout = F.out + OUT_SSMS + (size_t)(b * NH + h) * 16384; }
    const int rh = F.lane >> 5, j = qt * 32 + (F.lane & 31), r0 = rh * 64;
    float S[64];
#pragma unroll
    for (int i = 0; i < 64; ++i) S[i] = s0 ? s0[(r0 + i) * 128 + j] : 0.f;
    LAS float* kb = wl; LAS float* qb = wl + 128;
    size_t o = (size_t)row0 * 1024 + h * 128;
    f32x2 k2 = *(const GAS f32x2*)(F.KN + o + 2 * F.lane), q2 = *(const GAS f32x2*)(F.QN + o + 2 * F.lane);
    float v = F.VN[o + j], beta = F.BETA[(size_t)row0 * NH + h], g = F.GG[(size_t)row0 * NH + h];
    for (int t = 0; t < T; ++t) {
        *(LAS f32x2*)(kb + 2 * F.lane) = k2; *(LAS f32x2*)(qb + 2 * F.lane) = q2;
        const float vc = v, bc = beta, al = __expf(g);
        const size_t oc = o;
        if (t + 1 < T) { o += 1024; k2 = *(const GAS f32x2*)(F.KN + o + 2 * F.lane); q2 = *(const GAS f32x2*)(F.QN + o + 2 * F.lane); v = F.VN[o + j];
                         beta = F.BETA[(size_t)(row0 + t + 1) * NH + h]; g = F.GG[(size_t)(row0 + t + 1) * NH + h]; }
        LDS_WAIT(); asm volatile("" ::: "memory");
        float pred = 0.f;
#pragma unroll
        for (int i = 0; i < 64; i += 4) { const f32x4 kk = *(const LAS f32x4*)(kb + r0 + i);
            S[i] *= al; S[i + 1] *= al; S[i + 2] *= al; S[i + 3] *= al;
            pred += kk.x * S[i] + kk.y * S[i + 1] + kk.z * S[i + 2] + kk.w * S[i + 3];
            if ((i & 15) == 12) asm volatile("" ::: "memory"); }
        pred += __shfl_xor(pred, 32);
        const float dv = bc * (vc - pred);
        float oo = 0.f;
#pragma unroll
        for (int i = 0; i < 64; i += 4) { const f32x4 kk = *(const LAS f32x4*)(kb + r0 + i); const f32x4 qq = *(const LAS f32x4*)(qb + r0 + i);
            S[i] += kk.x * dv; S[i + 1] += kk.y * dv; S[i + 2] += kk.z * dv; S[i + 3] += kk.w * dv;
            oo += qq.x * S[i] + qq.y * S[i + 1] + qq.z * S[i + 2] + qq.w * S[i + 3];
            if ((i & 15) == 12) asm volatile("" ::: "memory"); }
        oo += __shfl_xor(oo, 32);
        if (rh == 0) F.OG[oc + j] = oo;
        LDS_WAIT(); asm volatile("" ::: "memory");
    }
#pragma unroll
    for (int i = 0; i < 64; ++i) sout[(r0 + i) * 128 + j] = S[i];
}
template <bool SAMPLE> __device__ __forceinline__ void attn_row_item(Frame& F, int item, LAS float* wl) {
    typedef float f32x2 __attribute__((ext_vector_type(2)));
    const int h = item & 7, mi = item >> 3;
    int b, tq, nkeys, qrow, krow0;
    if (SAMPLE) { b = mi / TS; tq = mi % TS; nkeys = PAST + tq + 1; qrow = MP + mi; krow0 = MP + b * TS; }
    else { b = mi / SEQ; tq = mi % SEQ; nkeys = tq + 1; qrow = mi; krow0 = b * SEQ; }
    LAS float* ql = wl + 128;
    { const unsigned w = *(const GAS unsigned*)(F.QB + (size_t)qrow * 1024 + h * 128 + 2 * F.lane);
      ql[2 * F.lane] = __uint_as_float(w << 16); ql[2 * F.lane + 1] = __uint_as_float(w & 0xffff0000u); }
    LDS_WAIT(); asm volatile("" ::: "memory");
    const float slope2 = exp2f(-(float)(h + 1)) * LOG2E;
    const int qpos = SAMPLE ? PAST + tq : tq;
    float M1 = -1e30f, M2 = -1e30f, l1 = 0.f, l2 = 0.f; f32x2 o1 = {0.f, 0.f}, o2 = {0.f, 0.f};
    for (int c0 = 0; c0 < nkeys; c0 += 64) {
        const int j = c0 + F.lane; const bool valid = j < nkeys;
        float s1 = -1e30f, s2 = -1e30f;
        if (valid) {
            float a1 = 0.f, a2 = 0.f;
            if (SAMPLE && j < PAST) {
                const int page = F.page_table[b * NPAGES + (j >> 7)];
                const GAS f32x4* kp = (const GAS f32x4*)(F.cache_k + ((size_t)(page * PAGE + (j & 127)) * NH + h) * 128);
#pragma unroll 4
                for (int i = 0; i < 16; ++i) { const f32x4 kv = kp[i]; const f32x4 qv = *(const LAS f32x4*)(ql + 4 * i); a1 += qv.x * kv.x + qv.y * kv.y + qv.z * kv.z + qv.w * kv.w; }
#pragma unroll 4
                for (int i = 16; i < 32; ++i) { const f32x4 kv = kp[i]; const f32x4 qv = *(const LAS f32x4*)(ql + 4 * i); a2 += qv.x * kv.x + qv.y * kv.y + qv.z * kv.z + qv.w * kv.w; }
            } else {
                const int kr = SAMPLE ? krow0 + (j - PAST) : krow0 + j;
                const GAS v4u* kp = (const GAS v4u*)(F.KB + (size_t)kr * 1024 + h * 128);
#pragma unroll 4
                for (int i = 0; i < 16; ++i) { const v4u w = kp[i]; const f32x4 qa = *(const LAS f32x4*)(ql + 8 * i), qb = *(const LAS f32x4*)(ql + 8 * i + 4);
                    const float d = qa.x * __uint_as_float(w.x << 16) + qa.y * __uint_as_float(w.x & 0xffff0000u) + qa.z * __uint_as_float(w.y << 16) + qa.w * __uint_as_float(w.y & 0xffff0000u)
                                  + qb.x * __uint_as_float(w.z << 16) + qb.y * __uint_as_float(w.z & 0xffff0000u) + qb.z * __uint_as_float(w.w << 16) + qb.w * __uint_as_float(w.w & 0xffff0000u);
                    if (i < 8) a1 += d; else a2 += d; }
            }
            const float bias = slope2 * (float)(qpos - j);
            s1 = a1 - bias; s2 = a2 - bias;
        }
        const float n1 = fmaxf(M1, wave_max(s1)), n2 = fmaxf(M2, wave_max(s2));
        const float al1 = exp2f(M1 - n1), al2 = exp2f(M2 - n2);
        const float p1 = valid ? exp2f(s1 - n1) : 0.f, p2 = valid ? exp2f(s2 - n2) : 0.f;
        l1 = l1 * al1 + p1; l2 = l2 * al2 + p2; o1 = o1 * al1; o2 = o2 * al2; M1 = n1; M2 = n2;
        wl[F.lane] = p1; wl[64 + F.lane] = p2;
        LDS_WAIT(); asm volatile("" ::: "memory");
        const int nk = (nkeys - c0) < 64 ? (nkeys - c0) : 64;
        for (int jj = 0; jj < nk; ++jj) {
            const float pp1 = wl[jj], pp2 = wl[64 + jj]; const int jk = c0 + jj; f32x2 vv;
            if (SAMPLE && jk < PAST) { const int page = F.page_table[b * NPAGES + (jk >> 7)];
                vv = *(const GAS f32x2*)(F.cache_v + ((size_t)(page * PAGE + (jk & 127)) * NH + h) * 128 + 2 * F.lane); }
            else { const int kr = SAMPLE ? krow0 + (jk - PAST) : krow0 + jk; const unsigned w = *(const GAS unsigned*)(F.VB + (size_t)kr * 1024 + h * 128 + 2 * F.lane);
                vv.x = __uint_as_float(w << 16); vv.y = __uint_as_float(w & 0xffff0000u); }
            o1 = o1 + vv * pp1; o2 = o2 + vv * pp2;
        }
        LDS_WAIT(); asm volatile("" ::: "memory");
    }
    const float L1 = 1.f / wave_sum(l1), L2 = 1.f / wave_sum(l2);
    const size_t oo = (size_t)qrow * 1024 + h * 128 + 2 * F.lane;
    *(GAS f32x2*)(F.O1 + oo) = o1 * L1; *(GAS f32x2*)(F.O2 + oo) = o2 * L2;
}
constexpr int N_GDN_ITEMS = (NBP + NBS) * NH * 4, N_ATT_S = MS * NH, N_ATT_P = MP * NH;
__device__ __forceinline__ void mixer_phase(Frame& F) {
    LAS float* wl = (LAS float*)(F.lds + RING_OFF + F.wave * 16384);
    if (F.gw < N_GDN_ITEMS) gdn_rec_item(F, F.gw, wl);
    for (;;) {
        int it = 0;
        if (F.lane == 0) it = (int)__hip_atomic_fetch_add(F.ctl + CW_QCTR, 1u, RLX_AGENT);
        it = __builtin_amdgcn_readfirstlane(it);
        if (it >= N_ATT_S + N_ATT_P) break;
        if (it < N_ATT_S) attn_row_item<true>(F, it, wl);
        else attn_row_item<false>(F, N_ATT_P - 1 - (it - N_ATT_S), wl);
    }
}
__device__ __forceinline__ void combine_phase(Frame& F) {
    typedef float f32x2 __attribute__((ext_vector_type(2)));
    const float lam = __expf(wave_sum(F.lq1[F.lane] * F.lk1[F.lane])) - __expf(wave_sum(F.lq2[F.lane] * F.lk2[F.lane])) + 0.2f;
    const f32x2 sw = *(const GAS f32x2*)(F.subln_w + 2 * F.lane), dw = *(const GAS f32x2*)(F.dnorm_w + 2 * F.lane);
    for (int m = F.gw; m < M_ALL; m += F.NGW) {
#pragma unroll 2
        for (int h = 0; h < NH; ++h) {
            const size_t o = (size_t)m * 1024 + h * 128 + 2 * F.lane;
            const f32x2 d = *(const GAS f32x2*)(F.O1 + o) - *(const GAS f32x2*)(F.O2 + o) * lam;
            const float rs = rsqrtf(wave_sum(d.x * d.x + d.y * d.y) * (1.f / 128.f) + EPS) * 0.8f;
            *(GAS unsigned*)(F.MIX + (size_t)m * DM + h * 128 + 2 * F.lane) = pk2(d.x * rs * sw.x, d.y * rs * sw.y);
            const f32x2 g = *(const GAS f32x2*)(F.OG + o);
            const float rg = rsqrtf(wave_sum(g.x * g.x + g.y * g.y) * (1.f / 128.f) + EPS);
            const f32x2 z = *(const GAS f32x2*)(F.H + (size_t)m * INW_PAD + C_Z + h * 128 + 2 * F.lane);
            *(GAS unsigned*)(F.MIX + (size_t)m * DM + 1024 + h * 128 + 2 * F.lane) = pk2(g.x * rg * dw.x * silu_f(z.x), g.y * rg * dw.y * silu_f(z.y));
        }
    }
}

struct Args { const void* in[30]; float* out; unsigned char* ws; int ph_lo, ph_hi; };
__global__ void __launch_bounds__(NTHREADS, 2) fwd_kernel(Args args) {
    extern __shared__ __attribute__((aligned(16))) unsigned char lds[];
    Frame F;
    F.lds = (LAS unsigned char*)lds; F.MISC = (volatile LAS unsigned*)(F.lds + MISC_OFF);
    F.tid = threadIdx.x; F.lane = F.tid & 63; F.wave = __builtin_amdgcn_readfirstlane(F.tid >> 6);
    F.G = gridDim.x; F.gw = (int)blockIdx.x * NWAVES + F.wave; F.NGW = F.G * NWAVES;
    unsigned char* ws = args.ws;
    F.ctl = (gu32*)(ws + WS_CTL);
    F.xp = (const float*)args.in[0]; F.xs = (const float*)args.in[1]; F.cache_k = (const float*)args.in[2]; F.cache_v = (const float*)args.in[3];
    F.state_ssm = (const float*)args.in[4]; F.state_conv = (const float*)args.in[5]; F.page_table = (const int*)args.in[6];
    F.ffn1_pre = (const float*)args.in[7]; F.ffn1_post = (const float*)args.in[8]; F.gate1 = (const float*)args.in[9]; F.up1 = (const float*)args.in[10]; F.down1 = (const float*)args.in[11];
    F.mix_pre = (const float*)args.in[12]; F.mix_post = (const float*)args.in[13]; F.w_in = (const float*)args.in[14]; F.conv_w = (const float*)args.in[15]; F.a_log = (const float*)args.in[16];
    F.dt_bias = (const float*)args.in[17]; F.dnorm_w = (const float*)args.in[18]; F.lq1 = (const float*)args.in[19]; F.lk1 = (const float*)args.in[20]; F.lq2 = (const float*)args.in[21]; F.lk2 = (const float*)args.in[22];
    F.subln_w = (const float*)args.in[23]; F.w_out = (const float*)args.in[24]; F.ffn2_pre = (const float*)args.in[25]; F.ffn2_post = (const float*)args.in[26];
    F.gate2 = (const float*)args.in[27]; F.up2 = (const float*)args.in[28]; F.down2 = (const float*)args.in[29];
    F.out = args.out;
    F.W1GU = (bf16*)(ws + WS_W1GU); F.W1D = (bf16*)(ws + WS_W1D); F.WIN = (bf16*)(ws + WS_WIN); F.WOUT = (bf16*)(ws + WS_WOUT); F.W2GU = (bf16*)(ws + WS_W2GU); F.W2D = (bf16*)(ws + WS_W2D);
    F.XN = (bf16*)(ws + WS_XN); F.ACT = (bf16*)(ws + WS_ACT); F.QB = (bf16*)(ws + WS_QB); F.KB = (bf16*)(ws + WS_KB); F.VB = (bf16*)(ws + WS_VB); F.MIX = (bf16*)(ws + WS_MIX);
    F.Fb = (float*)(ws + WS_F); F.X1 = (float*)(ws + WS_X1); F.X2 = (float*)(ws + WS_X2); F.C1 = (float*)(ws + WS_C1); F.H = (float*)(ws + WS_H);
    F.QN = (float*)(ws + WS_QN); F.KN = (float*)(ws + WS_KN); F.VN = (float*)(ws + WS_VN); F.BETA = (float*)(ws + WS_BETA); F.GG = (float*)(ws + WS_GG);
    F.OG = (float*)(ws + WS_OG); F.O1 = (float*)(ws + WS_O1); F.O2 = (float*)(ws + WS_O2);
    for (int u = F.tid; u < (LDS_BYTES - LDSCTL_OFF) / 4; u += NTHREADS) ((LAS unsigned*)(F.lds + LDSCTL_OFF))[u] = 0u;
    __syncthreads();
    XcdBarrier bar; bar.bar = (unsigned*)(F.ctl + CW_BAR); bar.x = 0; bar.st = nullptr;
    if (MK_N_LAUNCHES == 1) bar = xcd_barrier_post((unsigned*)(F.ctl + CW_BAR), F.MISC + 8);
    const int lo = args.ph_lo, hi = args.ph_hi;
#define IN(k) (lo <= (k) && (k) < hi)
#define SEAM(k) do { if (IN(k) && IN((k) + 1)) { if (MK_N_LAUNCHES == 1) xcd_barrier(bar); } } while (0)
#define GEMM_F32(Aptr, Bptr, N_, K_, Cptr) do { pg8::Gemm g{Aptr, Bptr, M_PAD, N_, K_}; pg8::StaticOrder S; S.init(M_PAD, N_, F.G, (int)blockIdx.x); EpiF32 E{Cptr, N_}; \
        pg8::gemm_phase<EpiF32, pg8::StaticOrder, PG8_ALIGN, PG8_SP2>(F.lds + RING_OFF, g, S, E); } while (0)

    if (IN(0)) { p0_prologue(F); } SEAM(0);
    if (IN(1)) { GEMM_F32(F.XN, F.W1GU, GU, DM, F.C1); } SEAM(1);
    if (IN(2)) { act_phase(F); } SEAM(2);
    if (IN(3)) { GEMM_F32(F.ACT, F.W1D, DM, FF, F.Fb); } SEAM(3);
    if (IN(4)) { thin_rows(F, nullptr, F.Fb, 0.5f, F.ffn1_post, F.X1, F.mix_pre, F.XN); } SEAM(4);
    if (IN(5)) { GEMM_F32(F.XN, F.WIN, INW_PAD, DM, F.H); } SEAM(5);
    if (IN(6)) { split_phase(F); gdn_prep_phase(F); } SEAM(6);
    if (IN(7)) { mixer_phase(F); } SEAM(7);
    if (IN(8)) { combine_phase(F); } SEAM(8);
    if (IN(9)) { GEMM_F32(F.MIX, F.WOUT, DM, DM, F.Fb); } SEAM(9);
    if (IN(10)) { thin_rows(F, F.X1, F.Fb, 1.0f, F.mix_post, F.X2, F.ffn2_pre, F.XN); } SEAM(10);
    if (IN(11)) { GEMM_F32(F.XN, F.W2GU, GU, DM, F.C1); } SEAM(11);
    if (IN(12)) { act_phase(F); } SEAM(12);
    if (IN(13)) { GEMM_F32(F.ACT, F.W2D, DM, FF, F.Fb); } SEAM(13);
    if (IN(14)) { thin_rows(F, F.X2, F.Fb, 0.5f, F.ffn2_post, F.out + OUT_Y, nullptr, nullptr); }
#undef IN
#undef SEAM
#undef GEMM_F32
}

extern "C" void kernel_launch(void* const* d_in, const int* in_sizes, int n_in, void* d_out, int out_size, void* d_ws, size_t ws_size, hipStream_t stream) {
    static int grid = 0;
    if (grid == 0) {
        if (n_in != 30 || ws_size < WS_END) { fprintf(stderr, "kernel_launch: unexpected shapes (n_in %d, out %d, ws %zu)\n", n_in, out_size, ws_size); grid = -1; return; }
        int dev = 0, cus = 0, per_cu = 0;
        if (hipGetDevice(&dev) != hipSuccess || hipDeviceGetAttribute(&cus, hipDeviceAttributeMultiprocessorCount, dev) != hipSuccess) { grid = -1; return; }
        if (hipFuncSetAttribute((const void*)fwd_kernel, hipFuncAttributeMaxDynamicSharedMemorySize, LDS_BYTES) != hipSuccess) { fprintf(stderr, "kernel_launch: hipFuncSetAttribute failed\n"); grid = -1; return; }
        if (hipOccupancyMaxActiveBlocksPerMultiprocessor(&per_cu, (const void*)fwd_kernel, NTHREADS, LDS_BYTES) != hipSuccess || per_cu < 1) { fprintf(stderr, "kernel_launch: occupancy query says %d\n", per_cu); }
        (void)hipGetLastError();
        grid = cus;
    }
    if (grid < 0) return;
    (void)hipMemsetAsync((char*)d_ws + WS_CTL, 0, CTL_ZERO_BYTES, stream);
    Args a{};
    for (int i = 0; i < 30; ++i) a.in[i] = d_in[i];
    a.out = (float*)d_out; a.ws = (unsigned char*)d_ws;
    if (MK_N_LAUNCHES == 1) { a.ph_lo = 0; a.ph_hi = NPHASE; hipLaunchKernelGGL(fwd_kernel, dim3(grid), dim3(NTHREADS), LDS_BYTES, stream, a); }
    else for (int p = 0; p < NPHASE; ++p) { a.ph_lo = p; a.ph_hi = p + 1; hipLaunchKernelGGL(fwd_kernel, dim3(grid), dim3(NTHREADS), LDS_BYTES, stream, a); }
}
```

```cpp
#include <hip/hip_runtime.h>
#include <cstdio>
#include <cstdint>
namespace pg8 {
#define PG8_LAS __attribute__((address_space(3)))
typedef unsigned short bf16_t;
typedef short bf16x8 __attribute__((ext_vector_type(8)));
typedef float f32x4 __attribute__((ext_vector_type(4)));
typedef unsigned u32x4 __attribute__((ext_vector_type(4)));
constexpr int BM = 256, BK = 64, HALF = 128, HTB = HALF * BK * 2  , STAGE_BYTES = 8 * HTB, NXCD = 8, WGM = 8;

__host__ __device__ __forceinline__ int lds_byte(int r, int c) { const int st = (r >> 4) * 2 + (c >> 5), rr = r & 15, cc = c & 31, ob = rr * 64 + cc * 2; return st * 1024 + (ob ^ (((ob >> 9) & 1) << 5)); }
__host__ __device__ __forceinline__ void stage_rc(int b, int& R, int& C) { const int st = b / 1024, sb = b % 1024, swz = sb ^ (((sb >> 9) & 1) << 5); R = (st >> 1) * 16 + swz / 64; C = (st & 1) * 32 + (swz % 64) / 2; }
__host__ __device__ __forceinline__ int perm32(int rho) { const int n = rho >> 4, i = rho & 15; return 8 * (i >> 2) + 4 * n + (i & 3); }

struct Unit { int pm, pn; };
struct Gemm { const bf16_t* A; const bf16_t* Bt; int M, N, K; int rot; };

struct StaticOrder {
    int nM, nN, nwg, G, c;
    __host__ __device__ void init(int M, int N, int G_, int c_) { nM = M / BM; nN = N / BM; nwg = nM * nN; G = G_; c = c_; }
    __host__ __device__ bool next(int i, Unit& u) const {
        const long L = (long)i * G + c; if (L >= nwg) return false;
        int wgid = (int)L; { const int q = nwg / NXCD, r = nwg % NXCD, xcd = wgid % NXCD, off = wgid / NXCD; wgid = (xcd < r ? xcd * (q + 1) : r * (q + 1) + (xcd - r) * q) + off; }
        const int nig = WGM * nN, gid = wgid / nig, fm = gid * WGM, gsz = (nM - fm) < WGM ? (nM - fm) : WGM;
        u.pm = fm + ((wgid % nig) % gsz); u.pn = (wgid % nig) / gsz; return true;
    }
    __device__ __forceinline__ void a_ready(const Unit&) const {}
    __device__ __forceinline__ void done(const Unit&) const {}
};

__device__ __forceinline__ unsigned cvt_pk_bf16(float lo, float hi) { unsigned r; asm volatile("v_cvt_pk_bf16_f32 %0, %1, %2" : "=v"(r) : "v"(lo), "v"(hi)); return r; }
typedef float f32x2 __attribute__((ext_vector_type(2)));
__device__ __forceinline__ f32x2 gelu_pk(f32x2 v) {
    const f32x2 av = __builtin_elementwise_abs(v), d = av * 0.2316418882f + 1.0f;
    f32x2 t; t.x = __builtin_amdgcn_rcpf(d.x); t.y = __builtin_amdgcn_rcpf(d.y);
    f32x2 q = t * 0.5307027145f + (-0.7265760135f); q = q * t + 0.7107068705f; q = q * t + (-0.142248368f); q = q * t + 0.127414796f; q = q * t;
    const f32x2 s = (v * v) * (-0.72134752044f);
    f32x2 e; e.x = __builtin_amdgcn_exp2f(s.x); e.y = __builtin_amdgcn_exp2f(s.y);
    const f32x2 m = v * (q * e), r = v - m;
    f32x2 o; o.x = v.x < 0.f ? m.x : r.x; o.y = v.y < 0.f ? m.y : r.y; return o;
}

template <int ACT  > struct EpiBf16 {
    static constexpr bool PERM = true, AFTER_DRAIN = false; static_assert(ACT == 0 || ACT == 1, "EpiBf16: ACT is 0 (none) or 1 (gelu_pk)");
    bf16_t* O; int ldc; const float* bias; int split_cols; size_t split_stride; float scale0;
    __device__ __forceinline__ void operator()(const f32x4 (&acc)[2][2][4][2], const Unit& u, int wr, int wc, int fr, int fq) const {
        const int row0 = u.pm * BM + wr * 64 + fr; int colt = u.pn * BM; bf16_t* base = O;
        float sc = 1.f; if (split_cols) { const int t = colt / split_cols; base += (size_t)t * split_stride; colt -= t * split_cols; if (t == 0) sc = scale0; }
        const int col0 = colt + wc * 32 + 8 * fq, bcol0 = u.pn * BM + wc * 32 + 8 * fq;
        f32x4 bv[2][2];
#pragma unroll
        for (int bj = 0; bj < 2; ++bj)
#pragma unroll
            for (int n = 0; n < 2; ++n) bv[bj][n] = bias ? *(const f32x4*)(bias + bcol0 + bj * HALF + 4 * n) : (f32x4){0.f, 0.f, 0.f, 0.f};
#pragma unroll
        for (int ai = 0; ai < 2; ++ai)
#pragma unroll
            for (int m = 0; m < 4; ++m) { bf16_t* rowp = base + (size_t)(row0 + ai * HALF + m * 16) * ldc + col0;
#pragma unroll
                for (int bj = 0; bj < 2; ++bj) { f32x4 v0 = acc[ai][bj][m][0] + bv[bj][0], v1 = acc[ai][bj][m][1] + bv[bj][1];
                    if (ACT == 1) { f32x2 a = gelu_pk((f32x2){v0[0], v0[1]}), b = gelu_pk((f32x2){v0[2], v0[3]}), c = gelu_pk((f32x2){v1[0], v1[1]}), d = gelu_pk((f32x2){v1[2], v1[3]});
                        v0 = (f32x4){a.x, a.y, b.x, b.y}; v1 = (f32x4){c.x, c.y, d.x, d.y}; }
                    v0 = v0 * sc; v1 = v1 * sc; u32x4 w; w.x = cvt_pk_bf16(v0[0], v0[1]); w.y = cvt_pk_bf16(v0[2], v0[3]); w.z = cvt_pk_bf16(v1[0], v1[1]); w.w = cvt_pk_bf16(v1[2], v1[3]);
                    *(u32x4*)(rowp + bj * HALF) = w; } }
    }
};

struct PanelStats {
    unsigned* xbuf;
    unsigned* cnt;
    unsigned* tmo;
    int ntn; float eps;
    unsigned code;
    __device__ __forceinline__ bool run(const f32x4 (&v)[2][2][4][2], const Unit& u, int wr, int wc, int fr, int fq, PG8_LAS unsigned char* lds, int wid, int lane) const {
        typedef float f32x2v __attribute__((ext_vector_type(2)));
        PG8_LAS f32x2v* P = (PG8_LAS f32x2v*)lds;
        PG8_LAS f32x2v* S = (PG8_LAS f32x2v*)(lds + 8192);
        PG8_LAS unsigned* flag = (PG8_LAS unsigned*)(lds + 8192 + 2048);
#pragma unroll
        for (int ai = 0; ai < 2; ++ai)
#pragma unroll
            for (int m = 0; m < 4; ++m) {
                float s = 0.f;
#pragma unroll
                for (int bj = 0; bj < 2; ++bj)
#pragma unroll
                    for (int n = 0; n < 2; ++n) { const f32x4 x = v[ai][bj][m][n]; s += (x[0] + x[1]) + (x[2] + x[3]); }
                s += __shfl_xor(s, 16); s += __shfl_xor(s, 32);
                const float mw = s * (1.0f / 64.0f); float q = 0.f;
#pragma unroll
                for (int bj = 0; bj < 2; ++bj)
#pragma unroll
                    for (int n = 0; n < 2; ++n) { const f32x4 d = v[ai][bj][m][n] - mw; q += (d[0] * d[0] + d[1] * d[1]) + (d[2] * d[2] + d[3] * d[3]); }
                q += __shfl_xor(q, 16); q += __shfl_xor(q, 32);
                if (fq == 0) P[(ai * HALF + wr * 64 + m * 16 + fr) * 4 + wc] = (f32x2v){mw, q};
            }
        asm volatile("s_waitcnt lgkmcnt(0)" ::: "memory"); __builtin_amdgcn_s_barrier(); asm volatile("" ::: "memory");
#if defined(BROKEN_EXCHANGE_NO_WAIT)
#warning BROKEN CONTROL BUILD: the row-statistics exchange does not wait; results are wrong by design
        if (blockIdx.x >= 64) { const long long t0_ = clock64(); while (clock64() - t0_ < 60000) __builtin_amdgcn_s_sleep(8); }
#endif
        const int row = wid * 32 + (lane & 31);
        if (lane < 32) {
            const f32x2v a = P[row * 4 + 0], b = P[row * 4 + 1], c = P[row * 4 + 2], d = P[row * 4 + 3];
            const float mt = (a.x + b.x + c.x + d.x) * 0.25f;
            const float da = a.x - mt, db = b.x - mt, dc = c.x - mt, dd = d.x - mt;
            const float m2 = (a.y + b.y) + (c.y + d.y) + 64.0f * ((da * da + db * db) + (dc * dc + dd * dd));
            unsigned long long* slot = (unsigned long long*)xbuf + ((size_t)(u.pm * BM + row) * 4 + u.pn);
            __hip_atomic_store(slot, ((unsigned long long)__float_as_uint(m2) << 32) | __float_as_uint(mt), __ATOMIC_RELAXED, __HIP_MEMORY_SCOPE_AGENT);
        }
        asm volatile("s_waitcnt vmcnt(0)" ::: "memory");
        if (lane == 0) __hip_atomic_fetch_add(cnt + 64 * u.pm, 1u, __ATOMIC_RELAXED, __HIP_MEMORY_SCOPE_AGENT);
        if (wid == 0) {
            bool dead = false; const unsigned long long t0 = __builtin_amdgcn_s_memrealtime(); const unsigned want = 8u * (unsigned)ntn;
            for (;;) {
#if defined(BROKEN_EXCHANGE_NO_WAIT)
                break;
#endif
                if ((unsigned)__builtin_amdgcn_readfirstlane(__hip_atomic_load(cnt + 64 * u.pm, __ATOMIC_RELAXED, __HIP_MEMORY_SCOPE_AGENT)) >= want) break;
                if (__builtin_amdgcn_s_memrealtime() - t0 > 2000000ull) {
                    if (lane == 0) { unsigned expect = 0u; __hip_atomic_compare_exchange_strong(tmo + 1, &expect, code | (unsigned)(u.pm & 0xff), __ATOMIC_RELAXED, __ATOMIC_RELAXED, __HIP_MEMORY_SCOPE_AGENT);
                                     __hip_atomic_store(tmo, 1u, __ATOMIC_RELAXED, __HIP_MEMORY_SCOPE_AGENT); }
                    dead = true; break; }
                __builtin_amdgcn_s_sleep(2);
            }
            __builtin_amdgcn_fence(__ATOMIC_ACQUIRE, "agent");
            if (lane == 0) flag[0] = dead ? 1u : 0u;
        }
        asm volatile("s_waitcnt vmcnt(0) lgkmcnt(0)" ::: "memory"); __builtin_amdgcn_s_barrier(); asm volatile("" ::: "memory");
        const bool bad = flag[0] != 0u;
        if (lane < 32) {
            const unsigned long long* slot = (const unsigned long long*)xbuf + (size_t)(u.pm * BM + row) * 4; float mt[4], m2[4]; float ms = 0.f;
#pragma unroll
            for (int t = 0; t < 4; ++t) { if (t < ntn) { const unsigned long long w = __hip_atomic_load(slot + t, __ATOMIC_RELAXED, __HIP_MEMORY_SCOPE_AGENT); mt[t] = __uint_as_float((unsigned)w); m2[t] = __uint_as_float((unsigned)(w >> 32)); } else { mt[t] = 0.f; m2[t] = 0.f; } ms += mt[t]; }
            const float mean = ms / (float)ntn; float q = 0.f;
#pragma unroll
            for (int t = 0; t < 4; ++t) if (t < ntn) { const float dm = mt[t] - mean; q += m2[t] + 256.0f * dm * dm; }
            S[row] = (f32x2v){mean, 1.0f / sqrtf(q / (256.0f * (float)ntn) + eps)};
        }
        asm volatile("s_waitcnt lgkmcnt(0)" ::: "memory"); __builtin_amdgcn_s_barrier(); asm volatile("" ::: "memory");
        return bad;
    }
};
struct EpiLnRes {
    static constexpr bool PERM = false, AFTER_DRAIN = true;
    const float* base; float* out; int ldc; const float* bias; PanelStats st; unsigned poison;
    __device__ __forceinline__ void fused(f32x4 (&acc)[2][2][4][2], const Unit& u, int wr, int wc, int fr, int fq, PG8_LAS unsigned char* lds, int wid, int lane) const {
        typedef float f32x2v __attribute__((ext_vector_type(2)));
        const PG8_LAS f32x2v* S = (const PG8_LAS f32x2v*)(lds + 8192);
        const int col0 = u.pn * BM + wc * 32 + 4 * fq;
#pragma unroll
        for (int bj = 0; bj < 2; ++bj)
#pragma unroll
            for (int n = 0; n < 2; ++n) { const f32x4 bv = bias ? *(const f32x4*)(bias + col0 + bj * HALF + n * 16) : (f32x4){0.f, 0.f, 0.f, 0.f};
#pragma unroll
                for (int ai = 0; ai < 2; ++ai)
#pragma unroll
                    for (int m = 0; m < 4; ++m) acc[ai][bj][m][n] += bv; }
        f32x4 pre[4][2][2];
#pragma unroll
        for (int m = 0; m < 4; ++m) { const size_t off = (size_t)(u.pm * BM + wr * 64 + m * 16 + fr) * ldc + col0;
#pragma unroll
            for (int bj = 0; bj < 2; ++bj)
#pragma unroll
                for (int n = 0; n < 2; ++n) pre[m][bj][n] = *(const f32x4*)(base + off + bj * HALF + n * 16); }
        const bool bad = st.run(acc, u, wr, wc, fr, fq, lds, wid, lane) || poison != 0u;
        const float qnan = __builtin_nanf("");
#pragma unroll
        for (int ai = 0; ai < 2; ++ai)
#pragma unroll
            for (int m = 0; m < 4; ++m) { const int r = ai * HALF + wr * 64 + m * 16 + fr; const f32x2v sr = S[r]; const size_t off = (size_t)(u.pm * BM + r) * ldc + col0;
#pragma unroll
                for (int bj = 0; bj < 2; ++bj)
#pragma unroll
                    for (int n = 0; n < 2; ++n) { const f32x4 bs = ai == 0 ? pre[m][bj][n] : *(const f32x4*)(base + off + bj * HALF + n * 16); f32x4 o = bs + (acc[ai][bj][m][n] - sr.x) * sr.y;
                        if (bad) o = (f32x4){qnan, qnan, qnan, qnan}; *(f32x4*)(out + off + bj * HALF + n * 16) = o; }
                if (m & 1) asm volatile("" ::: "memory"); }
    }
};
struct EpiLnResLn {
    static constexpr bool PERM = false, AFTER_DRAIN = true;
    const float* base; float* out; bf16_t* xn; int ldc; const float* bias; PanelStats st1, st2; unsigned poison;
    __device__ __forceinline__ void fused(f32x4 (&acc)[2][2][4][2], const Unit& u, int wr, int wc, int fr, int fq, PG8_LAS unsigned char* lds, int wid, int lane) const {
        typedef float f32x2v __attribute__((ext_vector_type(2))); typedef unsigned u32x2v __attribute__((ext_vector_type(2)));
        const PG8_LAS f32x2v* S = (const PG8_LAS f32x2v*)(lds + 8192);
        const int col0 = u.pn * BM + wc * 32 + 4 * fq;
#pragma unroll
        for (int bj = 0; bj < 2; ++bj)
#pragma unroll
            for (int n = 0; n < 2; ++n) { const f32x4 bv = bias ? *(const f32x4*)(bias + col0 + bj * HALF + n * 16) : (f32x4){0.f, 0.f, 0.f, 0.f};
#pragma unroll
                for (int ai = 0; ai < 2; ++ai)
#pragma unroll
                    for (int m = 0; m < 4; ++m) acc[ai][bj][m][n] += bv; }
        bool bad = st1.run(acc, u, wr, wc, fr, fq, lds, wid, lane) || poison != 0u;
        const float qnan = __builtin_nanf("");
#pragma unroll
        for (int ai = 0; ai < 2; ++ai)
#pragma unroll
            for (int m = 0; m < 4; ++m) { const int r = ai * HALF + wr * 64 + m * 16 + fr; const f32x2v sr = S[r]; const size_t off = (size_t)(u.pm * BM + r) * ldc + col0;
#pragma unroll
                for (int bj = 0; bj < 2; ++bj)
#pragma unroll
                    for (int n = 0; n < 2; ++n) { const f32x4 bs = *(const f32x4*)(base + off + bj * HALF + n * 16); acc[ai][bj][m][n] = bs + (acc[ai][bj][m][n] - sr.x) * sr.y; }
                asm volatile("" : "+v"(acc[ai][0][m][0]), "+v"(acc[ai][0][m][1]), "+v"(acc[ai][1][m][0]), "+v"(acc[ai][1][m][1]));
                if (m & 1) asm volatile("" ::: "memory"); }
        const bool bad1 = bad;
        bad = st2.run(acc, u, wr, wc, fr, fq, lds, wid, lane) || bad;
#pragma unroll
        for (int ai = 0; ai < 2; ++ai)
#pragma unroll
            for (int m = 0; m < 4; ++m) { const int r = ai * HALF + wr * 64 + m * 16 + fr; const f32x2v sr = S[r]; const size_t off = (size_t)(u.pm * BM + r) * ldc + col0;
#pragma unroll
                for (int bj = 0; bj < 2; ++bj)
#pragma unroll
                    for (int n = 0; n < 2; ++n) { const f32x4 x1 = acc[ai][bj][m][n]; *(f32x4*)(out + off + bj * HALF + n * 16) = bad1 ? (f32x4){qnan, qnan, qnan, qnan} : x1;
                        const f32x4 o = (x1 - sr.x) * sr.y; u32x2v w; w.x = cvt_pk_bf16(o[0], o[1]); w.y = cvt_pk_bf16(o[2], o[3]);
                        if (bad) { w.x = 0x7fc07fc0u; w.y = 0x7fc07fc0u; } *(u32x2v*)(xn + off + bj * HALF + n * 16) = w; }
                asm volatile("" ::: "memory"); }
    }
};

template <class Epi, class Sched, bool ALIGN_EPI = false, bool SP2 = false>
__device__ __forceinline__ void gemm_phase(PG8_LAS unsigned char* lds, const Gemm g, const Sched& S, const Epi& E, const int tid_in) {
    const int tid = tid_in, wid = __builtin_amdgcn_readfirstlane(tid >> 6), lane = tid & 63, wr = wid >> 2, wc = wid & 3, fr = lane & 15, fq = lane >> 4;
    const int K = g.K, nt = K / BK;
    unsigned voffA[2], voffB[2];
#pragma unroll
    for (int i = 0; i < 2; ++i) { int R, C; stage_rc(tid * 16 + i * 8192, R, C); const int Rb = Epi::PERM ? ((R & ~31) + perm32(R & 31)) : R;
        voffA[i] = (unsigned)(R * K + C) * 2u; voffB[i] = (unsigned)(Rb * K + C) * 2u; }
    const size_t kstep = (size_t)(BK * 2);
    const size_t hstep = (size_t)HALF * K * 2;
    const size_t tstep = 2 * hstep;
    const unsigned ldsw = (unsigned)wid * 1024u;
    const int aoff = lds_byte(wr * 64 + fr, fq * 8), boff = lds_byte(wc * 32 + fr, fq * 8);
#define PG8_SA(b, h) (((b) * 2 + (h)) * HTB)
#define PG8_SB(b, h) ((4 + (b) * 2 + (h)) * HTB)
#define PG8_STAGE(bufoff, gbase, voff) do { _Pragma("unroll") for (int _i = 0; _i < 2; ++_i) \
        __builtin_amdgcn_global_load_lds((const unsigned*)((const char*)(gbase) + (voff)[_i]), (PG8_LAS unsigned*)(lds + (bufoff) + ldsw + _i * 8192), 16, 0, 0); } while (0)
#define PG8_LDA(dst, b, h) do { _Pragma("unroll") for (int m = 0; m < 4; ++m) _Pragma("unroll") for (int k = 0; k < 2; ++k) dst[m][k] = *(const PG8_LAS bf16x8*)(lds + PG8_SA(b, h) + aoff + m * 2048 + k * 1024); } while (0)
#define PG8_LDB(dst, b, h) do { _Pragma("unroll") for (int n = 0; n < 2; ++n) _Pragma("unroll") for (int k = 0; k < 2; ++k) dst[n][k] = *(const PG8_LAS bf16x8*)(lds + PG8_SB(b, h) + boff + n * 2048 + k * 1024); } while (0)
#define PG8_MMA(ai, bj, At, Bt) do { __builtin_amdgcn_s_setprio(1); _Pragma("unroll") for (int m = 0; m < 4; ++m) _Pragma("unroll") for (int n = 0; n < 2; ++n) _Pragma("unroll") for (int k = 0; k < 2; ++k) \
        acc[ai][bj][m][n] = __builtin_amdgcn_mfma_f32_16x16x32_bf16(Bt[n][k], At[m][k], acc[ai][bj][m][n], 0, 0, 0); __builtin_amdgcn_s_setprio(0); } while (0)
#define PG8_WAIT_V(n) asm volatile("s_waitcnt vmcnt(" #n ")" ::: "memory")
#define PG8_WAIT_L(n) asm volatile("s_waitcnt lgkmcnt(" #n ")" ::: "memory")
#define PG8_BAR __builtin_amdgcn_s_barrier()
#define PG8_SCHED __builtin_amdgcn_sched_barrier(0)
    Unit cur, nxt; int ui = 0;
    if (!S.next(0, cur)) return;
    f32x4 acc[2][2][4][2];
#pragma unroll
    for (int a = 0; a < 2; ++a)
#pragma unroll
        for (int b = 0; b < 2; ++b)
#pragma unroll
            for (int m = 0; m < 4; ++m)
#pragma unroll
                for (int n = 0; n < 2; ++n) acc[a][b][m][n] = (f32x4){0.f, 0.f, 0.f, 0.f};
    bf16x8 At[4][2], B0[2][2], B1[2][2];
    const char* cA = (const char*)g.A + (size_t)cur.pm * tstep; const char* cB = (const char*)g.Bt + (size_t)cur.pn * tstep;
    const size_t rotb = (size_t)g.rot * kstep;
    S.a_ready(cur);
    { const char* cA0 = cA; const char* cB0 = cB; cA += rotb; cB += rotb;
    if constexpr (SP2) {
        PG8_STAGE(PG8_SB(0, 0), cB, voffB); PG8_STAGE(PG8_SB(0, 1), cB + hstep, voffB); PG8_STAGE(PG8_SA(0, 0), cA, voffA); PG8_STAGE(PG8_SA(0, 1), cA + hstep, voffA);
        if (wr == 1) PG8_BAR;
        PG8_WAIT_V(2); PG8_BAR;
        PG8_STAGE(PG8_SB(1, 0), cB + kstep, voffB); PG8_STAGE(PG8_SA(1, 0), cA + kstep, voffA); PG8_STAGE(PG8_SB(1, 1), cB + hstep + kstep, voffB);
        PG8_WAIT_V(6); PG8_BAR;
    } else {
        PG8_STAGE(PG8_SB(0, 0), cB, voffB); PG8_STAGE(PG8_SA(0, 0), cA, voffA); PG8_STAGE(PG8_SB(0, 1), cB + hstep, voffB); PG8_STAGE(PG8_SA(0, 1), cA + hstep, voffA);
        if (wr == 1) PG8_BAR;
        PG8_WAIT_V(4); PG8_BAR;
        PG8_STAGE(PG8_SB(1, 0), cB + kstep, voffB); PG8_STAGE(PG8_SA(1, 0), cA + kstep, voffA); PG8_STAGE(PG8_SB(1, 1), cB + hstep + kstep, voffB);
        PG8_WAIT_V(6); PG8_BAR;
    }
    cA = cA0; cB = cB0; }
    for (;;) {
        const bool has_next = S.next(ui + 1, nxt);
        const char* nA = has_next ? (const char*)g.A + (size_t)nxt.pm * tstep : cA; const char* nB = has_next ? (const char*)g.Bt + (size_t)nxt.pn * tstep : cB;
        for (int t = 0; t < nt; t += 2) {
            const bool last = (t == nt - 2);
            int kc = t + g.rot; kc = kc >= nt ? kc - nt : kc; int kn = kc + 2; kn = kn >= nt ? kn - nt : kn;
            const char* a1 = cA + (size_t)(kc + 1) * kstep;
            const char* a2 = last ? nA + rotb : cA + (size_t)kn * kstep; const char* b2 = last ? nB + rotb : cB + (size_t)kn * kstep;
            const char* a3 = a2 + kstep; const char* b3 = b2 + kstep;
            if (last && has_next) S.a_ready(nxt);
            if constexpr (SP2) {
            PG8_LDB(B0, 0, 0); PG8_LDB(B1, 0, 1); PG8_SCHED; PG8_LDA(At, 0, 0); PG8_STAGE(PG8_SA(1, 1), a1 + hstep, voffA);
            PG8_WAIT_V(8); PG8_WAIT_L(0); PG8_BAR; PG8_MMA(0, 0, At, B0); PG8_MMA(0, 1, At, B1); PG8_BAR; PG8_SCHED;
            PG8_LDA(At, 0, 1); PG8_STAGE(PG8_SB(0, 0), b2, voffB); PG8_STAGE(PG8_SB(0, 1), b2 + hstep, voffB); PG8_STAGE(PG8_SA(0, 0), a2, voffA);
            PG8_WAIT_V(8); PG8_WAIT_L(0); PG8_BAR; PG8_MMA(1, 0, At, B0); PG8_MMA(1, 1, At, B1); PG8_BAR; PG8_SCHED;
            PG8_LDB(B0, 1, 0); PG8_LDB(B1, 1, 1); PG8_SCHED; PG8_LDA(At, 1, 0); PG8_STAGE(PG8_SA(0, 1), a2 + hstep, voffA);
            PG8_WAIT_V(8); PG8_WAIT_L(0); PG8_BAR; PG8_MMA(0, 0, At, B0); PG8_MMA(0, 1, At, B1); PG8_BAR; PG8_SCHED;
            PG8_LDA(At, 1, 1); PG8_STAGE(PG8_SB(1, 0), b3, voffB); PG8_STAGE(PG8_SB(1, 1), b3 + hstep, voffB); PG8_STAGE(PG8_SA(1, 0), a3, voffA);
            PG8_WAIT_V(8); PG8_WAIT_L(0); PG8_BAR; PG8_MMA(1, 0, At, B0); PG8_MMA(1, 1, At, B1); PG8_BAR; PG8_SCHED;
            } else {
            PG8_LDB(B0, 0, 0); PG8_SCHED; PG8_LDA(At, 0, 0); PG8_STAGE(PG8_SA(1, 1), a1 + hstep, voffA);
            PG8_WAIT_L(8); PG8_BAR; PG8_WAIT_L(0); PG8_MMA(0, 0, At, B0); PG8_BAR; PG8_SCHED;
            PG8_LDB(B1, 0, 1); PG8_STAGE(PG8_SB(0, 0), b2, voffB);
            PG8_BAR; PG8_WAIT_L(0); PG8_MMA(0, 1, At, B1); PG8_BAR;
            PG8_LDA(At, 0, 1); PG8_STAGE(PG8_SA(0, 0), a2, voffA);
            PG8_BAR; PG8_WAIT_L(0); PG8_MMA(1, 0, At, B0); PG8_BAR; PG8_SCHED;
            PG8_STAGE(PG8_SB(0, 1), b2 + hstep, voffB);
            PG8_WAIT_V(6); PG8_BAR; PG8_MMA(1, 1, At, B1); PG8_BAR;
            PG8_LDB(B0, 1, 0); PG8_SCHED; PG8_LDA(At, 1, 0); PG8_STAGE(PG8_SA(0, 1), a2 + hstep, voffA);
            PG8_WAIT_L(8); PG8_BAR; PG8_WAIT_L(0); PG8_MMA(0, 0, At, B0); PG8_BAR; PG8_SCHED;
            PG8_LDB(B1, 1, 1); PG8_STAGE(PG8_SB(1, 0), b3, voffB);
            PG8_BAR; PG8_WAIT_L(0); PG8_MMA(0, 1, At, B1); PG8_BAR;
            PG8_LDA(At, 1, 1); PG8_STAGE(PG8_SA(1, 0), a3, voffA);
            PG8_BAR; PG8_WAIT_L(0); PG8_MMA(1, 0, At, B0); PG8_BAR; PG8_SCHED;
            PG8_STAGE(PG8_SB(1, 1), b3 + hstep, voffB);
            PG8_WAIT_V(6); PG8_BAR; PG8_MMA(1, 1, At, B1); PG8_BAR;
            }
        }
        if constexpr (ALIGN_EPI) { if (wr == 0) PG8_BAR; }
        if constexpr (!Epi::AFTER_DRAIN) { E(acc, cur, wr, wc, fr, fq); S.done(cur); }
        if (!has_next) break;
#pragma unroll
        for (int a = 0; a < 2; ++a)
#pragma unroll
            for (int b = 0; b < 2; ++b)
#pragma unroll
                for (int m = 0; m < 4; ++m)
#pragma unroll
                    for (int n = 0; n < 2; ++n) acc[a][b][m][n] = (f32x4){0.f, 0.f, 0.f, 0.f};
        cur = nxt; cA = nA; cB = nB; ++ui;
        if constexpr (ALIGN_EPI) { if (wr == 1) PG8_BAR; }
    }
    PG8_WAIT_V(0);
    if constexpr (!ALIGN_EPI) { if (wr == 0) PG8_BAR; }
    PG8_BAR;
    if constexpr (Epi::AFTER_DRAIN) { E.fused(acc, cur, wr, wc, fr, fq, lds, wid, lane); S.done(cur); }
#undef PG8_SA
#undef PG8_SB
#undef PG8_STAGE
#undef PG8_LDA
#undef PG8_LDB
#undef PG8_MMA
#undef PG8_WAIT_V
#undef PG8_WAIT_L
#undef PG8_BAR
#undef PG8_SCHED
}
}

#ifndef PG8_SP2
#define PG8_SP2 true
#endif
#ifndef PG8_ALIGN
#define PG8_ALIGN true
#endif
#include <hip/hip_bf16.h>
#include <cmath>
namespace attn_body {
using bf16=__hip_bfloat16;
using bf16x8=__attribute__((ext_vector_type(8)))short;
using s16x4=__attribute__((ext_vector_type(4)))short;
using f32x16=__attribute__((ext_vector_type(16)))float;
using u32x4=__attribute__((ext_vector_type(4)))unsigned;
constexpr int SEQ=2048,D=64,DM=1024;
constexpr int NW=8,QBLK=32,QB=QBLK*NW,KVBLK=64,NQB=SEQ/QB;
constexpr int ATTN_PITCH=DM, ATTN_UNIT_ROWS=QB;
__device__ __forceinline__ int crow(int r,int hi){return (r&3)+8*(r>>2)+4*hi;}
#define SBAR() __builtin_amdgcn_sched_barrier(0)
__device__ __forceinline__ void cmask(f32x16&p0,f32x16&p1,int jb,int qrel,int hi){
  const float NEG=-INFINITY; int kb=64*jb+4*hi;
  #pragma unroll
  for(int r=0;r<16;++r){int kv=kb+(r&3)+8*(r>>2); if(kv>qrel)p0[r]=NEG; if(kv+32>qrel)p1[r]=NEG;}
}

constexpr int NSLOT=3, SLOTB=8192;
constexpr int LDS_K=0, LDS_V=NSLOT*SLOTB, LDS_WS=2*NSLOT*SLOTB, LDS_OST=LDS_WS+NW*64*4, LDS_BYTES=LDS_OST+NW*4096;
constexpr float C2=0.125f*1.4426950408889634f;
__device__ __forceinline__ void glds16(const void*gsrc,unsigned lds_dst){unsigned keep;
  asm volatile("s_mov_b32 %0, m0\n\ts_mov_b32 m0, %2\n\ts_nop 0\n\tglobal_load_lds_dwordx4 %1, off\n\ts_mov_b32 m0, %0":"=&s"(keep):"v"(gsrc),"s"(lds_dst):"memory");}
__device__ __forceinline__ float max3f(float a,float b,float c){float r;asm("v_max3_f32 %0, %1, %2, %3":"=v"(r):"v"(a),"v"(b),"v"(c));return r;}
__device__ __forceinline__ float max2f(float a,float b){float r;asm("v_max_f32_e32 %0, %1, %2":"=v"(r):"v"(a),"v"(b));return r;}
__device__ __forceinline__ float fadd_s(float a,float b){float r;asm("v_add_f32_e32 %0, %1, %2":"=v"(r):"v"(a),"v"(b));return r;}
__device__ __forceinline__ float fsub_s(float a,float b){float r;asm("v_sub_f32_e32 %0, %1, %2":"=v"(r):"v"(a),"v"(b));return r;}
typedef float f32x2_t __attribute__((ext_vector_type(2))); typedef __bf16 bf16x2_t __attribute__((ext_vector_type(2)));
__device__ __forceinline__ unsigned cvtpk_s(float lo,float hi){f32x2_t v={lo,hi};bf16x2_t b=__builtin_convertvector(v,bf16x2_t);return __builtin_bit_cast(unsigned,b);}
#define WAIT_BAR(N) asm volatile("s_waitcnt vmcnt(" #N ") lgkmcnt(0)\n\ts_barrier":::"memory")

__device__ __forceinline__ void qkt(f32x16&p0,f32x16&p1,const char*Kslot,const bf16x8*qr,const f32x16&negm,int r32,int hi){
  const char*kb=Kslot+hi*1024+r32*16;
  #pragma unroll
  for(int d0=0;d0<4;++d0){
    const bf16x8 b0=*reinterpret_cast<const bf16x8*>(kb+d0*2048);
    const bf16x8 b1=*reinterpret_cast<const bf16x8*>(kb+d0*2048+512);
    if(d0==0){p0=__builtin_amdgcn_mfma_f32_32x32x16_bf16(b0,qr[0],negm,0,0,0);p1=__builtin_amdgcn_mfma_f32_32x32x16_bf16(b1,qr[0],negm,0,0,0);}
    else{p0=__builtin_amdgcn_mfma_f32_32x32x16_bf16(b0,qr[d0],p0,0,0,0);p1=__builtin_amdgcn_mfma_f32_32x32x16_bf16(b1,qr[d0],p1,0,0,0);}}
}
typedef __attribute__((address_space(3))) const char* lds_cptr;
typedef short v4i16_t __attribute__((ext_vector_type(4)));
__device__ __forceinline__ void kload8(bf16x8*kf,lds_cptr kp){
  kf[0]=*(const __attribute__((address_space(3))) bf16x8*)(kp);      kf[1]=*(const __attribute__((address_space(3))) bf16x8*)(kp+512);
  kf[2]=*(const __attribute__((address_space(3))) bf16x8*)(kp+2048); kf[3]=*(const __attribute__((address_space(3))) bf16x8*)(kp+2560);
  kf[4]=*(const __attribute__((address_space(3))) bf16x8*)(kp+4096); kf[5]=*(const __attribute__((address_space(3))) bf16x8*)(kp+4608);
  kf[6]=*(const __attribute__((address_space(3))) bf16x8*)(kp+6144); kf[7]=*(const __attribute__((address_space(3))) bf16x8*)(kp+6656);
}
__device__ __forceinline__ void kload2(bf16x8*kf,lds_cptr kp,int j){ kf[2*j]=*(const __attribute__((address_space(3))) bf16x8*)(kp+j*2048); kf[2*j+1]=*(const __attribute__((address_space(3))) bf16x8*)(kp+j*2048+512); }
__device__ __forceinline__ s16x4 vtr(lds_cptr p){ return __builtin_bit_cast(s16x4,__builtin_amdgcn_ds_read_tr16_b64_v4i16((__attribute__((address_space(3))) v4i16_t*)p)); }
__device__ __forceinline__ float rowmax2(const f32x16&p0,const f32x16&p1,float k32){
  float a=max3f(p0[0],p0[1],p0[2]),b=max3f(p1[0],p1[1],p1[2]);
  #pragma unroll
  for(int r=3;r<15;r+=2){a=max3f(a,p0[r],p0[r+1]);b=max3f(b,p1[r],p1[r+1]);}
  a=max2f(a,p0[15]);b=max2f(b,p1[15]);
  const float m=max2f(a,fadd_s(b,k32));
  auto rr=__builtin_amdgcn_permlane32_swap(__float_as_uint(m),__float_as_uint(m),false,false);
  return max2f(__uint_as_float(rr[0]),__uint_as_float(rr[1]));
}
__device__ __forceinline__ float rowmax(const f32x16&p0,const f32x16&p1){
  float a=max3f(p0[0],p0[1],p1[0]),b=max3f(p0[2],p0[3],p1[1]);a=max3f(a,p1[2],p1[3]);
  #pragma unroll
  for(int r=4;r<16;r+=4){a=max3f(a,p0[r],p0[r+1]);b=max3f(b,p0[r+2],p0[r+3]);a=max3f(a,p1[r],p1[r+1]);b=max3f(b,p1[r+2],p1[r+3]);}
  const float m=max2f(a,b);
  auto rr=__builtin_amdgcn_permlane32_swap(__float_as_uint(m),__float_as_uint(m),false,false);
  return max2f(__uint_as_float(rr[0]),__uint_as_float(rr[1]));
}
__device__ __forceinline__ void pv(f32x16*o,int vb,bf16x8 pa0,bf16x8 pa1,bf16x8 pa2,bf16x8 pa3){
  #pragma unroll
  for(int d0=0;d0<2;++d0){s16x4 lo[4],hi[4];
    #pragma unroll
    for(int ks=0;ks<4;++ks){
      asm volatile("ds_read_b64_tr_b16 %0,%1 offset:%c2":"=&v"(lo[ks]):"v"(vb),"i"(d0*4096+ks*1024):"memory");
      asm volatile("ds_read_b64_tr_b16 %0,%1 offset:%c2":"=&v"(hi[ks]):"v"(vb),"i"(d0*4096+ks*1024+512):"memory");}
    asm volatile("s_waitcnt lgkmcnt(0)":::"memory");SBAR();
    #define PK(k) (bf16x8){lo[k][0],lo[k][1],lo[k][2],lo[k][3],hi[k][0],hi[k][1],hi[k][2],hi[k][3]}
    o[d0]=__builtin_amdgcn_mfma_f32_32x32x16_bf16(pa0,PK(0),o[d0],0,0,0);
    o[d0]=__builtin_amdgcn_mfma_f32_32x32x16_bf16(pa1,PK(1),o[d0],0,0,0);
    o[d0]=__builtin_amdgcn_mfma_f32_32x32x16_bf16(pa2,PK(2),o[d0],0,0,0);
    o[d0]=__builtin_amdgcn_mfma_f32_32x32x16_bf16(pa3,PK(3),o[d0],0,0,0);
    #undef PK
  }
}

#ifndef ATTN_STORE16
#define ATTN_STORE16(p,v) (*(u32x4*)(p)=(v))
#endif
template<int THRL> __device__ __forceinline__ void attn_unit(int b,int h,int qb,const bf16*Q,const bf16*__restrict__ K,const bf16*__restrict__ V,bf16*O,float sl2,char*shm,int tid_in){
  const int tid=tid_in,lane=tid&63,r32=lane&31,hi=lane>>5; const int wid=__builtin_amdgcn_readfirstlane(tid>>6);
  const long rowbase=(long)b*SEQ; const int q0=qb*QB;
  const bf16*Qw=Q+(rowbase+q0+wid*QBLK)*DM+h*D;
  const bf16*Kh=K+rowbase*DM+h*D,*Vh=V+rowbase*DM+h*D;
  const unsigned lds0=(unsigned)(uintptr_t)shm;
  float*wsf=(float*)(shm+LDS_WS)+wid*64;
  const bf16*ksrc=Kh+(long)lane*DM+wid*8;
  const bf16*vsrc=Vh+(long)(16*(wid&3)+(lane>>2))*DM+(wid>>2)*32+(lane&3)*8;
  const unsigned kdst=lds0+LDS_K+wid*1024, vdst=lds0+LDS_V+wid*1024;
  #define DMA_K(t,slot) glds16(ksrc+(long)(t)*KVBLK*DM,(unsigned)__builtin_amdgcn_readfirstlane(kdst+(slot)))
  #define DMA_V(t,slot) glds16(vsrc+(long)(t)*KVBLK*DM,(unsigned)__builtin_amdgcn_readfirstlane(vdst+(slot)))
  const int vb0=(int)(lds0+LDS_V)+((lane>>4)&1)*32+(lane&3)*8+(4*hi+((lane&15)>>2))*64;
  const char*Kbase=shm+LDS_K; bf16x8 kf[8];
  const lds_cptr shm3=(lds_cptr)shm; const lds_cptr kp0=shm3+LDS_K+hi*1024+r32*16; const lds_cptr vp0=shm3+LDS_V+((lane>>4)&1)*32+(lane&3)*8+(4*hi+((lane&15)>>2))*64;
  const int NT=(q0+QB)/KVBLK;
  DMA_K(0,0);DMA_V(0,0);DMA_K(1,SLOTB);
  bf16x8 qr[4];
  #pragma unroll
  for(int d0=0;d0<4;++d0)qr[d0]=*reinterpret_cast<const bf16x8*>(&Qw[(long)r32*DM+d0*16+hi*8]);
  float mhat=0.f,l_reg=0.f;f32x16 o[2];o[0]=f32x16{};o[1]=f32x16{};const float k32=32.f*sl2,k64=64.f*sl2; f32x16 negm; { const float lb=sl2*(float)(4*hi-(q0+wid*QBLK+r32)); _Pragma("unroll") for(int r=0;r<16;++r)negm[r]=sl2*(float)((r&3)+8*(r>>2))+lb; } asm volatile("":"+v"(negm));
  const int qrel=wid*QBLK+r32;
  #define CMASK(P0,P1,t) do{int jb_=(t)-(NT-4); if(jb_>=0)cmask(P0,P1,jb_,qrel,hi);}while(0)
  bool resc=false;
  #define START(P0,P1) do{ const float rm=rowmax2(P0,P1,k32); resc=false; \
    { const float dl=max2f(rm,0.f),dl1=fsub_s(dl,k32); mhat=fadd_s(mhat,dl); \
      _Pragma("unroll") for(int r=0;r<16;++r){P0[r]=fsub_s(P0[r],dl);P1[r]=fsub_s(P1[r],dl1);} \
      _Pragma("unroll") for(int r=0;r<16;++r)negm[r]=fadd_s(negm[r],fsub_s(k64,dl)); asm volatile("":"+v"(negm)); } \
    _Pragma("unroll") for(int r=0;r<16;++r)P0[r]=__builtin_amdgcn_exp2f(P0[r]); }while(0)
  #define RESC() do{ if(resc){ asm volatile("s_waitcnt lgkmcnt(0)":::"memory"); \
      _Pragma("unroll") for(int d_=0;d_<2;++d_) _Pragma("unroll") for(int r=0;r<16;++r)o[d_][r]*=wsf[crow(r,hi)]; } }while(0)
  f32x16 pA0,pA1,pB0,pB1;
  int sl_prev=0,sl_cur=0,sl_next=SLOTB;
  #define ROT() do{sl_prev=sl_cur;sl_cur=sl_next;sl_next=(sl_next==(NSLOT-1)*SLOTB)?0:sl_next+SLOTB;}while(0)
  DMA_K(2,2*SLOTB);
  WAIT_BAR(3);
  qkt(pA0,pA1,Kbase,qr,negm,r32,hi);asm volatile("s_nop 15\n\ts_nop 7":"+v"(pA0),"+v"(pA1));CMASK(pA0,pA1,0);
  START(pA0,pA1);
  _Pragma("unroll") for(int r=0;r<16;++r)pA1[r]=__builtin_amdgcn_exp2f(pA1[r]);
  WAIT_BAR(0);
  DMA_K(3,0);DMA_V(1,SLOTB);
  ROT();
  kload8(kf,kp0+sl_cur);
  WAIT_BAR(2);
  s16x4 vlo[8],vhi[8]; u32x4 pw0,pw1,pw2,pw3;
  #define PKW(P,B) cvtpk_s(P[B],P[B+1])
  #define PAF(k) __builtin_bit_cast(bf16x8,pw##k)
  #define VFR(i) (bf16x8){vlo[i][0],vlo[i][1],vlo[i][2],vlo[i][3],vhi[i][0],vhi[i][1],vhi[i][2],vhi[i][3]}
  #define PIN(x) asm volatile("":"+v"(x))
  #define MX3(a,b,c) __builtin_fmaxf(__builtin_fmaxf((a),(b)),(c))
  #define GAPA(MF,A0,A1,A2,A3,W0,W1,PW) do{ MF; sacc+=A0; sacc+=A1; sacc+=A2; sacc+=A3; PIN(sacc); W0; W1; PIN(PW); SBAR(); }while(0)
  #define EX(v) __builtin_amdgcn_exp2f(v)
  #define GAPB(MF,X,B) do{ MF; X[B]=EX(X[B]); X[B+1]=EX(X[B+1]); X[B+2]=EX(X[B+2]); X[B+3]=EX(X[B+3]); PIN(X); SBAR(); }while(0)
  #define GAPB1(MF,X,B) do{ MF; X[B]=EX(X[B]+k32); X[B+1]=EX(X[B+1]+k32); X[B+2]=EX(X[B+2]+k32); X[B+3]=EX(X[B+3]+k32); PIN(X); SBAR(); }while(0)
  #define VRD(i) do{ vlo[i]=vtr(vp_+(((i)>>2)*4096+((i)&3)*1024)); vhi[i]=vtr(vp_+(((i)>>2)*4096+((i)&3)*1024+512)); }while(0)
  #define KRD(G,j) do{ if(G){ kload2(kf,kp0+sl_next,j); SBAR(); } }while(0)
  #define STEP(C0,C1,P0,P1,t,GK,GV,GL) do{ SBAR(); \
    const lds_cptr vp_=vp0+sl_prev; \
    VRD(0); SBAR(); float sacc=(P0[0]+P0[1]); \
    GAPA(C0=__builtin_amdgcn_mfma_f32_32x32x16_bf16(kf[0],qr[0],negm,0,0,0), P0[2],P0[3],P0[4],P0[5],     pw0[0]=PKW(P0,0), pw0[1]=PKW(P0,2), pw0); \
    VRD(4); SBAR(); GAPA(C1=__builtin_amdgcn_mfma_f32_32x32x16_bf16(kf[1],qr[0],negm,0,0,0), P0[6],P0[7],P0[8],P0[9],     pw0[2]=PKW(P0,4), pw0[3]=PKW(P0,6), pw0); \
    VRD(1); SBAR(); GAPA(C0=__builtin_amdgcn_mfma_f32_32x32x16_bf16(kf[2],qr[1],C0,0,0,0),   P0[10],P0[11],P0[12],P0[13], pw1[0]=PKW(P0,8), pw1[1]=PKW(P0,10), pw1); \
    VRD(5); SBAR(); GAPA(C1=__builtin_amdgcn_mfma_f32_32x32x16_bf16(kf[3],qr[1],C1,0,0,0),   P0[14],P0[15],P1[0],P1[1],   pw1[2]=PKW(P0,12),pw1[3]=PKW(P0,14), pw1); \
    VRD(2); SBAR(); GAPA(C0=__builtin_amdgcn_mfma_f32_32x32x16_bf16(kf[4],qr[2],C0,0,0,0),   P1[2],P1[3],P1[4],P1[5],     pw2[0]=PKW(P1,0), pw2[1]=PKW(P1,2), pw2); \
    VRD(6); SBAR(); GAPA(C1=__builtin_amdgcn_mfma_f32_32x32x16_bf16(kf[5],qr[2],C1,0,0,0),   P1[6],P1[7],P1[8],P1[9],     pw2[2]=PKW(P1,4), pw2[3]=PKW(P1,6), pw2); \
    VRD(3); SBAR(); GAPA(C0=__builtin_amdgcn_mfma_f32_32x32x16_bf16(kf[6],qr[3],C0,0,0,0),   P1[10],P1[11],P1[12],P1[13], pw3[0]=PKW(P1,8), pw3[1]=PKW(P1,10), pw3); \
    VRD(7); SBAR(); GAPA(C1=__builtin_amdgcn_mfma_f32_32x32x16_bf16(kf[7],qr[3],C1,0,0,0),   P1[14],P1[15],0.f,0.f,       pw3[2]=PKW(P1,12),pw3[3]=PKW(P1,14), pw3); \
    l_reg+=sacc; \
    if(GK){DMA_K((t)+3,sl_cur);} if(GV){DMA_V((t)+1,sl_next);} \
    CMASK(C0,C1,t); \
    { float a=MX3(C0[0],C0[1],C0[2]),b=MX3(C1[0],C1[1],C1[2]); \
      _Pragma("unroll") for(int r=3;r<15;r+=2){a=MX3(a,C0[r],C0[r+1]);b=MX3(b,C1[r],C1[r+1]);} \
      a=__builtin_fmaxf(a,C0[15]); b=__builtin_fmaxf(b,C1[15]); \
      float rm=__builtin_fmaxf(a,b+k32); { auto rr=__builtin_amdgcn_permlane32_swap(__float_as_uint(rm),__float_as_uint(rm),false,false); rm=__builtin_fmaxf(__uint_as_float(rr[0]),__uint_as_float(rr[1])); } \
      resc=false; float tadv=k64; \
      if(__builtin_expect(__any(rm>(float)THRL),0)){ const float dl=__builtin_fmaxf(rm,0.f); mhat+=dl; tadv=k64-dl; \
        _Pragma("unroll") for(int r=0;r<16;++r){C0[r]-=dl;C1[r]-=dl;} \
        const float f=__builtin_amdgcn_exp2f(-dl); l_reg*=f; if(hi==0)wsf[r32]=f; resc=true; } \
      _Pragma("unroll") for(int r=0;r<16;++r)negm[r]+=tadv; asm volatile("":"+v"(negm)); } \
    SBAR(); \
    GAPB(o[0]=__builtin_amdgcn_mfma_f32_32x32x16_bf16(PAF(0),VFR(0),o[0],0,0,0), C0,0); \
    GAPB(o[1]=__builtin_amdgcn_mfma_f32_32x32x16_bf16(PAF(0),VFR(4),o[1],0,0,0), C0,4); \
    KRD(GL,0); GAPB(o[0]=__builtin_amdgcn_mfma_f32_32x32x16_bf16(PAF(1),VFR(1),o[0],0,0,0), C0,8); \
    KRD(GL,1); GAPB(o[1]=__builtin_amdgcn_mfma_f32_32x32x16_bf16(PAF(1),VFR(5),o[1],0,0,0), C0,12); \
    KRD(GL,2); GAPB1(o[0]=__builtin_amdgcn_mfma_f32_32x32x16_bf16(PAF(2),VFR(2),o[0],0,0,0), C1,0); \
    KRD(GL,3); GAPB1(o[1]=__builtin_amdgcn_mfma_f32_32x32x16_bf16(PAF(2),VFR(6),o[1],0,0,0), C1,4); \
    GAPB1(o[0]=__builtin_amdgcn_mfma_f32_32x32x16_bf16(PAF(3),VFR(3),o[0],0,0,0), C1,8); \
    GAPB1(o[1]=__builtin_amdgcn_mfma_f32_32x32x16_bf16(PAF(3),VFR(7),o[1],0,0,0), C1,12); \
    }while(0)
  int t=1;
  #undef CMASK
  #define CMASK(P0,P1,t) do{}while(0)
  for(;t+5<NT;t+=2){
    STEP(pB0,pB1,pA0,pA1,t,true,true,true);     WAIT_BAR(2); RESC(); ROT();
    STEP(pA0,pA1,pB0,pB1,t+1,true,true,true);   WAIT_BAR(2); RESC(); ROT();
  }
  #undef CMASK
  #define CMASK(P0,P1,t) do{int jb_=(t)-(NT-4); if(jb_>=0)cmask(P0,P1,jb_,qrel,hi);}while(0)
  #define ENDW(tt) do{ if((tt)+3<NT){WAIT_BAR(2);} else if((tt)+2<NT){WAIT_BAR(1);} else {WAIT_BAR(0);} }while(0)
  for(;t+1<NT;t+=2){
    STEP(pB0,pB1,pA0,pA1,t,(t+3<NT),(t+1<NT),(t+1<NT));       ENDW(t);   RESC(); ROT();
    STEP(pA0,pA1,pB0,pB1,t+1,(t+4<NT),(t+2<NT),(t+2<NT));     ENDW(t+1); RESC(); ROT();
  }
  STEP(pB0,pB1,pA0,pA1,NT-1,false,false,false); RESC();
  { float sacc=pB0[0]+pB0[1]; _Pragma("unroll") for(int r=2;r<16;++r)sacc+=pB0[r]; _Pragma("unroll") for(int r=0;r<16;++r)sacc+=pB1[r]; l_reg+=sacc;
    pw0=(u32x4){PKW(pB0,0),PKW(pB0,2),PKW(pB0,4),PKW(pB0,6)};pw1=(u32x4){PKW(pB0,8),PKW(pB0,10),PKW(pB0,12),PKW(pB0,14)};pw2=(u32x4){PKW(pB1,0),PKW(pB1,2),PKW(pB1,4),PKW(pB1,6)};pw3=(u32x4){PKW(pB1,8),PKW(pB1,10),PKW(pB1,12),PKW(pB1,14)};
    SBAR(); pv(o,vb0+sl_cur,PAF(0),PAF(1),PAF(2),PAF(3)); }
  #undef PKW
  #undef PAF
  #undef VFR
  #undef PIN
  #undef MX3
  #undef GAPA
  #undef GAPB
  #undef GAPB1
  #undef EX
  #undef VRD
  #undef KRD
  #undef STEP
  #undef ENDW
  {auto rr=__builtin_amdgcn_permlane32_swap(__float_as_uint(l_reg),__float_as_uint(l_reg),false,false);l_reg=__uint_as_float(rr[0])+__uint_as_float(rr[1]);}
  if(hi==0)wsf[32+r32]=l_reg;asm volatile("s_waitcnt lgkmcnt(0)":::"memory");
  float rli[16];
  #pragma unroll
  for(int r=0;r<16;++r)rli[r]=__builtin_amdgcn_rcpf(wsf[32+crow(r,hi)]);
  bf16*Ow=O+(rowbase+q0+wid*QBLK)*DM+h*D;
  { bf16*stg=(bf16*)(shm+LDS_OST)+wid*2048;
    #pragma unroll
    for(int r=0;r<16;++r){const int orow=crow(r,hi);
      #pragma unroll
      for(int d0=0;d0<2;++d0)stg[orow*64+d0*32+r32]=__float2bfloat16(o[d0][r]*rli[r]);}
    asm volatile("s_waitcnt lgkmcnt(0)":::"memory");
    #pragma unroll
    for(int i=0;i<4;++i){const int row=i*8+(lane>>3),ch=lane&7; const u32x4 v=*(const u32x4*)(stg+row*64+ch*8); ATTN_STORE16(Ow+(long)row*DM+ch*8,v);} }
  asm volatile("s_waitcnt lgkmcnt(0)\n\ts_barrier":::"memory");
  #undef DMA_K
  #undef DMA_V
  #undef CMASK
  #undef START
  #undef RESC
  #undef ROT
}
constexpr int ATTN_LDS_BYTES=LDS_BYTES;
#undef SBAR
#undef WAIT_BAR
}
#define GAS __attribute__((address_space(1)))
#define LAS __attribute__((address_space(3)))
typedef unsigned short bf16;
typedef unsigned v4u __attribute__((ext_vector_type(4)));
typedef float f32x4 __attribute__((ext_vector_type(4)));
typedef short bf16x8 __attribute__((ext_vector_type(8)));
typedef GAS unsigned gu32;
typedef GAS unsigned long long gu64;
#define RLX_AGENT __ATOMIC_RELAXED, __HIP_MEMORY_SCOPE_AGENT
#define LDS_WAIT() asm volatile("s_waitcnt lgkmcnt(0)" ::: "memory")
#define VM_WAIT() asm volatile("s_waitcnt vmcnt(0)" ::: "memory")
__device__ __forceinline__ unsigned long long rt() { return __builtin_amdgcn_s_memrealtime(); }
typedef float hw_f32x2 __attribute__((ext_vector_type(2))); typedef __bf16 hw_bf16x2 __attribute__((ext_vector_type(2)));
__device__ __forceinline__ unsigned pk2(float lo, float hi) { const hw_f32x2 v = {lo, hi}; return __builtin_bit_cast(unsigned, __builtin_convertvector(v, hw_bf16x2)); }
__device__ __forceinline__ unsigned f2bf(float f) { return pk2(f, 0.f) & 0xffffu; }

#define XB_TMO      128
#define XB_XCNT(j)  (256  + 64 * (j))
#define XB_XSUB(j)  (1280 + 64 * (j))
#define XB_XGEN(j)  (2304 + 64 * (j))
#define XB_TOP      3328
#define XB_TOPGEN   3392
#define XCD_BAR_WORDS 3456
#define XB_SPIN_CAP (1u << 18)

__device__ __forceinline__ unsigned xb_ld(unsigned* p)              { return __hip_atomic_load(p, __ATOMIC_RELAXED, __HIP_MEMORY_SCOPE_AGENT); }
__device__ __forceinline__ unsigned xb_add(unsigned* p, unsigned v) { return __hip_atomic_fetch_add(p, v, __ATOMIC_RELAXED, __HIP_MEMORY_SCOPE_AGENT); }
__device__ __forceinline__ unsigned xb_xcc_id() { return (unsigned)__builtin_amdgcn_s_getreg((3 << 11) | 20) & 0xFu; }
#define XB_SPIN(cond, bar) do { unsigned _sp = 0; while (cond) { __builtin_amdgcn_s_sleep(1); \
    if ((++_sp & 255u) == 0u) { if (xb_ld(&(bar)[XB_TMO])) break; if (_sp > XB_SPIN_CAP) { atomicAdd(&(bar)[XB_TMO], 1u); break; } } } } while (0)

struct XcdBarrier {
    unsigned* bar; unsigned x;
    volatile LAS unsigned* st;
};

__device__ __forceinline__ XcdBarrier xcd_barrier_post(unsigned* bar, volatile LAS unsigned* st, bool leader) {
    XcdBarrier b; b.bar = bar; b.x = xb_xcc_id(); b.st = st;
    if (leader) (void)xb_add(&bar[XB_XCNT(b.x)], 1u);
    return b;
}
__device__ __forceinline__ void xcd_barrier_complete(unsigned* bar, unsigned x, unsigned& nloc, unsigned& nx) {
    const unsigned G = gridDim.x * gridDim.y * gridDim.z;
    unsigned sum, cnt, mine, sp = 0u;
    for (;;) {
        sum = 0u; cnt = 0u; mine = 0u;
#pragma unroll
        for (unsigned j = 0; j < 16; ++j) { const unsigned c = xb_ld(&bar[XB_XCNT(j)]); sum += c; cnt += (c > 0u) ? 1u : 0u; mine = (j == x) ? c : mine; }
        if (sum == G) break;
        __builtin_amdgcn_s_sleep(1);
        if ((++sp & 255u) == 0u) { if (xb_ld(&bar[XB_TMO])) break; if (sp > XB_SPIN_CAP) { atomicAdd(&bar[XB_TMO], 1u); break; } }
    }
    nloc = mine > 0u ? mine : 1u; nx = cnt > 0u ? cnt : 1u;
}

__device__ __forceinline__ void xcd_barrier(const XcdBarrier& b, bool leader) {
    asm volatile("s_waitcnt vmcnt(0)" ::: "memory");
    __syncthreads();
    if (leader) {
        unsigned* bar = b.bar;
        __builtin_amdgcn_s_waitcnt(0);
        unsigned nloc = b.st[0], nx = b.st[1];
        if (nloc == 0u) { xcd_barrier_complete(bar, b.x, nloc, nx); b.st[0] = nloc; b.st[1] = nx; }
        const unsigned old = xb_add(&bar[XB_XSUB(b.x)], 1u);
        const unsigned gen = old / nloc;
        if (old + 1u == (gen + 1u) * nloc) {
            __builtin_amdgcn_fence(__ATOMIC_RELEASE, "agent");
            asm volatile("s_waitcnt vmcnt(0)" ::: "memory");
            const unsigned og = xb_add(&bar[XB_TOP], 1u);
            const unsigned tg = og / nx;
            if (og + 1u == (tg + 1u) * nx) xb_add(&bar[XB_TOPGEN], 1u);
            else XB_SPIN(xb_ld(&bar[XB_TOPGEN]) == tg, bar);
            __builtin_amdgcn_fence(__ATOMIC_ACQUIRE, "agent");
            xb_add(&bar[XB_XGEN(b.x)], 1u);
            asm volatile("s_waitcnt vmcnt(0)" ::: "memory");
        } else {
            XB_SPIN(xb_ld(&bar[XB_XGEN(b.x)]) == gen, bar);
            __builtin_amdgcn_fence(__ATOMIC_ACQUIRE, "agent");
            asm volatile("s_waitcnt vmcnt(0)" ::: "memory");
        }
    }
    __syncthreads();
}
constexpr int DM = 2048, SEQ = 2048, NBP = 4, MP = NBP * SEQ, NBS = 8, TS = 8, MS = NBS * TS, M_ALL = MP + MS, M_PAD = 8448;
constexpr int PAST = 16384, PAGE = 128, NPAGES = PAST / PAGE;
constexpr int NH = 8, HD = 128;
constexpr int CONVD = 3072, INW = 7184, INW_PAD = 7424, FF = 5632, GU = 2 * FF;
constexpr int C_K = 1024, C_V = 2048, C_QKVB = 3072, C_Z = 6144, C_B = 7168, C_A = 7176;
constexpr float EPS = 1e-6f, LOG2E = 1.4426950408889634f, C2 = 0.125f * LOG2E;
constexpr int NWAVES = 8, NTHREADS = NWAVES * 64;
constexpr int PGU = 4, NSPLIT = NPAGES / PGU, NSP = NSPLIT + 1;
constexpr int NCHUNK_P = NBP * NH * (SEQ / 64), NCHUNK = NCHUNK_P + NBS * NH;
constexpr size_t OUT_Y = 0, OUT_KP = (size_t)M_ALL * DM, OUT_VP = OUT_KP + (size_t)MP * 1024, OUT_SSMP = OUT_VP + (size_t)MP * 1024,
                 OUT_CONVP = OUT_SSMP + (size_t)NBP * NH * 16384, OUT_KS = OUT_CONVP + (size_t)NBP * 3 * CONVD, OUT_VS = OUT_KS + (size_t)MS * 1024,
                 OUT_SSMS = OUT_VS + (size_t)MS * 1024, OUT_CONVS = OUT_SSMS + (size_t)NBS * NH * 16384, OUT_END = OUT_CONVS + (size_t)NBS * 3 * CONVD;
constexpr size_t MiB = 1u << 20;
constexpr size_t WS_CTL = 0, CTL_ZERO_BYTES = 1 * MiB;
constexpr size_t WS_W1GU = 16 * MiB, WS_W1D = 60 * MiB, WS_WIN = 82 * MiB, WS_WOUT = 111 * MiB, WS_W2GU = 119 * MiB, WS_W2D = 163 * MiB;
constexpr size_t WS_XN = 192 * MiB, WS_ACT = 226 * MiB, WS_F = 320 * MiB, WS_X1 = 388 * MiB, WS_X2 = 456 * MiB, WS_C1 = 528 * MiB, WS_H = 896 * MiB;
constexpr size_t WS_QKVB = 896 * MiB, WS_Z = 946 * MiB, WS_BA = 963 * MiB, WS_HS = 964 * MiB;
constexpr size_t WS_QB = 1136 * MiB, WS_KB = 1153 * MiB, WS_VB = 1170 * MiB;
constexpr size_t WS_UT = 1322 * MiB, WS_WC = 1356 * MiB, WS_QG = 1373 * MiB, WS_KDT = 1390 * MiB, WS_QKC = 1407 * MiB, WS_EGL = 1416 * MiB, WS_OG = 1424 * MiB, WS_O1 = 1458 * MiB, WS_O2 = 1491 * MiB, WS_MIX = 1526 * MiB, WS_PM = 1560 * MiB, WS_PL = 1561 * MiB, WS_PO = 1562 * MiB, WS_END = 1600 * MiB;
static_assert(WS_QKVB + (size_t)M_ALL * CONVD * 2 <= WS_Z && WS_Z + (size_t)M_ALL * 1024 * 2 <= WS_BA && WS_BA + (size_t)M_ALL * 16 * 4 <= WS_HS && WS_HS + (size_t)MS * INW_PAD * 4 <= WS_QB, "d_ws map 2");
static_assert(WS_W1GU + (size_t)GU * DM * 2 <= WS_W1D && WS_W1D + (size_t)DM * FF * 2 <= WS_WIN && WS_WIN + (size_t)INW_PAD * DM * 2 <= WS_WOUT && WS_WOUT + (size_t)DM * DM * 2 <= WS_W2GU &&
              WS_W2GU + (size_t)GU * DM * 2 <= WS_W2D && WS_W2D + (size_t)DM * FF * 2 <= WS_XN && WS_XN + (size_t)M_PAD * DM * 2 <= WS_ACT && WS_ACT + (size_t)M_PAD * FF * 2 <= WS_F &&
              WS_F + (size_t)M_PAD * DM * 4 <= WS_X1 && WS_X1 + (size_t)M_ALL * DM * 4 <= WS_X2 && WS_X2 + (size_t)M_ALL * DM * 4 <= WS_C1 && WS_C1 + (size_t)M_PAD * GU * 4 <= WS_H &&
              WS_H + (size_t)M_PAD * INW_PAD * 4 <= WS_QB && WS_QB + (size_t)M_PAD * 1024 * 2 <= WS_KB && WS_VB + (size_t)M_PAD * 1024 * 2 <= WS_UT && WS_UT + (size_t)NCHUNK * 8192 * 4 <= WS_WC && WS_WC + (size_t)NCHUNK * 8192 * 2 <= WS_QG && WS_QG + (size_t)NCHUNK * 8192 * 2 <= WS_KDT &&
              WS_KDT + (size_t)NCHUNK * 8192 * 2 <= WS_QKC && WS_QKC + (size_t)NCHUNK * 4096 * 2 <= WS_EGL && WS_EGL + (size_t)NCHUNK * 4 <= WS_OG && WS_OG + (size_t)M_ALL * 1024 * 4 <= WS_O1 && WS_O1 + (size_t)M_ALL * 1024 * 4 <= WS_O2 && WS_O2 + (size_t)M_ALL * 1024 * 4 <= WS_MIX &&
              WS_MIX + (size_t)M_PAD * DM * 2 <= WS_PM && WS_PO + (size_t)NBS * NH * NSP * 16 * 128 * 4 <= WS_END, "d_ws map");
constexpr int CW_QCTR = 64;
constexpr int CW_BAR = 4096;
constexpr int RING_OFF = 0, RING_BYTES = 131072, LDSCTL_OFF = RING_BYTES, LDS_BYTES = 147456, MISC_OFF = LDS_BYTES - 256;

#ifndef NT_WSTORE
#define NT_WSTORE 0
#endif
#ifndef CONV_NFAST
#define CONV_NFAST 1
#endif
#ifndef THIN_PIPE
#define THIN_PIPE 0
#endif
#ifndef CONV_PIPE
#define CONV_PIPE 1
#endif
#ifndef NT_OUT
#define NT_OUT 0
#endif
#ifndef CONV_TAILS
#define CONV_TAILS 0
#endif
#ifndef REP_PRO
#define REP_PRO 1
#endif
#ifndef REP_PREP
#define REP_PREP 1
#endif
#ifndef REP_SCAN
#define REP_SCAN 1
#endif
#ifndef REP_SATT
#define REP_SATT 1
#endif
#ifndef REP_FLASH
#define REP_FLASH 1
#endif
#ifndef REP_THIN
#define REP_THIN 1
#endif
#ifndef REP_G1
#define REP_G1 1
#endif
#ifndef MK_N_LAUNCHES
#define MK_N_LAUNCHES 1
#endif
constexpr int NPHASE = 13;

struct Args { const void* in[30]; float* out; unsigned char* ws; int ph_lo, ph_hi; };
struct Frame {
    const Args& A;
    LAS unsigned char* lds; volatile LAS unsigned* MISC; gu32* ctl; char* lds_g;
    int tid, lane, wave, G, gw, NGW, z; unsigned char* ws;
    __device__ __forceinline__ Frame(const Args& a) : A(a) {}
    __device__ __forceinline__ const float* xp() const { return (const float*)A.in[0 + z]; }
    __device__ __forceinline__ const float* xs() const { return (const float*)A.in[1 + z]; }
    __device__ __forceinline__ const float* cache_k() const { return (const float*)A.in[2 + z]; }
    __device__ __forceinline__ const float* cache_v() const { return (const float*)A.in[3 + z]; }
    __device__ __forceinline__ const float* state_ssm() const { return (const float*)A.in[4 + z]; }
    __device__ __forceinline__ const float* state_conv() const { return (const float*)A.in[5 + z]; }
    __device__ __forceinline__ const int* page_table() const { return (const int*)A.in[6 + z]; }
    __device__ __forceinline__ const float* ffn1_pre() const { return (const float*)A.in[7 + z]; }
    __device__ __forceinline__ const float* ffn1_post() const { return (const float*)A.in[8 + z]; }
    __device__ __forceinline__ const float* gate1() const { return (const float*)A.in[9 + z]; }
    __device__ __forceinline__ const float* up1() const { return (const float*)A.in[10 + z]; }
    __device__ __forceinline__ const float* down1() const { return (const float*)A.in[11 + z]; }
    __device__ __forceinline__ const float* mix_pre() const { return (const float*)A.in[12 + z]; }
    __device__ __forceinline__ const float* mix_post() const { return (const float*)A.in[13 + z]; }
    __device__ __forceinline__ const float* w_in() const { return (const float*)A.in[14 + z]; }
    __device__ __forceinline__ const float* conv_w() const { return (const float*)A.in[15 + z]; }
    __device__ __forceinline__ const float* a_log() const { return (const float*)A.in[16 + z]; }
    __device__ __forceinline__ const float* dt_bias() const { return (const float*)A.in[17 + z]; }
    __device__ __forceinline__ const float* dnorm_w() const { return (const float*)A.in[18 + z]; }
    __device__ __forceinline__ const float* lq1() const { return (const float*)A.in[19 + z]; }
    __device__ __forceinline__ const float* lk1() const { return (const float*)A.in[20 + z]; }
    __device__ __forceinline__ const float* lq2() const { return (const float*)A.in[21 + z]; }
    __device__ __forceinline__ const float* lk2() const { return (const float*)A.in[22 + z]; }
    __device__ __forceinline__ const float* subln_w() const { return (const float*)A.in[23 + z]; }
    __device__ __forceinline__ const float* w_out() const { return (const float*)A.in[24 + z]; }
    __device__ __forceinline__ const float* ffn2_pre() const { return (const float*)A.in[25 + z]; }
    __device__ __forceinline__ const float* ffn2_post() const { return (const float*)A.in[26 + z]; }
    __device__ __forceinline__ const float* gate2() const { return (const float*)A.in[27 + z]; }
    __device__ __forceinline__ const float* up2() const { return (const float*)A.in[28 + z]; }
    __device__ __forceinline__ const float* down2() const { return (const float*)A.in[29 + z]; }
    __device__ __forceinline__ float* out() const { return A.out; }
    __device__ __forceinline__ bf16* F16() const { return (bf16*)(ws + WS_C1); }
    __device__ __forceinline__ bf16* X1h() const { return (bf16*)(ws + WS_X1); }
    __device__ __forceinline__ bf16* X2h() const { return (bf16*)(ws + WS_X2); }
    __device__ __forceinline__ bf16* QKVB() const { return (bf16*)(ws + WS_QKVB); }
    __device__ __forceinline__ bf16* Zb() const { return (bf16*)(ws + WS_Z); }
    __device__ __forceinline__ float* BA() const { return (float*)(ws + WS_BA); }
    __device__ __forceinline__ float* HS() const { return (float*)(ws + WS_HS); }
    __device__ __forceinline__ float* PM() const { return (float*)(ws + WS_PM); }
    __device__ __forceinline__ float* PL() const { return (float*)(ws + WS_PL); }
    __device__ __forceinline__ float* PO() const { return (float*)(ws + WS_PO); }
    __device__ __forceinline__ bf16* W1GU() const { return (bf16*)(ws + WS_W1GU); }
    __device__ __forceinline__ bf16* W1D() const { return (bf16*)(ws + WS_W1D); }
    __device__ __forceinline__ bf16* WIN() const { return (bf16*)(ws + WS_WIN); }
    __device__ __forceinline__ bf16* WOUT() const { return (bf16*)(ws + WS_WOUT); }
    __device__ __forceinline__ bf16* W2GU() const { return (bf16*)(ws + WS_W2GU); }
    __device__ __forceinline__ bf16* W2D() const { return (bf16*)(ws + WS_W2D); }
    __device__ __forceinline__ bf16* X0h() const { return (bf16*)(ws + WS_XN); }
    __device__ __forceinline__ float* RS() const { return (float*)(ws + WS_CTL + 512 * 1024); }
    __device__ __forceinline__ bf16* ACT() const { return (bf16*)(ws + WS_ACT); }
    __device__ __forceinline__ bf16* QB() const { return (bf16*)(ws + WS_QB); }
    __device__ __forceinline__ bf16* KB() const { return (bf16*)(ws + WS_KB); }
    __device__ __forceinline__ bf16* VB() const { return (bf16*)(ws + WS_VB); }
    __device__ __forceinline__ bf16* MIX() const { return (bf16*)(ws + WS_MIX); }
    __device__ __forceinline__ bf16* O1b() const { return (bf16*)(ws + WS_O1); }
    __device__ __forceinline__ bf16* O2b() const { return (bf16*)(ws + WS_O2); }
    __device__ __forceinline__ bf16* WC() const { return (bf16*)(ws + WS_WC); }
    __device__ __forceinline__ bf16* QGc() const { return (bf16*)(ws + WS_QG); }
    __device__ __forceinline__ bf16* KDTc() const { return (bf16*)(ws + WS_KDT); }
    __device__ __forceinline__ bf16* QKc() const { return (bf16*)(ws + WS_QKC); }
    __device__ __forceinline__ float* Fb() const { return (float*)(ws + WS_F); }
    __device__ __forceinline__ float* X1() const { return (float*)(ws + WS_X1); }
    __device__ __forceinline__ float* X2() const { return (float*)(ws + WS_X2); }
    __device__ __forceinline__ float* C1() const { return (float*)(ws + WS_C1); }
    __device__ __forceinline__ float* H() const { return (float*)(ws + WS_H); }
    __device__ __forceinline__ float* UT() const { return (float*)(ws + WS_UT); }
    __device__ __forceinline__ float* EGL() const { return (float*)(ws + WS_EGL); }
    __device__ __forceinline__ bf16* OG() const { return (bf16*)(ws + WS_OG); }
};

#define LDS_BARRIER() asm volatile("s_waitcnt lgkmcnt(0)\n\ts_barrier" ::: "memory")
__device__ __forceinline__ int lane_id() { int r; asm volatile("v_mbcnt_lo_u32_b32 %0, -1, 0\n\tv_mbcnt_hi_u32_b32 %0, -1, %0" : "=v"(r)); return r; }
template <int X> __device__ __forceinline__ float xor_lane(float v) {
    if (X < 32) return __int_as_float(__builtin_amdgcn_ds_swizzle(__float_as_int(v), (X << 10) | 0x1f));
    else { auto rr = __builtin_amdgcn_permlane32_swap(__float_as_uint(v), __float_as_uint(v), false, false); return __uint_as_float(rr[0]) == v ? __uint_as_float(rr[1]) : __uint_as_float(rr[0]); }
}
__device__ __forceinline__ float xor32_sum(float v) { auto rr = __builtin_amdgcn_permlane32_swap(__float_as_uint(v), __float_as_uint(v), false, false); return __uint_as_float(rr[0]) + __uint_as_float(rr[1]); }
__device__ __forceinline__ float xor32_max(float v) { auto rr = __builtin_amdgcn_permlane32_swap(__float_as_uint(v), __float_as_uint(v), false, false); return fmaxf(__uint_as_float(rr[0]), __uint_as_float(rr[1])); }
__device__ __forceinline__ float sum16(float v) { v += xor_lane<1>(v); v += xor_lane<2>(v); v += xor_lane<4>(v); v += xor_lane<8>(v); return v; }
__device__ __forceinline__ float max16(float v) { v = fmaxf(v, xor_lane<1>(v)); v = fmaxf(v, xor_lane<2>(v)); v = fmaxf(v, xor_lane<4>(v)); v = fmaxf(v, xor_lane<8>(v)); return v; }
__device__ __forceinline__ float wave_sum(float v) { v = sum16(v); v += xor_lane<16>(v); return xor32_sum(v); }
__device__ __forceinline__ float wave_max(float v) { v = max16(v); v = fmaxf(v, xor_lane<16>(v)); return xor32_max(v); }
__device__ __forceinline__ float bf2f(unsigned short b) { return __uint_as_float(((unsigned)b) << 16); }
__device__ __forceinline__ float silu_f(float x) { return x * __builtin_amdgcn_rcpf(1.f + __expf(-x)); }
__device__ __forceinline__ float sigmoid_f(float x) { return __builtin_amdgcn_rcpf(1.f + __expf(-x)); }
__device__ __forceinline__ float softplus_f(float x) { return x > 20.f ? x : __logf(1.f + __expf(x)); }

struct EpiF32 {
    static constexpr bool PERM = false, AFTER_DRAIN = false;
    float* C; int ldc;
    __device__ __forceinline__ void operator()(const pg8::f32x4 (&acc)[2][2][4][2], const pg8::Unit& u, int wr, int wc, int fr, int fq) const {
        const int col0 = u.pn * pg8::BM + wc * 32 + 4 * fq;
#pragma unroll
        for (int ai = 0; ai < 2; ++ai)
#pragma unroll
            for (int m = 0; m < 4; ++m) {
                const int r = u.pm * pg8::BM + ai * pg8::HALF + wr * 64 + m * 16 + fr;
                float* rowp = C + (size_t)r * ldc + col0;
#pragma unroll
                for (int bj = 0; bj < 2; ++bj)
#pragma unroll
                    for (int n = 0; n < 2; ++n) *(pg8::f32x4*)(rowp + bj * pg8::HALF + n * 16) = acc[ai][bj][m][n];
            }
    }
};

struct EpiBf {
    static constexpr bool PERM = true, AFTER_DRAIN = false;
    bf16* O;
    __device__ __forceinline__ void operator()(const pg8::f32x4 (&acc)[2][2][4][2], const pg8::Unit& u, int wr, int wc, int fr, int fq) const {
        const int col0 = u.pn * pg8::BM + wc * 32 + 8 * fq;
#pragma unroll
        for (int ai = 0; ai < 2; ++ai)
#pragma unroll
            for (int m = 0; m < 4; ++m) { bf16* rowp = O + (size_t)(u.pm * pg8::BM + ai * pg8::HALF + wr * 64 + m * 16 + fr) * DM + col0;
#pragma unroll
                for (int bj = 0; bj < 2; ++bj) { const pg8::f32x4 v0 = acc[ai][bj][m][0], v1 = acc[ai][bj][m][1];
                    pg8::u32x4 w; w.x = pg8::cvt_pk_bf16(v0[0], v0[1]); w.y = pg8::cvt_pk_bf16(v0[2], v0[3]); w.z = pg8::cvt_pk_bf16(v1[0], v1[1]); w.w = pg8::cvt_pk_bf16(v1[2], v1[3]);
                    *(pg8::u32x4*)(rowp + bj * pg8::HALF) = w; } }
    }
};
struct EpiAct {
    static constexpr bool PERM = true, AFTER_DRAIN = false;
    bf16* O; const float* RS;
    __device__ __forceinline__ void operator()(const pg8::f32x4 (&acc)[2][2][4][2], const pg8::Unit& u, int wr, int wc, int fr, int fq) const {
        const int col0 = u.pn * 128 + wc * 32 + 8 * fq;
#pragma unroll
        for (int ai = 0; ai < 2; ++ai)
#pragma unroll
            for (int m = 0; m < 4; ++m) {
                const int r = u.pm * pg8::BM + ai * pg8::HALF + wr * 64 + m * 16 + fr;
                const float rs = RS[r];
                const pg8::f32x4 g0 = acc[ai][0][m][0] * rs, g1 = acc[ai][0][m][1] * rs, u0 = acc[ai][1][m][0] * rs, u1 = acc[ai][1][m][1] * rs;
                pg8::u32x4 w;
                w.x = pg8::cvt_pk_bf16(silu_f(g0[0]) * u0[0], silu_f(g0[1]) * u0[1]); w.y = pg8::cvt_pk_bf16(silu_f(g0[2]) * u0[2], silu_f(g0[3]) * u0[3]);
                w.z = pg8::cvt_pk_bf16(silu_f(g1[0]) * u1[0], silu_f(g1[1]) * u1[1]); w.w = pg8::cvt_pk_bf16(silu_f(g1[2]) * u1[2], silu_f(g1[3]) * u1[3]);
                *(pg8::u32x4*)(O + (size_t)r * FF + col0) = w;
            }
    }
};
struct EpiIn {
    static constexpr bool PERM = true, AFTER_DRAIN = false;
    bf16 *QBp, *KBp, *VBp, *QKVBp, *Zp; float *BAp, *out; const float* RS;
    __device__ __forceinline__ void operator()(const pg8::f32x4 (&acc)[2][2][4][2], const pg8::Unit& u, int wr, int wc, int fr, int fq) const {
        const int pn = u.pn;
#pragma unroll
        for (int ai = 0; ai < 2; ++ai)
#pragma unroll
            for (int m = 0; m < 4; ++m) {
                const int r = u.pm * pg8::BM + ai * pg8::HALF + wr * 64 + m * 16 + fr; const float rs = RS[r];
#pragma unroll
                for (int bj = 0; bj < 2; ++bj) {
                    const int c8 = pn * 256 + bj * 128 + wc * 32 + 8 * fq;
                    pg8::f32x4 v0 = acc[ai][bj][m][0] * rs, v1 = acc[ai][bj][m][1] * rs;
                    if (pn == 28) { if (c8 < C_B + 16) { *(pg8::f32x4*)(BAp + (size_t)r * 16 + (c8 - C_B)) = v0; *(pg8::f32x4*)(BAp + (size_t)r * 16 + (c8 - C_B) + 4) = v1; } continue; }
                    bf16* dst;
                    if (pn < 4) { dst = QBp + (size_t)r * 1024 + c8; v0 = v0 * C2; v1 = v1 * C2; }
                    else if (pn < 8) { dst = KBp + (size_t)r * 1024 + (c8 - C_K); float* o = out + OUT_KP + (size_t)r * 1024 + (c8 - C_K); if (NT_OUT) { __builtin_nontemporal_store(v0, (pg8::f32x4*)o); __builtin_nontemporal_store(v1, (pg8::f32x4*)(o + 4)); } else { *(pg8::f32x4*)o = v0; *(pg8::f32x4*)(o + 4) = v1; } }
                    else if (pn < 12) { dst = VBp + (size_t)r * 1024 + (c8 - C_V); float* o = out + OUT_VP + (size_t)r * 1024 + (c8 - C_V); if (NT_OUT) { __builtin_nontemporal_store(v0, (pg8::f32x4*)o); __builtin_nontemporal_store(v1, (pg8::f32x4*)(o + 4)); } else { *(pg8::f32x4*)o = v0; *(pg8::f32x4*)(o + 4) = v1; } }
                    else if (pn < 24) { dst = QKVBp + (size_t)r * CONVD + (c8 - C_QKVB); const int t = r & (SEQ - 1);
                        if (t >= SEQ - 3) { float* o = out + OUT_CONVP + (size_t)((r >> 11) * 3 + (t - (SEQ - 3))) * CONVD + (c8 - C_QKVB); *(pg8::f32x4*)o = v0; *(pg8::f32x4*)(o + 4) = v1; } }
                    else { dst = Zp + (size_t)r * 1024 + (c8 - C_Z); }
                    pg8::u32x4 w; w.x = pg8::cvt_pk_bf16(v0[0], v0[1]); w.y = pg8::cvt_pk_bf16(v0[2], v0[3]); w.z = pg8::cvt_pk_bf16(v1[0], v1[1]); w.w = pg8::cvt_pk_bf16(v1[2], v1[3]);
                    *(pg8::u32x4*)dst = w;
                }
            }
    }
};
struct SkEpiF32 { float* C; __device__ __forceinline__ void operator()(int row, int c, float v0, float) const { C[(size_t)row * DM + c] = v0; } };
struct SkEpiAct { bf16* O; const float* RS; __device__ __forceinline__ void operator()(int row, int c, float g, float u) const { const float rs = RS[row]; O[(size_t)row * FF + c] = (bf16)f2bf(silu_f(g * rs) * (u * rs)); } };
struct SkEpiIn {
    bf16 *QBp, *KBp, *VBp, *QKVBp, *Zp; float *BAp, *out; const float* RS;
    __device__ __forceinline__ void operator()(int ms, int c, float v, float) const {
        v *= RS[ms];
        if (c < C_K) QBp[(size_t)ms * 1024 + c] = (bf16)f2bf(v * C2);
        else if (c < C_V) { KBp[(size_t)ms * 1024 + (c - C_K)] = (bf16)f2bf(v); out[OUT_KS + (size_t)ms * 1024 + (c - C_K)] = v; }
        else if (c < C_QKVB) { VBp[(size_t)ms * 1024 + (c - C_V)] = (bf16)f2bf(v); out[OUT_VS + (size_t)ms * 1024 + (c - C_V)] = v; }
        else if (c < C_Z) { QKVBp[(size_t)ms * CONVD + (c - C_QKVB)] = (bf16)f2bf(v); const int t = ms % TS;
            if (t >= TS - 3) out[OUT_CONVS + (size_t)((ms / TS) * 3 + (t - (TS - 3))) * CONVD + (c - C_QKVB)] = v; }
        else if (c < C_B) Zp[(size_t)ms * 1024 + (c - C_Z)] = (bf16)f2bf(v);
        else if (c < INW) BAp[(size_t)ms * 16 + (c - C_B)] = v;
    }
};
struct SkEpiAddF32 { float* C; __device__ __forceinline__ void operator()(int row, int c, float v0, float) const { __hip_atomic_fetch_add(C + (size_t)row * DM + c, v0, __ATOMIC_RELAXED, __HIP_MEMORY_SCOPE_AGENT); } };
template <int NB, int KS, class Epi, int GOFF = 128, bool PAIR = true> __device__ __forceinline__ void skinny_phase(Frame& F, const bf16* A, const bf16* Bt, int K, int ncu, const Epi& E, int wg_lo) {
    if ((int)blockIdx.x < wg_lo) return;
    int lane = lane_id(); asm volatile("" : "+v"(lane));
    const int w = F.wave, n = lane & 15, kq = lane >> 4, kw = K / (8 * KS), tid = 64 * w + lane;
    LAS float* red = (LAS float*)(F.lds + RING_OFF);
    for (int u = (int)blockIdx.x - wg_lo; u < ncu * KS; u += F.G - wg_lo) {
        const int cu = u / KS, kp = u % KS, c0 = (PAIR ? 16 : 16 * NB) * cu;
        const int br0 = (NB == 1 || !PAIR) ? c0 : 256 * (c0 >> 7) + (c0 & 127);
        const bf16* bp = Bt + (size_t)(br0 + n) * K + (kp * 8 + w) * kw + 8 * kq;
        const bf16* ap = A + (size_t)n * K + (kp * 8 + w) * kw + 8 * kq;
        f32x4 acc[NB][4];
#pragma unroll
        for (int g = 0; g < NB; ++g)
#pragma unroll
            for (int rt = 0; rt < 4; ++rt) acc[g][rt] = (f32x4){0.f, 0.f, 0.f, 0.f};
        for (int k = 0; k < kw; k += 128) {
            bf16x8 b[4][NB], a[4][4];
#pragma unroll
            for (int s4 = 0; s4 < 4; ++s4) if (k + 32 * s4 < kw) {
#pragma unroll
                for (int g = 0; g < NB; ++g) b[s4][g] = *(const GAS bf16x8*)(bp + (size_t)(GOFF * g) * K + k + 32 * s4);
#pragma unroll
                for (int rt = 0; rt < 4; ++rt) a[s4][rt] = *(const GAS bf16x8*)(ap + (size_t)(16 * rt) * K + k + 32 * s4);
            }
#pragma unroll
            for (int s4 = 0; s4 < 4; ++s4) if (k + 32 * s4 < kw) {
#pragma unroll
                for (int rt = 0; rt < 4; ++rt)
#pragma unroll
                    for (int g = 0; g < NB; ++g) acc[g][rt] = __builtin_amdgcn_mfma_f32_16x16x32_bf16(a[s4][rt], b[s4][g], acc[g][rt], 0, 0, 0);
            }
        }
#pragma unroll
        for (int g = 0; g < NB; ++g)
#pragma unroll
            for (int rt = 0; rt < 4; ++rt)
#pragma unroll
                for (int r = 0; r < 4; ++r) red[((g * 8 + w) * 64 + 16 * rt + 4 * kq + r) * 16 + n] = acc[g][rt][r];
        __syncthreads();
#pragma unroll
        for (int q = 0; q < 2; ++q) { const int o = tid + 512 * q; float s0 = 0.f, s1 = 0.f;
#pragma unroll
            for (int ww = 0; ww < 8; ++ww) { s0 += red[ww * 1024 + o]; if (NB == 2) s1 += red[(8 + ww) * 1024 + o]; }
            if (PAIR) E(o >> 4, c0 + (o & 15), s0, s1); else { E(o >> 4, c0 + (o & 15), s0, 0.f); if (NB == 2) E(o >> 4, c0 + GOFF + (o & 15), s1, 0.f); } }
        __syncthreads();
    }
}
__device__ __forceinline__ void transpose_item(const float* W, int N, int k0, int n0, bf16* WT, int K, int drow0, LAS float* scr, int lane, const float* ks = nullptr) {
    const int cc = n0 + (lane & 31);
    float ld[32];
#pragma unroll
    for (int i = 0; i < 32; ++i) ld[i] = (cc < N) ? W[(size_t)(k0 + 2 * i + (lane >> 5)) * N + cc] : 0.f;
    if (ks) {
#pragma unroll
        for (int i = 0; i < 32; ++i) ld[i] *= ks[k0 + 2 * i + (lane >> 5)]; }
#pragma unroll
    for (int i = 0; i < 32; ++i) scr[(2 * i + (lane >> 5)) * 33 + (lane & 31)] = ld[i];
    LDS_WAIT(); asm volatile("" ::: "memory");
    const int c = lane & 7;
#pragma unroll
    for (int j = 0; j < 4; ++j) { const int n = (lane >> 3) + 8 * j; const LAS float* s = scr + (8 * c) * 33 + n;
        v4u o; o.x = pk2(s[0 * 33], s[1 * 33]); o.y = pk2(s[2 * 33], s[3 * 33]); o.z = pk2(s[4 * 33], s[5 * 33]); o.w = pk2(s[6 * 33], s[7 * 33]);
#if NT_WSTORE
        __builtin_nontemporal_store(o, (GAS v4u*)(WT + (size_t)(drow0 + n) * K + k0 + 8 * c)); }
#else
        *(GAS v4u*)(WT + (size_t)(drow0 + n) * K + k0 + 8 * c) = o; }
#endif
    LDS_WAIT(); asm volatile("" ::: "memory");
}
__device__ __forceinline__ void tr_gu(const float* W, bf16* WT, int half, int r, LAS float* scr, int lane) {
    constexpr int nblk = FF / 32; const int kb = r / nblk, nb = r % nblk, n0 = 32 * nb;
    transpose_item(W, FF, 64 * kb, n0, WT, DM, 256 * (n0 >> 7) + 128 * half + (n0 & 127), scr, lane);
}
__device__ __forceinline__ void tr_plain(const float* W, int K, int N, int nblk, bf16* WT, int r, LAS float* scr, int lane) {
    const int kb = r / nblk, nb = r % nblk;
    transpose_item(W, N, 64 * kb, 32 * nb, WT, K, 32 * nb, scr, lane);
}
__device__ __forceinline__ f32x4 ld_bf16x4(const bf16* p) { const unsigned long long w = *(const GAS unsigned long long*)p; const unsigned lo = (unsigned)w, hi = (unsigned)(w >> 32);
    return (f32x4){__uint_as_float(lo << 16), __uint_as_float(lo & 0xffff0000u), __uint_as_float(hi << 16), __uint_as_float(hi & 0xffff0000u)}; }
__device__ __forceinline__ void st_bf16x4(bf16* p, f32x4 v) { *(GAS unsigned long long*)p = (unsigned long long)pk2(v.x, v.y) | ((unsigned long long)pk2(v.z, v.w) << 32); }
__device__ __forceinline__ void thin_finish(Frame& F, f32x4 (&v)[8], const f32x4 (&g)[8], bool has_f, int m, float scale, const float* post_w, bf16* xout16, float* xout32, float* rs_out) {
    const int lane = F.lane;
    if (has_f) {
        float ss = 0.f;
#pragma unroll
        for (int j = 0; j < 8; ++j) ss += (g[j].x * g[j].x + g[j].y * g[j].y) + (g[j].z * g[j].z + g[j].w * g[j].w);
        const float rs = scale * rsqrtf(wave_sum(ss) * (1.f / DM) + EPS);
        const GAS f32x4* w4 = (const GAS f32x4*)post_w + lane;
#pragma unroll
        for (int j = 0; j < 8; ++j) { const f32x4 w = w4[64 * j]; v[j] = v[j] + g[j] * w * rs; }
    }
    if (xout16) {
#pragma unroll
        for (int j = 0; j < 8; ++j) st_bf16x4(xout16 + (size_t)m * DM + 4 * (64 * j + lane), v[j]); }
    if (xout32) { GAS f32x4* o4 = (GAS f32x4*)(xout32 + (size_t)m * DM) + lane;
#pragma unroll
        for (int j = 0; j < 8; ++j) { if (NT_OUT) __builtin_nontemporal_store(v[j], o4 + 64 * j); else o4[64 * j] = v[j]; } }
    if (rs_out) {
        float ss = 0.f;
#pragma unroll
        for (int j = 0; j < 8; ++j) ss += (v[j].x * v[j].x + v[j].y * v[j].y) + (v[j].z * v[j].z + v[j].w * v[j].w);
        const float rs = rsqrtf(wave_sum(ss) * (1.f / DM) + EPS);
        if (lane == 0) rs_out[m] = rs;
    }
}
__device__ __forceinline__ void thin_rows(Frame& F, const bf16* xin16, const bf16* f16, float* fs, float scale, const float* post_w, bf16* xout16, float* xout32, float* rs_out) {
    const int lane = F.lane;
    const bool pipe = THIN_PIPE && xin16 && f16;
    if (pipe) {
        typedef unsigned long long u64t;
        u64t ax[8], aq[8], bx[8], bq[8];
#define TH_LOAD(X, Q, m_) do { _Pragma("unroll") for (int j = 0; j < 8; ++j) { X[j] = *(const GAS u64t*)(xin16 + (size_t)(m_) * DM + 4 * (64 * j + lane)); Q[j] = *(const GAS u64t*)(f16 + (size_t)(m_) * DM + 4 * (64 * j + lane)); } } while (0)
#define TH_UNPK(w_) (f32x4){__uint_as_float((unsigned)(w_) << 16), __uint_as_float((unsigned)(w_) & 0xffff0000u), __uint_as_float((unsigned)((w_) >> 32) << 16), __uint_as_float((unsigned)((w_) >> 32) & 0xffff0000u)}
#define TH_FIN(X, Q, m_) do { f32x4 v[8], g[8]; _Pragma("unroll") for (int j = 0; j < 8; ++j) { v[j] = TH_UNPK(X[j]); g[j] = TH_UNPK(Q[j]); } thin_finish(F, v, g, true, m_, scale, post_w, xout16, xout32, rs_out); } while (0)
        int m = F.gw;
        if (m < MP) TH_LOAD(ax, aq, m);
        while (m < MP) {
            const int m2 = m + F.NGW, m3 = m2 + F.NGW;
            if (m2 < MP) TH_LOAD(bx, bq, m2);
            TH_FIN(ax, aq, m);
            if (m3 < MP) TH_LOAD(ax, aq, m3);
            if (m2 < MP) TH_FIN(bx, bq, m2);
            m = m3;
        }
#undef TH_LOAD
#undef TH_UNPK
#undef TH_FIN
    }
    for (int m = F.gw; m < M_ALL; m += F.NGW) {
        if (pipe && m < MP) continue;
        f32x4 v[8], g[8];
        if (xin16) {
#pragma unroll
            for (int j = 0; j < 8; ++j) v[j] = ld_bf16x4(xin16 + (size_t)m * DM + 4 * (64 * j + lane));
        } else { const GAS f32x4* x4 = (const GAS f32x4*)(m < MP ? F.xp() + (size_t)m * DM : F.xs() + (size_t)(m - MP) * DM) + lane;
#pragma unroll
            for (int j = 0; j < 8; ++j) v[j] = x4[64 * j]; }
        if (f16) {
            if (m < MP) {
#pragma unroll
                for (int j = 0; j < 8; ++j) g[j] = ld_bf16x4(f16 + (size_t)m * DM + 4 * (64 * j + lane));
            } else { GAS f32x4* f4 = (GAS f32x4*)(fs + (size_t)m * DM) + lane;
#pragma unroll
                for (int j = 0; j < 8; ++j) { g[j] = f4[64 * j]; f4[64 * j] = (f32x4){0.f, 0.f, 0.f, 0.f}; } }
        } else {
#pragma unroll
            for (int j = 0; j < 8; ++j) g[j] = (f32x4){0.f, 0.f, 0.f, 0.f}; }
        thin_finish(F, v, g, f16 != nullptr, m, scale, post_w, xout16, xout32, rs_out);
    }
}
__device__ __forceinline__ void transpose_item64(const float* W, int N, int k0, int n0, bf16* WT, int K, int drow0, LAS float* scr, int lane) {
    const int kr = lane >> 4, c = lane & 15, nr = lane >> 2, kc = lane & 3; const bool inb = n0 + 4 * c < N;
#pragma unroll
    for (int half = 0; half < 2; ++half) {
        f32x4 v[8];
#pragma unroll
        for (int i = 0; i < 8; ++i) v[i] = inb ? *(const GAS f32x4*)(W + (size_t)(k0 + 32 * half + 4 * i + kr) * N + n0 + 4 * c) : (f32x4){0.f, 0.f, 0.f, 0.f};
#pragma unroll
        for (int i = 0; i < 8; ++i) *(LAS f32x4*)(scr + (4 * i + kr) * 68 + 4 * c) = v[i];
        LDS_WAIT(); asm volatile("" ::: "memory");
#pragma unroll
        for (int it = 0; it < 4; ++it) { const int n = nr + 16 * it; const LAS float* sp = scr + (8 * kc) * 68 + n;
            v4u o; o.x = pk2(sp[0 * 68], sp[1 * 68]); o.y = pk2(sp[2 * 68], sp[3 * 68]); o.z = pk2(sp[4 * 68], sp[5 * 68]); o.w = pk2(sp[6 * 68], sp[7 * 68]);
            *(GAS v4u*)(WT + (size_t)(drow0 + n) * K + k0 + 32 * half + 8 * kc) = o; }
        LDS_WAIT(); asm volatile("" ::: "memory");
    }
}
__device__ __forceinline__ void convert_matrix(Frame& F, const float* W, int K, int N, int Npad, bf16* WT, int mode, int wg_lo, const float* ks = nullptr) {
    if ((int)blockIdx.x < wg_lo) return;
    LAS float* scr = (LAS float*)(F.lds + RING_OFF + F.wave * 16384);
    const int nkb = K / 64, nit = nkb * (Npad / 32), wv = ((int)blockIdx.x - wg_lo) * NWAVES + F.wave, nwv = (F.G - wg_lo) * NWAVES;
    for (int it = wv; it < nit; it += nwv) {
#if CONV_NFAST
        const int nnb = Npad / 32, n0 = 32 * (it % nnb), kb = it / nnb;
#else
        const int kb = it % nkb, n0 = 32 * (it / nkb);
#endif
        const int drow0 = mode == 0 ? n0 : 256 * (n0 >> 7) + 128 * (mode - 1) + (n0 & 127);
        transpose_item(W, N, 64 * kb, n0, WT, K, drow0, scr, F.lane, ks);
    }
}
struct ConvItem { const float* src; bf16* dst; const float* ks; int N, K, cc, k0; };
constexpr int CV_GU = (DM / 64) * (FF / 32), CV_IN = (DM / 64) * (INW_PAD / 32), CV_OUT = (DM / 64) * (DM / 32), CV_DN = (FF / 64) * (DM / 32);
constexpr int CV_E0 = CV_GU, CV_E1 = CV_E0 + CV_GU, CV_E2 = CV_E1 + CV_GU, CV_E3 = CV_E2 + CV_GU, CV_E4 = CV_E3 + CV_IN, CV_E5 = CV_E4 + CV_OUT, CV_E6 = CV_E5 + CV_DN, CV_TOT = CV_E6 + CV_DN;
__device__ __forceinline__ void conv_decode(const Frame& F, int g, int lane, ConvItem& c) {
    const float* W; bf16* WT; const float* ks; int K, N, Npad, mode, it;
    if (g < CV_E0)      { W = F.gate1(); WT = F.W1GU(); ks = F.ffn1_pre(); K = DM; N = FF; Npad = FF; mode = 1; it = g; }
    else if (g < CV_E1) { W = F.up1();   WT = F.W1GU(); ks = F.ffn1_pre(); K = DM; N = FF; Npad = FF; mode = 2; it = g - CV_E0; }
    else if (g < CV_E2) { W = F.gate2(); WT = F.W2GU(); ks = F.ffn2_pre(); K = DM; N = FF; Npad = FF; mode = 1; it = g - CV_E1; }
    else if (g < CV_E3) { W = F.up2();   WT = F.W2GU(); ks = F.ffn2_pre(); K = DM; N = FF; Npad = FF; mode = 2; it = g - CV_E2; }
    else if (g < CV_E4) { W = F.w_in();  WT = F.WIN();  ks = F.mix_pre();  K = DM; N = INW; Npad = INW_PAD; mode = 0; it = g - CV_E3; }
    else if (g < CV_E5) { W = F.w_out(); WT = F.WOUT(); ks = nullptr;      K = DM; N = DM; Npad = DM; mode = 0; it = g - CV_E4; }
    else if (g < CV_E6) { W = F.down1(); WT = F.W1D();  ks = nullptr;      K = FF; N = DM; Npad = DM; mode = 0; it = g - CV_E5; }
    else                { W = F.down2(); WT = F.W2D();  ks = nullptr;      K = FF; N = DM; Npad = DM; mode = 0; it = g - CV_E6; }
    const int nnb = Npad / 32, n0 = 32 * (it % nnb), kb = it / nnb;
    const int drow0 = mode == 0 ? n0 : 256 * (n0 >> 7) + 128 * (mode - 1) + (n0 & 127);
    c.N = N; c.K = K; c.k0 = 64 * kb; c.cc = n0 + (lane & 31); c.ks = ks;
    c.src = W + (size_t)(64 * kb + (lane >> 5)) * N + c.cc;
    c.dst = WT + (size_t)(drow0 + (lane >> 3)) * K + 64 * kb + 8 * (lane & 7);
}
#define CV_LOAD(ld, kv0, kv1, c) do { \
        _Pragma("unroll") for (int i = 0; i < 32; ++i) ld[i] = ((c).cc < (c).N) ? (c).src[(size_t)(2 * i) * (c).N] : 0.f; \
        if ((c).ks) { kv0 = *(const GAS f32x4*)((c).ks + (c).k0 + 8 * (lane & 7)); kv1 = *(const GAS f32x4*)((c).ks + (c).k0 + 8 * (lane & 7) + 4); } \
        else { kv0 = (f32x4){1.f, 1.f, 1.f, 1.f}; kv1 = kv0; } } while (0)
#define CV_STORE(ld, kv0, kv1, c) do { \
        _Pragma("unroll") for (int i = 0; i < 32; ++i) scr[(2 * i + (lane >> 5)) * 33 + (lane & 31)] = ld[i]; \
        LDS_WAIT(); asm volatile("" ::: "memory"); \
        _Pragma("unroll") for (int j = 0; j < 4; ++j) { const LAS float* s_ = scr + (8 * (lane & 7)) * 33 + (lane >> 3) + 8 * j; \
            v4u o_; o_.x = pk2(s_[0 * 33] * kv0.x, s_[1 * 33] * kv0.y); o_.y = pk2(s_[2 * 33] * kv0.z, s_[3 * 33] * kv0.w); o_.z = pk2(s_[4 * 33] * kv1.x, s_[5 * 33] * kv1.y); o_.w = pk2(s_[6 * 33] * kv1.z, s_[7 * 33] * kv1.w); \
            *(GAS v4u*)((c).dst + (size_t)(8 * j) * (c).K) = o_; } \
        LDS_WAIT(); asm volatile("" ::: "memory"); } while (0)
__device__ __forceinline__ void convert_all(Frame& F) {
    LAS float* scr = (LAS float*)(F.lds + RING_OFF + F.wave * 16384);
    const int lane = F.lane, wv = (int)blockIdx.x * NWAVES + F.wave, nwv = F.G * NWAVES;
    float ldA[32], ldB[32], ldC[32]; f32x4 kA0, kA1, kB0, kB1, kC0, kC1; ConvItem cA, cB, cC;
    const int g0 = wv;
    if (g0 < CV_TOT) { conv_decode(F, g0, lane, cA); CV_LOAD(ldA, kA0, kA1, cA); }
    if (g0 + nwv < CV_TOT) { conv_decode(F, g0 + nwv, lane, cB); CV_LOAD(ldB, kB0, kB1, cB); }
    for (int g = g0; g < CV_TOT; g += 3 * nwv) {
        if (g + 2 * nwv < CV_TOT) { conv_decode(F, g + 2 * nwv, lane, cC); CV_LOAD(ldC, kC0, kC1, cC); }
        CV_STORE(ldA, kA0, kA1, cA);
        if (g + 3 * nwv < CV_TOT) { conv_decode(F, g + 3 * nwv, lane, cA); CV_LOAD(ldA, kA0, kA1, cA); }
        if (g + nwv < CV_TOT) CV_STORE(ldB, kB0, kB1, cB);
        if (g + 4 * nwv < CV_TOT) { conv_decode(F, g + 4 * nwv, lane, cB); CV_LOAD(ldB, kB0, kB1, cB); }
        if (g + 2 * nwv < CV_TOT) CV_STORE(ldC, kC0, kC1, cC);
    }
}
__device__ __forceinline__ void p0_prologue(Frame& F) {
#if CONV_PIPE
    convert_all(F);
#else
    convert_matrix(F, F.gate1(), DM, FF, FF, F.W1GU(), 1, 0, F.ffn1_pre());
    convert_matrix(F, F.up1(), DM, FF, FF, F.W1GU(), 2, 0, F.ffn1_pre());
    convert_matrix(F, F.up2(), DM, FF, FF, F.W2GU(), 2, 0, F.ffn2_pre());
    convert_matrix(F, F.w_in(), DM, INW, INW_PAD, F.WIN(), 0, 0, F.mix_pre()); convert_matrix(F, F.w_out(), DM, DM, DM, F.WOUT(), 0, 0);
    convert_matrix(F, F.gate2(), DM, FF, FF, F.W2GU(), 1, 0, F.ffn2_pre());
#if !CONV_TAILS
    convert_matrix(F, F.down1(), FF, DM, DM, F.W1D(), 0, 0); convert_matrix(F, F.down2(), FF, DM, DM, F.W2D(), 0, 0);
#endif
#endif
    thin_rows(F, nullptr, nullptr, nullptr, 0.f, nullptr, F.X0h(), nullptr, F.RS());
    { const int gt = (int)blockIdx.x * NTHREADS + F.tid, NT = F.G * NTHREADS; GAS f32x4* z = (GAS f32x4*)(F.Fb() + (size_t)MP * DM);
      for (int i = gt; i < MS * DM / 4; i += NT) z[i] = (f32x4){0.f, 0.f, 0.f, 0.f}; }
}
constexpr int G1_R = 0, G1_Q = 65536, G1_K = G1_Q + 17408, G1_KDT = G1_K + 17408, G1_SM = G1_KDT + 18432, G1_CW = G1_SM + 1024, G1_END = G1_CW + 6144, QS = 136, TS72 = 72;
static_assert(G1_END <= RING_BYTES, "G1 LDS");
__device__ __forceinline__ void gdn_chunk_prep(Frame& F, int ci_lo, int ci_hi, int ci_step) {
    typedef float f32x2 __attribute__((ext_vector_type(2)));
    LAS float* R = (LAS float*)(F.lds + G1_R); LAS bf16* QI = (LAS bf16*)(F.lds + G1_Q); LAS float* Lm = (LAS float*)(F.lds + G1_Q);
    LAS bf16* KI = (LAS bf16*)(F.lds + G1_K); LAS bf16* KD = (LAS bf16*)(F.lds + G1_KDT); LAS float* SM = (LAS float*)(F.lds + G1_SM); LAS float* CW = (LAS float*)(F.lds + G1_CW);
    const int w = F.wave; int h_cw = -1;
    for (int ci = ci_lo; ci < ci_hi; ci += ci_step) {
        int lane = lane_id(); asm volatile("" : "+v"(lane));
        const int m16 = lane & 15, kq = lane >> 4, tid = 64 * w + lane;
        int h, t0, T, row0; const float* cs = nullptr;
        if (ci < NCHUNK_P) { const int sh = ci >> 5; h = sh & 7; t0 = (ci & 31) * 64; T = SEQ; row0 = (sh >> 3) * SEQ; }
        else { const int sb = ci - NCHUNK_P, b = sb >> 3; h = sb & 7; t0 = 0; T = TS; row0 = MP + b * TS; cs = F.state_conv() + (size_t)b * 3 * CONVD; }
        if (h != h_cw) { for (int i = tid; i < 1536; i += NTHREADS) { const int p = i >> 9, j = (i >> 7) & 3, c = i & 127; CW[i] = F.conv_w()[(size_t)j * CONVD + p * 1024 + h * 128 + c]; } h_cw = h; }
        const int r4 = lane >> 4, cg = lane & 15;
        v4u xr[2][3][4];
        if (false) { const int tok = t0 + 8 * w + r4;
#pragma unroll
            for (int p = 0; p < 3; ++p)
#pragma unroll
                for (int j = 0; j < 4; ++j) { const int tt = tok + j - 3;
                    xr[0][p][j] = (tt >= 0) ? *(const GAS v4u*)(F.QKVB() + (size_t)(row0 + tt) * CONVD + p * 1024 + h * 128 + 8 * cg) : (v4u){0u, 0u, 0u, 0u}; } }
        {
            const int tok = t0 + lane; const bool valid = tok < T; float g = 0.f, be = 0.f;
            if (valid) { const float* hr = F.BA() + (size_t)(row0 + tok) * 16; be = sigmoid_f(hr[h]); g = -__expf(F.a_log()[h]) * softplus_f(hr[8 + h] + F.dt_bias()[h]); }
            float G = g;
#pragma unroll
            for (int o = 1; o < 64; o <<= 1) { const float t = __shfl_up(G, o); if (lane >= o) G += t; }
            const float G63 = __shfl(G, 63);
            SM[lane] = G; SM[64 + lane] = be; SM[128 + lane] = __expf(G); SM[192 + lane] = __expf(G63 - G);
            if (w == 0 && lane == 0) F.EGL()[ci] = __expf(G63);
        }
        LDS_BARRIER();
        if (false) { const int tok = t0 + 8 * w + 4 + r4;
#pragma unroll
            for (int p = 0; p < 3; ++p)
#pragma unroll
                for (int j = 0; j < 4; ++j) { const int tt = tok + j - 3;
                    xr[1][p][j] = (tt >= 0) ? *(const GAS v4u*)(F.QKVB() + (size_t)(row0 + tt) * CONVD + p * 1024 + h * 128 + 8 * cg) : (v4u){0u, 0u, 0u, 0u}; } }
#pragma unroll
        for (int g = 0; g < 2; ++g) {
            const int i = 8 * w + 4 * g + r4, tok = t0 + i; const bool valid = tok < T;
            LAS float* cwp = CW + 8 * cg; asm volatile("" : "+v"(cwp));
            float a[3][8];
#pragma unroll
            for (int p = 0; p < 3; ++p) {
                float acc[8];
#pragma unroll
                for (int c = 0; c < 8; ++c) acc[c] = 0.f;
#pragma unroll
                for (int j = 0; j < 4; ++j) {
                    float xv[8];
                    if (false) { const v4u xw = xr[g][p][j];
                        xv[0] = __uint_as_float(xw.x << 16); xv[1] = __uint_as_float(xw.x & 0xffff0000u); xv[2] = __uint_as_float(xw.y << 16); xv[3] = __uint_as_float(xw.y & 0xffff0000u);
                        xv[4] = __uint_as_float(xw.z << 16); xv[5] = __uint_as_float(xw.z & 0xffff0000u); xv[6] = __uint_as_float(xw.w << 16); xv[7] = __uint_as_float(xw.w & 0xffff0000u); }
                    else {
                        const int tt = tok + j - 3;
#pragma unroll
                        for (int c = 0; c < 8; ++c) xv[c] = 0.f;
                        if (valid) {
                            if (tt >= 0) { const v4u xw = *(const GAS v4u*)(F.QKVB() + (size_t)(row0 + tt) * CONVD + p * 1024 + h * 128 + 8 * cg);
                                xv[0] = __uint_as_float(xw.x << 16); xv[1] = __uint_as_float(xw.x & 0xffff0000u); xv[2] = __uint_as_float(xw.y << 16); xv[3] = __uint_as_float(xw.y & 0xffff0000u);
                                xv[4] = __uint_as_float(xw.z << 16); xv[5] = __uint_as_float(xw.z & 0xffff0000u); xv[6] = __uint_as_float(xw.w << 16); xv[7] = __uint_as_float(xw.w & 0xffff0000u); }
                            else { const f32x4 c0 = *(const GAS f32x4*)(cs + (size_t)(tt + 3) * CONVD + p * 1024 + h * 128 + 8 * cg), c1 = *(const GAS f32x4*)(cs + (size_t)(tt + 3) * CONVD + p * 1024 + h * 128 + 8 * cg + 4);
                                xv[0] = c0.x; xv[1] = c0.y; xv[2] = c0.z; xv[3] = c0.w; xv[4] = c1.x; xv[5] = c1.y; xv[6] = c1.z; xv[7] = c1.w; }
                        }
                    }
                    const f32x4 w0 = *(const LAS f32x4*)(cwp + (p * 4 + j) * 128), w1 = *(const LAS f32x4*)(cwp + (p * 4 + j) * 128 + 4);
                    acc[0] += xv[0] * w0.x; acc[1] += xv[1] * w0.y; acc[2] += xv[2] * w0.z; acc[3] += xv[3] * w0.w; acc[4] += xv[4] * w1.x; acc[5] += xv[5] * w1.y; acc[6] += xv[6] * w1.z; acc[7] += xv[7] * w1.w;
                }
#pragma unroll
                for (int c = 0; c < 8; ++c) a[p][c] = valid ? silu_f(acc[c]) : 0.f;
            }
            float sq = 0.f, sk = 0.f;
#pragma unroll
            for (int c = 0; c < 8; ++c) { sq += a[0][c] * a[0][c]; sk += a[1][c] * a[1][c]; }
            sq = sum16(sq); sk = sum16(sk);
            const float rq = rsqrtf(sq + 1e-6f) * 0.08838834764831845f, rk = rsqrtf(sk + 1e-6f);
            const float be = SM[64 + i], eg = SM[128 + i], ed = SM[192 + i];
            float qn[8], kn[8];
#pragma unroll
            for (int c = 0; c < 8; ++c) { qn[c] = a[0][c] * rq; kn[c] = a[1][c] * rk; }
            *(LAS v4u*)(QI + i * QS + 8 * cg) = (v4u){pk2(qn[0], qn[1]), pk2(qn[2], qn[3]), pk2(qn[4], qn[5]), pk2(qn[6], qn[7])};
            *(LAS v4u*)(KI + i * QS + 8 * cg) = (v4u){pk2(kn[0], kn[1]), pk2(kn[2], kn[3]), pk2(kn[4], kn[5]), pk2(kn[6], kn[7])};
            *(GAS v4u*)(F.QGc() + ((size_t)ci * 64 + i) * 128 + 8 * cg) = (v4u){pk2(qn[0] * eg, qn[1] * eg), pk2(qn[2] * eg, qn[3] * eg), pk2(qn[4] * eg, qn[5] * eg), pk2(qn[6] * eg, qn[7] * eg)};
#pragma unroll
            for (int c = 0; c < 8; ++c) KD[(8 * cg + c) * TS72 + i] = (bf16)f2bf(kn[c] * ed);
            const float bg = be * eg;
            *(LAS f32x4*)(R + i * 256 + 8 * cg) = (f32x4){a[2][0] * be, a[2][1] * be, a[2][2] * be, a[2][3] * be}; *(LAS f32x4*)(R + i * 256 + 8 * cg + 4) = (f32x4){a[2][4] * be, a[2][5] * be, a[2][6] * be, a[2][7] * be};
            *(LAS f32x4*)(R + i * 256 + 128 + 8 * cg) = (f32x4){kn[0] * bg, kn[1] * bg, kn[2] * bg, kn[3] * bg}; *(LAS f32x4*)(R + i * 256 + 128 + 8 * cg + 4) = (f32x4){kn[4] * bg, kn[5] * bg, kn[6] * bg, kn[7] * bg};
        }
        LDS_BARRIER();
        {
            const int tm = w & 3, tnb = (w >> 2) * 2;
            f32x4 kk[2], kqv[2];
#pragma unroll
            for (int t2 = 0; t2 < 2; ++t2) { kk[t2] = (f32x4){0.f, 0.f, 0.f, 0.f}; kqv[t2] = (f32x4){0.f, 0.f, 0.f, 0.f}; }
#pragma unroll
            for (int ks = 0; ks < 4; ++ks) {
                const bf16x8 ak = *(const LAS bf16x8*)(KI + (16 * tm + m16) * QS + 32 * ks + 8 * kq);
#pragma unroll
                for (int t2 = 0; t2 < 2; ++t2) {
                    const bf16x8 bk = *(const LAS bf16x8*)(KI + (16 * (tnb + t2) + m16) * QS + 32 * ks + 8 * kq);
                    const bf16x8 bq = *(const LAS bf16x8*)(QI + (16 * (tnb + t2) + m16) * QS + 32 * ks + 8 * kq);
                    kk[t2] = __builtin_amdgcn_mfma_f32_16x16x32_bf16(ak, bk, kk[t2], 0, 0, 0);
                    kqv[t2] = __builtin_amdgcn_mfma_f32_16x16x32_bf16(ak, bq, kqv[t2], 0, 0, 0);
                }
            }
#pragma unroll
            for (int t2 = 0; t2 < 2; ++t2) {
                const int i = 16 * (tnb + t2) + m16, j0 = 16 * tm + 4 * kq; const float Gi = SM[i]; float o4[4];
#pragma unroll
                for (int r = 0; r < 4; ++r) { const int j = j0 + r; o4[r] = (i >= j) ? kqv[t2][r] * __expf(Gi - SM[j]) : 0.f; }
                *(GAS unsigned long long*)(F.QKc() + ((size_t)ci * 64 + i) * 64 + j0) = (unsigned long long)pk2(o4[0], o4[1]) | ((unsigned long long)pk2(o4[2], o4[3]) << 32);
            }
            LDS_BARRIER();
#pragma unroll
            for (int t2 = 0; t2 < 2; ++t2) {
                const int j = 16 * (tnb + t2) + m16; const float Gj = SM[j];
#pragma unroll
                for (int r = 0; r < 4; ++r) { const int i = 16 * tm + 4 * kq + r; Lm[i * 64 + j] = (i > j) ? SM[64 + i] * kk[t2][r] * __expf(SM[i] - Gj) : 0.f; }
            }
        }
        LDS_BARRIER();
        if (w < 2) {
            typedef float f32x2 __attribute__((ext_vector_type(2)));
            const int c2 = 64 * w + lane;
            LAS float* Lb = Lm; asm volatile("" : "+v"(Lb));
            f32x2 x[64];
#pragma unroll
            for (int i = 0; i < 64; ++i) x[i] = *(const LAS f32x2*)(R + i * 256 + 2 * c2);
#define G1_SOLVE_ROW(i) do { f32x2 a0 = {0.f, 0.f}, a1 = {0.f, 0.f}; \
                _Pragma("unroll") for (int j4 = 0; j4 < ((i) + 3) / 4; ++j4) { const f32x4 l = *(const LAS f32x4*)(Lb + (i) * 64 + 4 * j4); \
                    a0 = a0 + x[4 * j4] * l.x; a1 = a1 + x[4 * j4 + 1] * l.y; a0 = a0 + x[4 * j4 + 2] * l.z; a1 = a1 + x[4 * j4 + 3] * l.w; } \
                x[i] = x[i] - (a0 + a1); asm volatile("" ::: "memory"); } while (0)
#pragma unroll
            for (int i = 1; i < TS; ++i) G1_SOLVE_ROW(i);
            if (false) {
#pragma unroll
                for (int i = TS; i < 64; ++i) G1_SOLVE_ROW(i);
            }
#ifdef REP_SOLVE
            asm volatile("" : "+v"(Lb));
#pragma unroll
            for (int i = 0; i < 64; ++i) x[i] = *(const LAS f32x2*)(R + i * 256 + 2 * c2);
#pragma unroll
            for (int i = 1; i < 64; ++i) G1_SOLVE_ROW(i);
            asm volatile("" : "+v"(Lb));
#pragma unroll
            for (int i = 0; i < 64; ++i) x[i] = *(const LAS f32x2*)(R + i * 256 + 2 * c2);
#pragma unroll
            for (int i = 1; i < 64; ++i) G1_SOLVE_ROW(i);
#endif
#undef G1_SOLVE_ROW
            if (w == 0) { float* up = F.UT() + (size_t)ci * 8192 + 2 * lane;
#pragma unroll
                for (int i = 0; i < 64; ++i) *(GAS f32x2*)(up + i * 128) = x[i];
            } else { bf16* wp = F.WC() + (size_t)ci * 8192 + 2 * lane;
#pragma unroll
                for (int i = 0; i < 64; ++i) *(GAS unsigned*)(wp + i * 128) = pk2(x[i].x, x[i].y); }
        } else if (w >= 4) {
            const int t = tid - 256;
#pragma unroll
            for (int q = 0; q < 4; ++q) { const int p = t + 256 * q, row = p >> 3, pc = p & 7;
                *(GAS v4u*)(F.KDTc() + (size_t)ci * 8192 + row * 64 + pc * 8) = *(const LAS v4u*)(KD + row * TS72 + pc * 8); }
        }
        LDS_BARRIER();
    }
}
constexpr int P2_HALF = 69632, P2_R = 0, P2_Q = 32768, P2_K = 50176, P2_SM = 67584, P2_CW = 2 * P2_HALF;
static_assert(P2_SM + 1024 <= P2_HALF && P2_CW + 6144 <= MISC_OFF, "prep2 LDS");
__device__ __forceinline__ void gdn_chunk_prep2(Frame& F, int ci_lo, int ci_hi) {
    typedef float f32x2 __attribute__((ext_vector_type(2)));
    const int w = F.wave, hb = w >> 2, wl = w & 3;
    LAS unsigned char* HB = F.lds + hb * P2_HALF;
    LAS bf16* R16 = (LAS bf16*)(HB + P2_R); LAS bf16* QI = (LAS bf16*)(HB + P2_Q); LAS float* Lm = (LAS float*)(HB + P2_Q); LAS bf16* KI = (LAS bf16*)(HB + P2_K); LAS float* SM = (LAS float*)(HB + P2_SM);
    LAS float* CW = (LAS float*)(F.lds + P2_CW);
    int h_cw = -1;
    for (int cp = ci_lo; cp < ci_hi; cp += 2) {
        int lane = lane_id(); asm volatile("" : "+v"(lane));
        const int m16 = lane & 15, kq = lane >> 4, tid = 64 * w + lane, r4 = lane >> 4, cg = lane & 15;
        const int ci = cp + hb, sh = ci >> 5, h = sh & 7, t0 = (ci & 31) * 64, row0 = (sh >> 3) * SEQ;
        if (h != h_cw) { for (int i = tid; i < 1536; i += NTHREADS) { const int p = i >> 9, j = (i >> 7) & 3, c = i & 127; CW[i] = F.conv_w()[(size_t)j * CONVD + p * 1024 + h * 128 + c]; } h_cw = h; }
        v4u xr[2][3][4];
#define P2_LOADG(buf, g_) do { const int tok_ = t0 + 16 * wl + 4 * (g_) + r4; \
            _Pragma("unroll") for (int p = 0; p < 3; ++p) _Pragma("unroll") for (int j = 0; j < 4; ++j) { const int tt = tok_ + j - 3; \
                xr[buf][p][j] = (tt >= 0) ? *(const GAS v4u*)(F.QKVB() + (size_t)(row0 + tt) * CONVD + p * 1024 + h * 128 + 8 * cg) : (v4u){0u, 0u, 0u, 0u}; } } while (0)
        P2_LOADG(0, 0);
        {
            const float* hr = F.BA() + (size_t)(row0 + t0 + lane) * 16; const float be = sigmoid_f(hr[h]), g = -__expf(F.a_log()[h]) * softplus_f(hr[8 + h] + F.dt_bias()[h]);
            float G = g;
#pragma unroll
            for (int o = 1; o < 64; o <<= 1) { const float t = __shfl_up(G, o); if (lane >= o) G += t; }
            const float G63 = __shfl(G, 63);
            SM[lane] = G; SM[64 + lane] = be; SM[128 + lane] = __expf(G); SM[192 + lane] = __expf(G63 - G);
            if (wl == 0 && lane == 0) F.EGL()[ci] = __expf(G63);
        }
        LDS_BARRIER();
#pragma unroll
        for (int g = 0; g < 4; ++g) {
            if (g + 1 < 4) P2_LOADG((g + 1) & 1, g + 1);
            const int i = 16 * wl + 4 * g + r4;
            LAS float* cwp = CW + 8 * cg; asm volatile("" : "+v"(cwp));
            float a[3][8];
#pragma unroll
            for (int p = 0; p < 3; ++p) {
                float acc[8];
#pragma unroll
                for (int c = 0; c < 8; ++c) acc[c] = 0.f;
#pragma unroll
                for (int j = 0; j < 4; ++j) {
                    const v4u xw = xr[g & 1][p][j]; float xv[8];
                    xv[0] = __uint_as_float(xw.x << 16); xv[1] = __uint_as_float(xw.x & 0xffff0000u); xv[2] = __uint_as_float(xw.y << 16); xv[3] = __uint_as_float(xw.y & 0xffff0000u);
                    xv[4] = __uint_as_float(xw.z << 16); xv[5] = __uint_as_float(xw.z & 0xffff0000u); xv[6] = __uint_as_float(xw.w << 16); xv[7] = __uint_as_float(xw.w & 0xffff0000u);
                    const f32x4 w0 = *(const LAS f32x4*)(cwp + (p * 4 + j) * 128), w1 = *(const LAS f32x4*)(cwp + (p * 4 + j) * 128 + 4);
                    acc[0] += xv[0] * w0.x; acc[1] += xv[1] * w0.y; acc[2] += xv[2] * w0.z; acc[3] += xv[3] * w0.w; acc[4] += xv[4] * w1.x; acc[5] += xv[5] * w1.y; acc[6] += xv[6] * w1.z; acc[7] += xv[7] * w1.w;
                }
#pragma unroll
                for (int c = 0; c < 8; ++c) a[p][c] = silu_f(acc[c]);
            }
            float sq = 0.f, sk = 0.f;
#pragma unroll
            for (int c = 0; c < 8; ++c) { sq += a[0][c] * a[0][c]; sk += a[1][c] * a[1][c]; }
            sq = sum16(sq); sk = sum16(sk);
            const float rq = rsqrtf(sq + 1e-6f) * 0.08838834764831845f, rk = rsqrtf(sk + 1e-6f);
            const float be = SM[64 + i], eg = SM[128 + i], ed = SM[192 + i], bg = be * eg;
            float qn[8], kn[8];
#pragma unroll
            for (int c = 0; c < 8; ++c) { qn[c] = a[0][c] * rq; kn[c] = a[1][c] * rk; }
            *(LAS v4u*)(QI + i * QS + 8 * cg) = (v4u){pk2(qn[0], qn[1]), pk2(qn[2], qn[3]), pk2(qn[4], qn[5]), pk2(qn[6], qn[7])};
            *(LAS v4u*)(KI + i * QS + 8 * cg) = (v4u){pk2(kn[0], kn[1]), pk2(kn[2], kn[3]), pk2(kn[4], kn[5]), pk2(kn[6], kn[7])};
            *(GAS v4u*)(F.QGc() + ((size_t)ci * 64 + i) * 128 + 8 * cg) = (v4u){pk2(qn[0] * eg, qn[1] * eg), pk2(qn[2] * eg, qn[3] * eg), pk2(qn[4] * eg, qn[5] * eg), pk2(qn[6] * eg, qn[7] * eg)};
#pragma unroll
            for (int c = 0; c < 8; ++c) F.KDTc()[(size_t)ci * 8192 + (8 * cg + c) * 64 + i] = (bf16)f2bf(kn[c] * ed);
            *(LAS v4u*)(R16 + i * 256 + 8 * cg) = (v4u){pk2(a[2][0] * be, a[2][1] * be), pk2(a[2][2] * be, a[2][3] * be), pk2(a[2][4] * be, a[2][5] * be), pk2(a[2][6] * be, a[2][7] * be)};
            *(LAS v4u*)(R16 + i * 256 + 128 + 8 * cg) = (v4u){pk2(kn[0] * bg, kn[1] * bg), pk2(kn[2] * bg, kn[3] * bg), pk2(kn[4] * bg, kn[5] * bg), pk2(kn[6] * bg, kn[7] * bg)};
        }
#undef P2_LOADG
        LDS_BARRIER();
        {
            const int tm = wl;
            f32x4 kk[4], kqv[4];
#pragma unroll
            for (int t4 = 0; t4 < 4; ++t4) { kk[t4] = (f32x4){0.f, 0.f, 0.f, 0.f}; kqv[t4] = (f32x4){0.f, 0.f, 0.f, 0.f}; }
#pragma unroll
            for (int ks = 0; ks < 4; ++ks) {
                const bf16x8 ak = *(const LAS bf16x8*)(KI + (16 * tm + m16) * QS + 32 * ks + 8 * kq);
#pragma unroll
                for (int t4 = 0; t4 < 4; ++t4) {
                    const bf16x8 bk = *(const LAS bf16x8*)(KI + (16 * t4 + m16) * QS + 32 * ks + 8 * kq);
                    const bf16x8 bq = *(const LAS bf16x8*)(QI + (16 * t4 + m16) * QS + 32 * ks + 8 * kq);
                    kk[t4] = __builtin_amdgcn_mfma_f32_16x16x32_bf16(ak, bk, kk[t4], 0, 0, 0);
                    kqv[t4] = __builtin_amdgcn_mfma_f32_16x16x32_bf16(ak, bq, kqv[t4], 0, 0, 0);
                }
            }
#pragma unroll
            for (int t4 = 0; t4 < 4; ++t4) {
                const int i = 16 * t4 + m16, j0 = 16 * tm + 4 * kq; const float Gi = SM[i]; float o4[4];
#pragma unroll
                for (int r = 0; r < 4; ++r) { const int j = j0 + r; o4[r] = (i >= j) ? kqv[t4][r] * __expf(Gi - SM[j]) : 0.f; }
                *(GAS unsigned long long*)(F.QKc() + ((size_t)ci * 64 + i) * 64 + j0) = (unsigned long long)pk2(o4[0], o4[1]) | ((unsigned long long)pk2(o4[2], o4[3]) << 32);
            }
            LDS_BARRIER();
#pragma unroll
            for (int t4 = 0; t4 < 4; ++t4) {
                const int j = 16 * t4 + m16; const float Gj = SM[j];
#pragma unroll
                for (int r = 0; r < 4; ++r) { const int i = 16 * tm + 4 * kq + r; Lm[i * 64 + j] = (i > j) ? SM[64 + i] * kk[t4][r] * __expf(SM[i] - Gj) : 0.f; }
            }
        }
        LDS_BARRIER();
        if (wl < 2) {
            const int c2 = 64 * wl + lane;
            LAS float* Lb = Lm; asm volatile("" : "+v"(Lb));
            f32x2 x[64];
#pragma unroll
            for (int i = 0; i < 64; ++i) { const unsigned rw = *(const LAS unsigned*)(R16 + i * 256 + 2 * c2); x[i] = (f32x2){__uint_as_float(rw << 16), __uint_as_float(rw & 0xffff0000u)}; }
#pragma unroll
            for (int i = 1; i < 64; ++i) { f32x2 a0 = {0.f, 0.f}, a1 = {0.f, 0.f};
#pragma unroll
                for (int j4 = 0; j4 < (i + 3) / 4; ++j4) { const f32x4 l = *(const LAS f32x4*)(Lb + i * 64 + 4 * j4);
                    a0 = a0 + x[4 * j4] * l.x; a1 = a1 + x[4 * j4 + 1] * l.y; a0 = a0 + x[4 * j4 + 2] * l.z; a1 = a1 + x[4 * j4 + 3] * l.w; }
                x[i] = x[i] - (a0 + a1); asm volatile("" ::: "memory"); }
            if (wl == 0) { float* up = F.UT() + (size_t)ci * 8192 + 2 * lane;
#pragma unroll
                for (int i = 0; i < 64; ++i) *(GAS f32x2*)(up + i * 128) = x[i];
            } else { bf16* wp = F.WC() + (size_t)ci * 8192 + 2 * lane;
#pragma unroll
                for (int i = 0; i < 64; ++i) *(GAS unsigned*)(wp + i * 128) = pk2(x[i].x, x[i].y); }
        }
        LDS_BARRIER();
    }
}
constexpr int G2_W = 0, G2_QG = 17408, G2_QK = 34816, G2_KDT = 44032, G2_WAVE = 62464, G2_WAVE_BYTES = 6656, G2_END = G2_WAVE + 8 * G2_WAVE_BYTES;
static_assert(G2_END <= RING_BYTES, "G2 LDS");
constexpr int N_SCAN_ITEMS = NBP * NH + NBS * NH;
__device__ __forceinline__ void gdn_scan_item(Frame& F, int item) {
    int NC, ci0, T, row0, h; const float* s0 = nullptr; float* sout;
    if (item < NBP * NH) { NC = SEQ / 64; ci0 = item * 32; T = SEQ; row0 = (item >> 3) * SEQ; h = item & 7; sout = F.out() + OUT_SSMP + (size_t)item * 16384; }
    else { const int sb = item - NBP * NH; NC = 1; ci0 = NCHUNK_P + sb; T = TS; row0 = MP + (sb >> 3) * TS; h = sb & 7; s0 = F.state_ssm() + (size_t)sb * 16384; sout = F.out() + OUT_SSMS + (size_t)sb * 16384; }
    const int s = F.wave; int lane = lane_id(); asm volatile("" : "+v"(lane));
    const int n = lane & 15, kq = lane >> 4, tid = 64 * s + lane;
    LAS unsigned char* L = F.lds;
    LAS unsigned char* Vb = L + G2_WAVE + s * G2_WAVE_BYTES; LAS unsigned char* Sb = Vb + 2304;
    f32x4 S[8];
#pragma unroll
    for (int dt = 0; dt < 8; ++dt)
#pragma unroll
        for (int r = 0; r < 4; ++r) S[dt][r] = s0 ? s0[(size_t)(16 * dt + 4 * kq + r) * 128 + 16 * s + n] : 0.f;
    v4u st[7]; f32x4 ut[4];
#define G2_LOAD(ci_) do { const size_t cb = (size_t)(ci_); \
        _Pragma("unroll") for (int q = 0; q < 2; ++q) { const int p = tid + 512 * q; st[q] = *(const GAS v4u*)(F.WC() + cb * 8192 + (p >> 4) * 128 + (p & 15) * 8); st[2 + q] = *(const GAS v4u*)(F.QGc() + cb * 8192 + (p >> 4) * 128 + (p & 15) * 8); \
            st[5 + q] = *(const GAS v4u*)(F.KDTc() + cb * 8192 + (p >> 3) * 64 + (p & 7) * 8); } \
        st[4] = *(const GAS v4u*)(F.QKc() + cb * 4096 + (tid >> 3) * 64 + (tid & 7) * 8); \
        _Pragma("unroll") for (int rt = 0; rt < 4; ++rt) _Pragma("unroll") for (int r = 0; r < 4; ++r) ut[rt][r] = F.UT()[(cb * 64 + 16 * rt + 4 * kq + r) * 128 + 16 * s + n]; } while (0)
#define G2_STORE() do { \
        _Pragma("unroll") for (int q = 0; q < 2; ++q) { const int p = tid + 512 * q; *(LAS v4u*)(L + G2_W + (p >> 4) * 272 + (p & 15) * 16) = st[q]; *(LAS v4u*)(L + G2_QG + (p >> 4) * 272 + (p & 15) * 16) = st[2 + q]; \
            *(LAS v4u*)(L + G2_KDT + (p >> 3) * 144 + (p & 7) * 16) = st[5 + q]; } \
        *(LAS v4u*)(L + G2_QK + (tid >> 3) * 144 + (tid & 7) * 16) = st[4]; } while (0)
    G2_LOAD(ci0);
    G2_STORE();
    f32x4 uc[4];
#pragma unroll
    for (int rt = 0; rt < 4; ++rt) uc[rt] = ut[rt];
#pragma unroll
    for (int dt = 0; dt < 8; ++dt) *(LAS unsigned long long*)(Sb + n * 272 + (16 * dt + 4 * kq) * 2) = (unsigned long long)pk2(S[dt][0], S[dt][1]) | ((unsigned long long)pk2(S[dt][2], S[dt][3]) << 32);
    LDS_BARRIER();
    for (int c = 0; c < NC; ++c) {
        const float egl = F.EGL()[ci0 + c];
        if (c + 1 < NC) G2_LOAD(ci0 + c + 1);
        LDS_WAIT(); asm volatile("" ::: "memory");
        bf16x8 sbf[4];
#pragma unroll
        for (int ks = 0; ks < 4; ++ks) sbf[ks] = *(const LAS bf16x8*)(Sb + n * 272 + (32 * ks + 8 * kq) * 2);
        f32x4 vn[4], oo[4];
#pragma unroll
        for (int rt = 0; rt < 4; ++rt) {
            f32x4 acc = {0.f, 0.f, 0.f, 0.f}, ao = {0.f, 0.f, 0.f, 0.f};
#pragma unroll
            for (int ks = 0; ks < 4; ++ks) {
                const bf16x8 aw = *(const LAS bf16x8*)(L + G2_W + (16 * rt + n) * 272 + (32 * ks + 8 * kq) * 2);
                const bf16x8 aq = *(const LAS bf16x8*)(L + G2_QG + (16 * rt + n) * 272 + (32 * ks + 8 * kq) * 2);
                acc = __builtin_amdgcn_mfma_f32_16x16x32_bf16(aw, sbf[ks], acc, 0, 0, 0);
                ao = __builtin_amdgcn_mfma_f32_16x16x32_bf16(aq, sbf[ks], ao, 0, 0, 0);
            }
            vn[rt] = uc[rt] - acc; oo[rt] = ao;
            *(LAS unsigned long long*)(Vb + n * 144 + (16 * rt + 4 * kq) * 2) = (unsigned long long)pk2(vn[rt][0], vn[rt][1]) | ((unsigned long long)pk2(vn[rt][2], vn[rt][3]) << 32);
        }
        LDS_WAIT(); asm volatile("" ::: "memory");
        bf16x8 vbf[2];
#pragma unroll
        for (int k2 = 0; k2 < 2; ++k2) vbf[k2] = *(const LAS bf16x8*)(Vb + n * 144 + (32 * k2 + 8 * kq) * 2);
#pragma unroll
        for (int rt = 0; rt < 4; ++rt) {
#pragma unroll
            for (int k2 = 0; k2 < 2; ++k2) { const bf16x8 a = *(const LAS bf16x8*)(L + G2_QK + (16 * rt + n) * 144 + (32 * k2 + 8 * kq) * 2); oo[rt] = __builtin_amdgcn_mfma_f32_16x16x32_bf16(a, vbf[k2], oo[rt], 0, 0, 0); }
#pragma unroll
            for (int r = 0; r < 4; ++r) { const int t = 64 * c + 16 * rt + 4 * kq + r; if (t < T) F.OG()[(size_t)(row0 + t) * 1024 + h * 128 + 16 * s + n] = (bf16)f2bf(oo[rt][r]); }
        }
#pragma unroll
        for (int dt = 0; dt < 8; ++dt) {
            f32x4 acc = S[dt] * egl;
#pragma unroll
            for (int k2 = 0; k2 < 2; ++k2) { const bf16x8 a = *(const LAS bf16x8*)(L + G2_KDT + (16 * dt + n) * 144 + (32 * k2 + 8 * kq) * 2); acc = __builtin_amdgcn_mfma_f32_16x16x32_bf16(a, vbf[k2], acc, 0, 0, 0); }
            S[dt] = acc;
            *(LAS unsigned long long*)(Sb + n * 272 + (16 * dt + 4 * kq) * 2) = (unsigned long long)pk2(acc[0], acc[1]) | ((unsigned long long)pk2(acc[2], acc[3]) << 32);
        }
        LDS_BARRIER();
        if (c + 1 < NC) { G2_STORE();
#pragma unroll
            for (int rt = 0; rt < 4; ++rt) uc[rt] = ut[rt]; }
        LDS_BARRIER();
    }
#pragma unroll
    for (int dt = 0; dt < 8; ++dt)
#pragma unroll
        for (int r = 0; r < 4; ++r) sout[(size_t)(16 * dt + 4 * kq + r) * 128 + 16 * s + n] = S[dt][r];
#undef G2_LOAD
#undef G2_STORE
}
template <bool SAMPLE> __device__ __forceinline__ void attn_row_item(Frame& F, int item, LAS float* wl) {
    typedef float f32x2 __attribute__((ext_vector_type(2)));
    const int h = item & 7, mi = item >> 3;
    int b, tq, nkeys, qrow, krow0;
    if (SAMPLE) { b = mi / TS; tq = mi % TS; nkeys = PAST + tq + 1; qrow = MP + mi; krow0 = MP + b * TS; }
    else { b = mi / SEQ; tq = mi % SEQ; nkeys = tq + 1; qrow = mi; krow0 = b * SEQ; }
    LAS float* ql = wl + 128;
    { const unsigned w = *(const GAS unsigned*)(F.QB() + (size_t)qrow * 1024 + h * 128 + 2 * F.lane);
      ql[2 * F.lane] = __uint_as_float(w << 16); ql[2 * F.lane + 1] = __uint_as_float(w & 0xffff0000u); }
    LDS_WAIT(); asm volatile("" ::: "memory");
    const float slope2 = exp2f(-(float)(h + 1)) * LOG2E;
    const int qpos = SAMPLE ? PAST + tq : tq;
    float M1 = -1e30f, M2 = -1e30f, l1 = 0.f, l2 = 0.f; f32x2 o1 = {0.f, 0.f}, o2 = {0.f, 0.f};
    for (int c0 = 0; c0 < nkeys; c0 += 64) {
        const int j = c0 + F.lane; const bool valid = j < nkeys;
        float s1 = -1e30f, s2 = -1e30f;
        if (valid) {
            float a1 = 0.f, a2 = 0.f;
            if (SAMPLE && j < PAST) {
                const int page = F.page_table()[b * NPAGES + (j >> 7)];
                const GAS f32x4* kp = (const GAS f32x4*)(F.cache_k() + ((size_t)(page * PAGE + (j & 127)) * NH + h) * 128);
#pragma unroll 4
                for (int i = 0; i < 16; ++i) { const f32x4 kv = kp[i]; const f32x4 qv = *(const LAS f32x4*)(ql + 4 * i); a1 += qv.x * kv.x + qv.y * kv.y + qv.z * kv.z + qv.w * kv.w; }
#pragma unroll 4
                for (int i = 16; i < 32; ++i) { const f32x4 kv = kp[i]; const f32x4 qv = *(const LAS f32x4*)(ql + 4 * i); a2 += qv.x * kv.x + qv.y * kv.y + qv.z * kv.z + qv.w * kv.w; }
            } else {
                const int kr = SAMPLE ? krow0 + (j - PAST) : krow0 + j;
                const GAS v4u* kp = (const GAS v4u*)(F.KB() + (size_t)kr * 1024 + h * 128);
#pragma unroll 4
                for (int i = 0; i < 16; ++i) { const v4u w = kp[i]; const f32x4 qa = *(const LAS f32x4*)(ql + 8 * i), qb = *(const LAS f32x4*)(ql + 8 * i + 4);
                    const float d = qa.x * __uint_as_float(w.x << 16) + qa.y * __uint_as_float(w.x & 0xffff0000u) + qa.z * __uint_as_float(w.y << 16) + qa.w * __uint_as_float(w.y & 0xffff0000u)
                                  + qb.x * __uint_as_float(w.z << 16) + qb.y * __uint_as_float(w.z & 0xffff0000u) + qb.z * __uint_as_float(w.w << 16) + qb.w * __uint_as_float(w.w & 0xffff0000u);
                    if (i < 8) a1 += d; else a2 += d; }
            }
            const float bias = slope2 * (float)(qpos - j);
            s1 = a1 - bias; s2 = a2 - bias;
        }
        const float n1 = fmaxf(M1, wave_max(s1)), n2 = fmaxf(M2, wave_max(s2));
        const float al1 = exp2f(M1 - n1), al2 = exp2f(M2 - n2);
        const float p1 = valid ? exp2f(s1 - n1) : 0.f, p2 = valid ? exp2f(s2 - n2) : 0.f;
        l1 = l1 * al1 + p1; l2 = l2 * al2 + p2; o1 = o1 * al1; o2 = o2 * al2; M1 = n1; M2 = n2;
        wl[F.lane] = p1; wl[64 + F.lane] = p2;
        LDS_WAIT(); asm volatile("" ::: "memory");
        const int nk = (nkeys - c0) < 64 ? (nkeys - c0) : 64;
        for (int jj = 0; jj < nk; ++jj) {
            const float pp1 = wl[jj], pp2 = wl[64 + jj]; const int jk = c0 + jj; f32x2 vv;
            if (SAMPLE && jk < PAST) { const int page = F.page_table()[b * NPAGES + (jk >> 7)];
                vv = *(const GAS f32x2*)(F.cache_v() + ((size_t)(page * PAGE + (jk & 127)) * NH + h) * 128 + 2 * F.lane); }
            else { const int kr = SAMPLE ? krow0 + (jk - PAST) : krow0 + jk; const unsigned w = *(const GAS unsigned*)(F.VB() + (size_t)kr * 1024 + h * 128 + 2 * F.lane);
                vv.x = __uint_as_float(w << 16); vv.y = __uint_as_float(w & 0xffff0000u); }
            o1 = o1 + vv * pp1; o2 = o2 + vv * pp2;
        }
        LDS_WAIT(); asm volatile("" ::: "memory");
    }
    const float L1 = 1.f / wave_sum(l1), L2 = 1.f / wave_sum(l2);
    const size_t oo = (size_t)qrow * 1024 + h * 128 + 2 * F.lane;
    *(GAS unsigned*)(F.O1b() + oo) = pk2(o1.x * L1, o1.y * L1); *(GAS unsigned*)(F.O2b() + oo) = pk2(o2.x * L2, o2.y * L2);
}
constexpr int SA_WAVE_BYTES = 16384, SA_ROW = 132, SA_PIMG = 8192, SA_PROW = 136;
__device__ __forceinline__ unsigned sa_offb(unsigned row, unsigned ch) { return 256u * row + 16u * (ch ^ (((row & 3u) << 2) | ((row >> 2) & 3u))); }
typedef short sa_v4i16 __attribute__((ext_vector_type(4)));
__device__ __forceinline__ sa_v4i16 sa_tr(const LAS unsigned char* p) { return __builtin_amdgcn_ds_read_tr16_b64_v4i16((LAS sa_v4i16*)p); }
__device__ __forceinline__ void sattn_unit(Frame& F, int unit) {
    typedef float f32x2 __attribute__((ext_vector_type(2)));
    int lane = F.lane; asm volatile("" : "+v"(lane));
    const int h = F.wave, n = lane & 15, kq = lane >> 4;
    const bool newtok = unit >= NBS * NSPLIT;
    const int b = newtok ? unit - NBS * NSPLIT : unit / NSPLIT, split = newtok ? NSPLIT : unit % NSPLIT;
    LAS unsigned char* WL = F.lds + RING_OFF + h * SA_WAVE_BYTES;
    LAS float* Ssc = (LAS float*)WL; LAS float* ALP = Ssc + 16 * SA_ROW;
    const float sl2 = exp2f(-(float)(h + 1)) * LOG2E;
    const size_t pi = (size_t)(b * NH + h) * NSP + split;
    if (!newtok) {
        bf16x8 aq[4];
#pragma unroll
        for (int ks = 0; ks < 4; ++ks) {
            const bool nz = (n < 8) == (ks < 2);
            const bf16* qp = F.QB() + (size_t)(MP + b * TS + (n & 7)) * 1024 + h * 128 + (n >> 3) * 64 + 32 * (ks & 1) + 8 * kq;
            aq[ks] = nz ? *(const GAS bf16x8*)qp : (bf16x8){0, 0, 0, 0, 0, 0, 0, 0};
        }
        f32x4 acc[8];
#pragma unroll
        for (int c = 0; c < 8; ++c) acc[c] = (f32x4){0.f, 0.f, 0.f, 0.f};
        float m_run[4], l_run[4];
#pragma unroll
        for (int r = 0; r < 4; ++r) { m_run[r] = -1e30f; l_run[r] = 0.f; }
        const int rp2 = lane >> 5, c4 = lane & 31, kr = rp2, ch = c4 >> 1, hf = c4 & 1;
        const unsigned tq_ = (lane & 15) >> 2, tp_ = lane & 3;
#pragma unroll 1
        for (int pgi = 0; pgi < PGU; ++pgi) {
            const int pg = split * PGU + pgi, phys = F.page_table()[b * NPAGES + pg];
            const float* kbase = F.cache_k() + ((size_t)phys * PAGE * NH + h) * 128;
            const float* vbase = F.cache_v() + ((size_t)phys * PAGE * NH + h) * 128;
            f32x4 sc[8];
            const unsigned roff = (unsigned)(rp2 * 1024 + 4 * c4) * 4u;
            {
                f32x4 kv[2][8];
#pragma unroll
                for (int i = 0; i < 8; ++i) kv[0][i] = __builtin_nontemporal_load((const GAS f32x4*)((const GAS char*)(kbase + (size_t)(2 * i) * 1024) + roff));
#pragma unroll
                for (int kt = 0; kt < 8; ++kt) {
                    if (kt + 1 < 8) {
#pragma unroll
                        for (int i = 0; i < 8; ++i) kv[(kt + 1) & 1][i] = __builtin_nontemporal_load((const GAS f32x4*)((const GAS char*)(kbase + (size_t)(16 * (kt + 1) + 2 * i) * 1024) + roff));
                    }
#pragma unroll
                    for (int i = 0; i < 8; ++i) { const f32x4 v = kv[kt & 1][i]; *(LAS unsigned long long*)(WL + (2 * i + rp2) * 272 + c4 * 8) = (unsigned long long)pk2(v.x, v.y) | ((unsigned long long)pk2(v.z, v.w) << 32); }
                    LDS_WAIT(); asm volatile("" ::: "memory");
                    f32x4 a4 = {0.f, 0.f, 0.f, 0.f};
#pragma unroll
                    for (int ks = 0; ks < 4; ++ks) a4 = __builtin_amdgcn_mfma_f32_16x16x32_bf16(aq[ks], *(const LAS bf16x8*)(WL + n * 272 + (32 * ks + 8 * kq) * 2), a4, 0, 0, 0);
                    LDS_WAIT(); asm volatile("" ::: "memory");
                    const int kpos = pg * PAGE + 16 * kt + n;
#pragma unroll
                    for (int r = 0; r < 4; ++r) sc[kt][r] = a4[r] - sl2 * (float)(PAST + ((4 * kq + r) & 7) - kpos);
                }
            }
            f32x4 vl[16];
#pragma unroll
            for (int i = 0; i < 16; ++i) vl[i] = __builtin_nontemporal_load((const GAS f32x4*)((const GAS char*)(vbase + (size_t)(2 * i) * 1024) + roff));
#pragma unroll
            for (int r = 0; r < 4; ++r) {
                float mx = sc[0][r];
#pragma unroll
                for (int kt = 1; kt < 8; ++kt) mx = fmaxf(mx, sc[kt][r]);
                mx = max16(mx);
                const float mn = fmaxf(m_run[r], mx), al = __builtin_amdgcn_exp2f(m_run[r] - mn); float ls = 0.f;
#pragma unroll
                for (int kt = 0; kt < 8; ++kt) { const float p = __builtin_amdgcn_exp2f(sc[kt][r] - mn); sc[kt][r] = p; ls += p; }
                ls = sum16(ls);
                l_run[r] = l_run[r] * al + ls; m_run[r] = mn;
#pragma unroll
                for (int c = 0; c < 8; ++c) acc[c][r] *= al;
            }
#pragma unroll
            for (int kt = 0; kt < 8; ++kt)
#pragma unroll
                for (int r = 0; r < 4; ++r) *(LAS bf16*)(WL + SA_PIMG + ((4 * kq + r) * SA_PROW + 16 * kt + n) * 2) = (bf16)f2bf(sc[kt][r]);
#pragma unroll 1
            for (int t32 = 0; t32 < 4; ++t32) {
                unsigned tq2 = tq_, kr2 = (unsigned)kr; asm volatile("" : "+v"(tq2), "+v"(kr2));
#pragma unroll
                for (int i = 0; i < 16; ++i) { const f32x4 v = vl[i];
                    *(LAS unsigned long long*)(WL + sa_offb(2 * i + kr2, ch) + 8 * hf) = (unsigned long long)pk2(v.x, v.y) | ((unsigned long long)pk2(v.z, v.w) << 32); }
                if (t32 + 1 < 4) {
#pragma unroll
                    for (int i = 0; i < 16; ++i) vl[i] = __builtin_nontemporal_load((const GAS f32x4*)((const GAS char*)(vbase + (size_t)(32 * (t32 + 1) + 2 * i) * 1024) + roff));
                }
                LDS_WAIT(); asm volatile("" ::: "memory");
                const bf16x8 pa = *(const LAS bf16x8*)(WL + SA_PIMG + (n * SA_PROW + 32 * t32 + 8 * kq) * 2);
#pragma unroll
                for (int c = 0; c < 8; ++c) {
                    const sa_v4i16 lo = sa_tr(WL + sa_offb(8 * kq + tq2, 2 * c + (tp_ >> 1)) + 8 * (tp_ & 1));
                    const sa_v4i16 hi = sa_tr(WL + sa_offb(8 * kq + 4 + tq2, 2 * c + (tp_ >> 1)) + 8 * (tp_ & 1));
                    const bf16x8 vb = {lo[0], lo[1], lo[2], lo[3], hi[0], hi[1], hi[2], hi[3]};
                    acc[c] = __builtin_amdgcn_mfma_f32_16x16x32_bf16(pa, vb, acc[c], 0, 0, 0);
                }
                LDS_WAIT(); asm volatile("" ::: "memory");
            }
        }
        if (n == 0) {
#pragma unroll
            for (int r = 0; r < 4; ++r) { F.PM()[pi * 16 + 4 * kq + r] = m_run[r]; F.PL()[pi * 16 + 4 * kq + r] = l_run[r]; }
        }
#pragma unroll
        for (int c = 0; c < 8; ++c)
#pragma unroll
            for (int r = 0; r < 4; ++r) F.PO()[(pi * 16 + 4 * kq + r) * 128 + 16 * c + n] = acc[c][r];
    } else {
        f32x2 o[16];
#pragma unroll
        for (int m = 0; m < 16; ++m) o[m] = (f32x2){0.f, 0.f};
        float m_run = -1e30f, l_run = 0.f;
        const size_t krow0 = (size_t)(MP + b * TS);
        const bf16* qp = F.QB() + (krow0 + (n & 7)) * 1024 + h * 128 + (n >> 3) * 64;
#pragma unroll
        for (int kk = 0; kk < 2; ++kk) {
            const int t = kq + 4 * kk; const bf16* kp = F.KB() + (krow0 + t) * 1024 + h * 128 + (n >> 3) * 64; float acc = 0.f;
            for (int d = 0; d < 64; d += 2) { const unsigned qw = *(const GAS unsigned*)(qp + d), kw = *(const GAS unsigned*)(kp + d);
                acc += __uint_as_float(qw << 16) * __uint_as_float(kw << 16) + __uint_as_float(qw & 0xffff0000u) * __uint_as_float(kw & 0xffff0000u); }
            const int tq = n & 7;
            Ssc[n * SA_ROW + t] = (t <= tq) ? acc - sl2 * (float)(tq - t) : -1e30f;
        }
        LDS_WAIT(); asm volatile("" ::: "memory");
        {
            const f32x4 s0 = *(const LAS f32x4*)(Ssc + n * SA_ROW), s1 = *(const LAS f32x4*)(Ssc + n * SA_ROW + 4);
            const float mx = fmaxf(fmaxf(fmaxf(s0.x, s0.y), fmaxf(s0.z, s0.w)), fmaxf(fmaxf(s1.x, s1.y), fmaxf(s1.z, s1.w)));
            f32x4 p0, p1; p0.x = __builtin_amdgcn_exp2f(s0.x - mx); p0.y = __builtin_amdgcn_exp2f(s0.y - mx); p0.z = __builtin_amdgcn_exp2f(s0.z - mx); p0.w = __builtin_amdgcn_exp2f(s0.w - mx); p1.x = __builtin_amdgcn_exp2f(s1.x - mx); p1.y = __builtin_amdgcn_exp2f(s1.y - mx); p1.z = __builtin_amdgcn_exp2f(s1.z - mx); p1.w = __builtin_amdgcn_exp2f(s1.w - mx);
            m_run = mx; l_run = (p0.x + p0.y) + (p0.z + p0.w) + (p1.x + p1.y) + (p1.z + p1.w);
            LDS_WAIT(); asm volatile("" ::: "memory");
            if (kq == 0) { *(LAS f32x4*)(Ssc + n * SA_ROW) = p0; *(LAS f32x4*)(Ssc + n * SA_ROW + 4) = p1; }
        }
        LDS_WAIT(); asm volatile("" ::: "memory");
#pragma unroll
        for (int t = 0; t < TS; ++t) {
            const unsigned w = *(const GAS unsigned*)(F.VB() + (krow0 + t) * 1024 + h * 128 + 2 * lane); const f32x2 v2 = {__uint_as_float(w << 16), __uint_as_float(w & 0xffff0000u)};
#pragma unroll
            for (int m = 0; m < 16; ++m) o[m] = o[m] + v2 * Ssc[m * SA_ROW + t];
        }
        LDS_WAIT(); asm volatile("" ::: "memory");
        if (kq == 0) { F.PM()[pi * 16 + n] = m_run; F.PL()[pi * 16 + n] = l_run; }
#pragma unroll
        for (int m = 0; m < 16; ++m) *(GAS f32x2*)(F.PO() + (pi * 16 + m) * 128 + 2 * lane) = o[m];
    }
}
constexpr int N_SATT_UNITS = NBS * NSPLIT + NBS;
constexpr int N_ATT_S = MS * NH, N_ATT_UNITS = NBP * NH * 2 * 2 * (SEQ / 256);
constexpr int CW_QCTR2 = 128;
#ifndef FLASH_XCD
#define FLASH_XCD 1
#endif
__device__ __forceinline__ void flash_loop(Frame& F, int ctr) {
#if FLASH_XCD
    const int x0 = (int)(xb_xcc_id() & 7u);
    int qi = 0;
    for (;;) {
        const int xq = (x0 + qi) & 7;
        __syncthreads();
        if (F.wave == 0 && lane_id() == 0) F.MISC[16] = __hip_atomic_fetch_add(F.ctl + ctr + 64 * xq, 1u, RLX_AGENT);
        __syncthreads();
        const int uu = (int)F.MISC[16];
        if (uu >= N_ATT_UNITS / 8) { if (++qi == 8) break; continue; }
        const int half = uu >> 6, within = uu & 63, qb = 7 - (within >> 3), r = within & 7, b = half * 2 + (r >> 2), h = xq, map = (r >> 1) & 1, vhalf = r & 1;
#else
    for (;;) {
        __syncthreads();
        if (F.wave == 0 && lane_id() == 0) F.MISC[16] = __hip_atomic_fetch_add(F.ctl + ctr, 1u, RLX_AGENT);
        __syncthreads();
        const int uu = (int)F.MISC[16];
        if (uu >= N_ATT_UNITS * REP_FLASH) break;
        const int u = uu & (N_ATT_UNITS - 1);
        const int qb = 7 - (u >> 7), vh = u & 127, b = vh >> 5, h = (vh >> 2) & 7, map = (vh >> 1) & 1, vhalf = vh & 1;
#endif
        const attn_body::bf16* Qp = (const attn_body::bf16*)(F.QB() + h * 128 + map * 64);
        const attn_body::bf16* Kp = (const attn_body::bf16*)(F.KB() + h * 128 + map * 64);
        const attn_body::bf16* Vp = (const attn_body::bf16*)(F.VB() + h * 128 + vhalf * 64);
        attn_body::bf16* Op = (attn_body::bf16*)((map ? F.O2b() : F.O1b()) + h * 128 + vhalf * 64);
        attn_body::attn_unit<8>(b, 0, qb, Qp, Kp, Vp, Op, exp2f(-(float)(h + 1)) * LOG2E, F.lds_g + RING_OFF, F.tid);
    }
}
__device__ __forceinline__ void sattn_loop(Frame& F) {
    for (;;) {
        __syncthreads();
        if (F.wave == 0 && lane_id() == 0) F.MISC[16] = __hip_atomic_fetch_add(F.ctl + CW_QCTR, 1u, RLX_AGENT);
        __syncthreads();
        const int uq = (int)F.MISC[16];
        if (uq >= N_SATT_UNITS * REP_SATT) break;
        sattn_unit(F, REP_SATT > 1 ? uq % N_SATT_UNITS : uq);
    }
}
constexpr int N_MEM_WG = 56;
__device__ __forceinline__ void mixer_phase(Frame& F) {
#define MIX_TID() do { int t_ = F.wave * 64 + lane_id(); asm volatile("" : "+v"(t_)); F.tid = t_; F.lane = t_ & 63; } while (0)
    if ((int)blockIdx.x >= F.G - N_MEM_WG) { MIX_TID(); sattn_loop(F); }
    MIX_TID();
    for (int rp = 0; rp < REP_SCAN; ++rp) {
        const int it = (int)blockIdx.x + (F.G < N_SCAN_ITEMS ? 1 << 20 : 0);
        if (it < N_SCAN_ITEMS) {
            if (it >= NBP * NH) { gdn_chunk_prep(F, NCHUNK_P + (it - NBP * NH), NCHUNK_P + (it - NBP * NH) + 1, 1); asm volatile("s_waitcnt vmcnt(0)" ::: "memory"); __syncthreads(); }
            gdn_scan_item(F, it);
        }
    }
    MIX_TID();
    flash_loop(F, CW_QCTR2);
    MIX_TID();
    sattn_loop(F);
#undef MIX_TID
}
__device__ __forceinline__ void combine_phase(Frame& F) {
    typedef float f32x2 __attribute__((ext_vector_type(2)));
    static_assert(NSP <= 64, "one partial per lane in the sample rows' merge");
    const int lane = F.lane;
    const float lam = __expf(wave_sum(F.lq1()[lane] * F.lk1()[lane])) - __expf(wave_sum(F.lq2()[lane] * F.lk2()[lane])) + 0.2f;
    {
        const f32x2 sw = *(const GAS f32x2*)(F.subln_w() + 2 * lane), dw = *(const GAS f32x2*)(F.dnorm_w() + 2 * lane);
        for (int item = F.gw; item < MS * NH; item += F.NGW) {
            const int ms = item >> 3, h = item & 7, m = MP + ms, b = ms / TS, tq = ms % TS; const size_t p0 = (size_t)(b * NH + h) * NSP; f32x2 om[2];
#pragma unroll
            for (int mp = 0; mp < 2; ++mp) { const int r = mp * 8 + tq;
                const float pm = lane < NSP ? F.PM()[(p0 + lane) * 16 + r] : -1e30f, pl = lane < NSP ? F.PL()[(p0 + lane) * 16 + r] : 0.f;
                const float M = wave_max(pm), wgt = lane < NSP ? exp2f(pm - M) : 0.f, L = wave_sum(wgt * pl);
                f32x2 acc = {0.f, 0.f};
#pragma unroll
                for (int i = 0; i < NSP; ++i) { const float wi = __builtin_bit_cast(float, __builtin_amdgcn_readlane(__builtin_bit_cast(int, wgt), i)); acc = acc + *(const GAS f32x2*)(F.PO() + ((p0 + i) * 16 + r) * 128 + 2 * lane) * wi; }
                om[mp] = acc * (1.f / L); }
            const f32x2 d = om[0] - om[1] * lam;
            const size_t o = (size_t)m * 1024 + h * 128 + 2 * lane;
            const float rs = rsqrtf(wave_sum(d.x * d.x + d.y * d.y) * (1.f / 128.f) + EPS) * 0.8f;
            *(GAS unsigned*)(F.MIX() + (size_t)m * DM + h * 128 + 2 * lane) = pk2(d.x * rs * sw.x, d.y * rs * sw.y);
            const unsigned gw = *(const GAS unsigned*)(F.OG() + o); const f32x2 g = {__uint_as_float(gw << 16), __uint_as_float(gw & 0xffff0000u)};
            const float rg = rsqrtf(wave_sum(g.x * g.x + g.y * g.y) * (1.f / 128.f) + EPS);
            const unsigned zw = *(const GAS unsigned*)(F.Zb() + o); const f32x2 z = {__uint_as_float(zw << 16), __uint_as_float(zw & 0xffff0000u)};
            *(GAS unsigned*)(F.MIX() + (size_t)m * DM + 1024 + h * 128 + 2 * lane) = pk2(g.x * rg * dw.x * silu_f(z.x), g.y * rg * dw.y * silu_f(z.y));
        }
    }
    {
        const int hq = lane >> 4, c8 = lane & 15;
        float sw[8], dw[8];
#pragma unroll
        for (int e = 0; e < 8; ++e) { sw[e] = F.subln_w()[8 * c8 + e] * 0.8f; dw[e] = F.dnorm_w()[8 * c8 + e]; }
#define CB_LOAD(S, item_) do { const int m_ = (item_) >> 1, col_ = (((item_) & 1) * 4 + hq) * 128 + 8 * c8; \
            S##a = *(const GAS v4u*)(F.O1b() + (size_t)m_ * 1024 + col_); S##b = *(const GAS v4u*)(F.O2b() + (size_t)m_ * 1024 + col_); \
            S##z = *(const GAS v4u*)(F.Zb() + (size_t)m_ * 1024 + col_); S##g = *(const GAS v4u*)(F.OG() + (size_t)m_ * 1024 + col_); } while (0)
#define CB_PROC(S, item_) do { const int m = (item_) >> 1, col = (((item_) & 1) * 4 + hq) * 128 + 8 * c8; \
            float d[8], g[8], z[8]; \
            const unsigned w1[4] = {S##a.x, S##a.y, S##a.z, S##a.w}, w2[4] = {S##b.x, S##b.y, S##b.z, S##b.w}, wz[4] = {S##z.x, S##z.y, S##z.z, S##z.w}, wg[4] = {S##g.x, S##g.y, S##g.z, S##g.w}; \
            _Pragma("unroll") for (int e = 0; e < 4; ++e) { d[2 * e] = __uint_as_float(w1[e] << 16) - lam * __uint_as_float(w2[e] << 16); d[2 * e + 1] = __uint_as_float(w1[e] & 0xffff0000u) - lam * __uint_as_float(w2[e] & 0xffff0000u); \
                z[2 * e] = __uint_as_float(wz[e] << 16); z[2 * e + 1] = __uint_as_float(wz[e] & 0xffff0000u); g[2 * e] = __uint_as_float(wg[e] << 16); g[2 * e + 1] = __uint_as_float(wg[e] & 0xffff0000u); } \
            float sd = 0.f, sg = 0.f; \
            _Pragma("unroll") for (int e = 0; e < 8; ++e) { sd += d[e] * d[e]; sg += g[e] * g[e]; } \
            const float rs = rsqrtf(sum16(sd) * (1.f / 128.f) + EPS), rg = rsqrtf(sum16(sg) * (1.f / 128.f) + EPS); \
            *(GAS v4u*)(F.MIX() + (size_t)m * DM + col) = (v4u){pk2(d[0] * rs * sw[0], d[1] * rs * sw[1]), pk2(d[2] * rs * sw[2], d[3] * rs * sw[3]), pk2(d[4] * rs * sw[4], d[5] * rs * sw[5]), pk2(d[6] * rs * sw[6], d[7] * rs * sw[7])}; \
            _Pragma("unroll") for (int e = 0; e < 8; ++e) g[e] = g[e] * rg * dw[e] * silu_f(z[e]); \
            *(GAS v4u*)(F.MIX() + (size_t)m * DM + 1024 + col) = (v4u){pk2(g[0], g[1]), pk2(g[2], g[3]), pk2(g[4], g[5]), pk2(g[6], g[7])}; } while (0)
        {
            constexpr int TOT = 2 * MP; const int st = F.NGW;
            v4u Aa, Ab, Az, Ag, Ba, Bb, Bz, Bg, Ca, Cb, Cz, Cg;
            if (F.gw < TOT) CB_LOAD(A, F.gw);
            if (F.gw + st < TOT) CB_LOAD(B, F.gw + st);
            for (int item = F.gw; item < TOT; item += 3 * st) {
                if (item + 2 * st < TOT) CB_LOAD(C, item + 2 * st);
                CB_PROC(A, item);
                if (item + 3 * st < TOT) CB_LOAD(A, item + 3 * st);
                if (item + st < TOT) CB_PROC(B, item + st);
                if (item + 4 * st < TOT) CB_LOAD(B, item + 4 * st);
                if (item + 2 * st < TOT) CB_PROC(C, item + 2 * st);
            }
        }
#undef CB_LOAD
#undef CB_PROC
    }
}
__global__ void __launch_bounds__(NTHREADS, 2) fwd_kernel(Args args) {
    extern __shared__ __attribute__((aligned(16))) unsigned char lds[];
    Frame F(args);
    F.lds = (LAS unsigned char*)lds; F.MISC = (volatile LAS unsigned*)(F.lds + MISC_OFF); F.lds_g = (char*)lds;
    F.tid = threadIdx.x; F.lane = F.tid & 63; F.wave = __builtin_amdgcn_readfirstlane(F.tid >> 6);
    F.G = gridDim.x; F.gw = (int)blockIdx.x * NWAVES + F.wave; F.NGW = F.G * NWAVES;
    F.ctl = (gu32*)(args.ws + WS_CTL); F.z = 0; F.ws = args.ws;
    for (int u = F.tid; u < (LDS_BYTES - LDSCTL_OFF) / 4; u += NTHREADS) ((LAS unsigned*)(F.lds + LDSCTL_OFF))[u] = 0u;
    __syncthreads();
    XcdBarrier bar; bar.bar = (unsigned*)(F.ctl + CW_BAR); bar.x = 0; bar.st = nullptr;
    if (MK_N_LAUNCHES == 1) bar = xcd_barrier_post((unsigned*)(F.ctl + CW_BAR), F.MISC + 8, F.tid == 0);
    const int lo = args.ph_lo, hi = args.ph_hi;
#define IN(k) (lo <= (k) && (k) < hi)
#define PB() do { int t_ = F.wave * 64 + lane_id(); asm volatile("" : "+v"(t_)); F.tid = t_; F.lane = t_ & 63; int z_ = 0; asm volatile("" : "+s"(z_)); F.z = z_; F.ws = args.ws + z_; } while (0)
#define SEAM(k) do { if (IN(k) && IN((k) + 1)) { if (MK_N_LAUNCHES == 1) xcd_barrier(bar, F.wave == 0 && lane_id() == 0); } } while (0)
#ifndef ROT_ALL
#define ROT_ALL 0
#endif
#define GEMM_PH(EpiT, Eobj, Aptr, Bptr, N_, K_) GEMM_PHX(EpiT, Eobj, Aptr, Bptr, N_, K_, ROT_ALL)
#define GEMM_PHR(EpiT, Eobj, Aptr, Bptr, N_, K_) GEMM_PHX(EpiT, Eobj, Aptr, Bptr, N_, K_, 1)
#define GEMM_PHX(EpiT, Eobj, Aptr, Bptr, N_, K_, ROT_) do { pg8::Gemm g{Aptr, Bptr, MP, N_, K_, (ROT_) ? (((int)blockIdx.x & 7) * ((K_) / 64) / 8) & ~1 : 0}; pg8::StaticOrder S; S.init(MP, N_, F.G, (int)blockIdx.x); \
        pg8::gemm_phase<EpiT, pg8::StaticOrder, PG8_ALIGN, PG8_SP2>(F.lds + RING_OFF, g, S, Eobj, F.tid); } while (0)
    if (IN(0)) { PB(); for (int rp = 0; rp < REP_PRO; ++rp) p0_prologue(F); } SEAM(0);
#ifdef REP_BAR
    for (int rp = 0; rp < REP_BAR; ++rp) xcd_barrier(bar, F.wave == 0 && lane_id() == 0);
#endif
    if (IN(1)) { PB(); EpiAct E{F.ACT(), F.RS()}; for (int rp = 0; rp < REP_G1; ++rp) GEMM_PH(EpiAct, E, F.X0h(), F.W1GU(), GU, DM);
                 SkEpiAct SE{F.ACT() + (size_t)MP * FF, F.RS() + MP}; skinny_phase<2, 1>(F, F.X0h() + (size_t)MP * DM, F.W1GU(), DM, FF / 16, SE, 128);
#if CONV_TAILS
                 convert_matrix(F, F.down1(), FF, DM, DM, F.W1D(), 0, 128);
#endif
    } SEAM(1);
    if (IN(2)) { PB(); EpiBf E{F.F16()}; GEMM_PHR(EpiBf, E, F.ACT(), F.W1D(), DM, FF);
#ifdef REP_G2
        GEMM_PHR(EpiBf, E, F.ACT(), F.W1D(), DM, FF);
#endif
 SkEpiAddF32 SE{F.Fb() + (size_t)MP * DM}; skinny_phase<1, 2>(F, F.ACT() + (size_t)MP * FF, F.W1D(), FF, DM / 16, SE, 0); } SEAM(2);
    if (IN(3)) { PB(); for (int rp = 0; rp < REP_THIN; ++rp) thin_rows(F, F.X0h(), F.F16(), F.Fb(), 0.5f, F.ffn1_post(), F.X1h(), nullptr, F.RS()); } SEAM(3);
    if (IN(4)) { PB(); EpiIn E{F.QB(), F.KB(), F.VB(), F.QKVB(), F.Zb(), F.BA(), F.out(), F.RS()}; GEMM_PH(EpiIn, E, F.X1h(), F.WIN(), INW_PAD, DM);
#ifdef REP_WIN
        GEMM_PH(EpiIn, E, F.X1h(), F.WIN(), INW_PAD, DM);
#endif

                 SkEpiIn SE{F.QB() + (size_t)MP * 1024, F.KB() + (size_t)MP * 1024, F.VB() + (size_t)MP * 1024, F.QKVB() + (size_t)MP * CONVD, F.Zb() + (size_t)MP * 1024, F.BA() + (size_t)MP * 16, F.out(), F.RS() + MP};
                 skinny_phase<2, 1, SkEpiIn, 16, false>(F, F.X1h() + (size_t)MP * DM, F.WIN(), DM, (INW + 31) / 32, SE, 160); } SEAM(4);
    if (IN(5)) { PB(); for (int rp = 0; rp < REP_PREP; ++rp) { const int per = 2 * ((NCHUNK_P / 2 + F.G - 1) / F.G), c0 = per * (int)blockIdx.x; gdn_chunk_prep2(F, c0 < NCHUNK_P ? c0 : NCHUNK_P, c0 + per < NCHUNK_P ? c0 + per : NCHUNK_P); } } SEAM(5);
    if (IN(6)) { PB(); mixer_phase(F); } SEAM(6);
    if (IN(7)) { PB(); combine_phase(F);
#ifdef REP_COMB
        combine_phase(F); combine_phase(F);
#endif
    } SEAM(7);
    if (IN(8)) { PB(); EpiBf E{F.F16()}; GEMM_PH(EpiBf, E, F.MIX(), F.WOUT(), DM, DM); SkEpiAddF32 SE{F.Fb() + (size_t)MP * DM}; skinny_phase<1, 2>(F, F.MIX() + (size_t)MP * DM, F.WOUT(), DM, DM / 16, SE, 0); } SEAM(8);
    if (IN(9)) { PB(); thin_rows(F, F.X1h(), F.F16(), F.Fb(), 1.0f, F.mix_post(), F.X2h(), nullptr, F.RS()); } SEAM(9);
    if (IN(10)) { PB(); EpiAct E{F.ACT(), F.RS()}; GEMM_PH(EpiAct, E, F.X2h(), F.W2GU(), GU, DM);
                  SkEpiAct SE{F.ACT() + (size_t)MP * FF, F.RS() + MP}; skinny_phase<2, 1>(F, F.X2h() + (size_t)MP * DM, F.W2GU(), DM, FF / 16, SE, 128);
#if CONV_TAILS
                  convert_matrix(F, F.down2(), FF, DM, DM, F.W2D(), 0, 128);
#endif
    } SEAM(10);
    if (IN(11)) { PB(); EpiBf E{F.F16()}; GEMM_PHR(EpiBf, E, F.ACT(), F.W2D(), DM, FF); SkEpiAddF32 SE{F.Fb() + (size_t)MP * DM}; skinny_phase<1, 2>(F, F.ACT() + (size_t)MP * FF, F.W2D(), FF, DM / 16, SE, 0); } SEAM(11);
    if (IN(12)) { PB(); thin_rows(F, F.X2h(), F.F16(), F.Fb(), 0.5f, F.ffn2_post(), nullptr, F.out() + OUT_Y, nullptr); }
#undef IN
#undef SEAM
#undef GEMM_PH
#undef GEMM_PHR
#undef GEMM_PHX
}

extern "C" void kernel_launch(void* const* d_in, const int* in_sizes, int n_in, void* d_out, int out_size, void* d_ws, size_t ws_size, hipStream_t stream) {
    static int grid = 0;
    if (grid == 0) {
        if (n_in != 30 || ws_size < WS_END) { fprintf(stderr, "kernel_launch: unexpected shapes (n_in %d, out %d, ws %zu)\n", n_in, out_size, ws_size); grid = -1; return; }
        int dev = 0, cus = 0, per_cu = 0;
        if (hipGetDevice(&dev) != hipSuccess || hipDeviceGetAttribute(&cus, hipDeviceAttributeMultiprocessorCount, dev) != hipSuccess) { grid = -1; return; }
        if (hipFuncSetAttribute((const void*)fwd_kernel, hipFuncAttributeMaxDynamicSharedMemorySize, LDS_BYTES) != hipSuccess) { fprintf(stderr, "kernel_launch: hipFuncSetAttribute failed\n"); grid = -1; return; }
        if (hipOccupancyMaxActiveBlocksPerMultiprocessor(&per_cu, (const void*)fwd_kernel, NTHREADS, LDS_BYTES) != hipSuccess || per_cu < 1) { fprintf(stderr, "kernel_launch: occupancy query says %d\n", per_cu); }
        (void)hipGetLastError();
        grid = cus;
    }
    if (grid < 0) return;
    (void)hipMemsetAsync((char*)d_ws + WS_CTL, 0, CTL_ZERO_BYTES, stream);
    Args a{};
    for (int i = 0; i < 30; ++i) a.in[i] = d_in[i];
    a.out = (float*)d_out; a.ws = (unsigned char*)d_ws;
    if (MK_N_LAUNCHES == 1) { a.ph_lo = 0; a.ph_hi = NPHASE; hipLaunchKernelGGL(fwd_kernel, dim3(grid), dim3(NTHREADS), LDS_BYTES, stream, a); }
    else for (int p = 0; p < NPHASE; ++p) { a.ph_lo = p; a.ph_hi = p + 1; hipLaunchKernelGGL(fwd_kernel, dim3(grid), dim3(NTHREADS), LDS_BYTES, stream, a); }
}
```

```cpp
#include <hip/hip_runtime.h>
#include <cstdio>
#include <cstdint>
namespace pg8 {
#define PG8_LAS __attribute__((address_space(3)))
typedef unsigned short bf16_t;
typedef short bf16x8 __attribute__((ext_vector_type(8)));
typedef float f32x4 __attribute__((ext_vector_type(4)));
typedef unsigned u32x4 __attribute__((ext_vector_type(4)));
constexpr int BM = 256, BK = 64, HALF = 128, HTB = HALF * BK * 2  , STAGE_BYTES = 8 * HTB, NXCD = 8, WGM = 8;

__host__ __device__ __forceinline__ int lds_byte(int r, int c) { const int st = (r >> 4) * 2 + (c >> 5), rr = r & 15, cc = c & 31, ob = rr * 64 + cc * 2; return st * 1024 + (ob ^ (((ob >> 9) & 1) << 5)); }
__host__ __device__ __forceinline__ void stage_rc(int b, int& R, int& C) { const int st = b / 1024, sb = b % 1024, swz = sb ^ (((sb >> 9) & 1) << 5); R = (st >> 1) * 16 + swz / 64; C = (st & 1) * 32 + (swz % 64) / 2; }
__host__ __device__ __forceinline__ int perm32(int rho) { const int n = rho >> 4, i = rho & 15; return 8 * (i >> 2) + 4 * n + (i & 3); }

struct Unit { int pm, pn; };
struct Gemm { const bf16_t* A; const bf16_t* Bt; int M, N, K; int rot; };

struct StaticOrder {
    int nM, nN, nwg, G, c;
    __host__ __device__ void init(int M, int N, int G_, int c_) { nM = M / BM; nN = N / BM; nwg = nM * nN; G = G_; c = c_; }
    __host__ __device__ bool next(int i, Unit& u) const {
        const long L = (long)i * G + c; if (L >= nwg) return false;
        int wgid = (int)L; { const int q = nwg / NXCD, r = nwg % NXCD, xcd = wgid % NXCD, off = wgid / NXCD; wgid = (xcd < r ? xcd * (q + 1) : r * (q + 1) + (xcd - r) * q) + off; }
        const int nig = WGM * nN, gid = wgid / nig, fm = gid * WGM, gsz = (nM - fm) < WGM ? (nM - fm) : WGM;
        u.pm = fm + ((wgid % nig) % gsz); u.pn = (wgid % nig) / gsz; return true;
    }
    __device__ __forceinline__ void a_ready(const Unit&) const {}
    __device__ __forceinline__ void done(const Unit&) const {}
};

__device__ __forceinline__ unsigned cvt_pk_bf16(float lo, float hi) { unsigned r; asm volatile("v_cvt_pk_bf16_f32 %0, %1, %2" : "=v"(r) : "v"(lo), "v"(hi)); return r; }
typedef float f32x2 __attribute__((ext_vector_type(2)));
__device__ __forceinline__ f32x2 gelu_pk(f32x2 v) {
    const f32x2 av = __builtin_elementwise_abs(v), d = av * 0.2316418882f + 1.0f;
    f32x2 t; t.x = __builtin_amdgcn_rcpf(d.x); t.y = __builtin_amdgcn_rcpf(d.y);
    f32x2 q = t * 0.5307027145f + (-0.7265760135f); q = q * t + 0.7107068705f; q = q * t + (-0.142248368f); q = q * t + 0.127414796f; q = q * t;
    const f32x2 s = (v * v) * (-0.72134752044f);
    f32x2 e; e.x = __builtin_amdgcn_exp2f(s.x); e.y = __builtin_amdgcn_exp2f(s.y);
    const f32x2 m = v * (q * e), r = v - m;
    f32x2 o; o.x = v.x < 0.f ? m.x : r.x; o.y = v.y < 0.f ? m.y : r.y; return o;
}

template <int ACT  > struct EpiBf16 {
    static constexpr bool PERM = true, AFTER_DRAIN = false; static_assert(ACT == 0 || ACT == 1, "EpiBf16: ACT is 0 (none) or 1 (gelu_pk)");
    bf16_t* O; int ldc; const float* bias; int split_cols; size_t split_stride; float scale0;
    __device__ __forceinline__ void operator()(const f32x4 (&acc)[2][2][4][2], const Unit& u, int wr, int wc, int fr, int fq) const {
        const int row0 = u.pm * BM + wr * 64 + fr; int colt = u.pn * BM; bf16_t* base = O;
        float sc = 1.f; if (split_cols) { const int t = colt / split_cols; base += (size_t)t * split_stride; colt -= t * split_cols; if (t == 0) sc = scale0; }
        const int col0 = colt + wc * 32 + 8 * fq, bcol0 = u.pn * BM + wc * 32 + 8 * fq;
        f32x4 bv[2][2];
#pragma unroll
        for (int bj = 0; bj < 2; ++bj)
#pragma unroll
            for (int n = 0; n < 2; ++n) bv[bj][n] = bias ? *(const f32x4*)(bias + bcol0 + bj * HALF + 4 * n) : (f32x4){0.f, 0.f, 0.f, 0.f};
#pragma unroll
        for (int ai = 0; ai < 2; ++ai)
#pragma unroll
            for (int m = 0; m < 4; ++m) { bf16_t* rowp = base + (size_t)(row0 + ai * HALF + m * 16) * ldc + col0;
#pragma unroll
                for (int bj = 0; bj < 2; ++bj) { f32x4 v0 = acc[ai][bj][m][0] + bv[bj][0], v1 = acc[ai][bj][m][1] + bv[bj][1];
                    if (ACT == 1) { f32x2 a = gelu_pk((f32x2){v0[0], v0[1]}), b = gelu_pk((f32x2){v0[2], v0[3]}), c = gelu_pk((f32x2){v1[0], v1[1]}), d = gelu_pk((f32x2){v1[2], v1[3]});
                        v0 = (f32x4){a.x, a.y, b.x, b.y}; v1 = (f32x4){c.x, c.y, d.x, d.y}; }
                    v0 = v0 * sc; v1 = v1 * sc; u32x4 w; w.x = cvt_pk_bf16(v0[0], v0[1]); w.y = cvt_pk_bf16(v0[2], v0[3]); w.z = cvt_pk_bf16(v1[0], v1[1]); w.w = cvt_pk_bf16(v1[2], v1[3]);
                    *(u32x4*)(rowp + bj * HALF) = w; } }
    }
};

struct PanelStats {
    unsigned* xbuf;
    unsigned* cnt;
    unsigned* tmo;
    int ntn; float eps;
    unsigned code;
    __device__ __forceinline__ bool run(const f32x4 (&v)[2][2][4][2], const Unit& u, int wr, int wc, int fr, int fq, PG8_LAS unsigned char* lds, int wid, int lane) const {
        typedef float f32x2v __attribute__((ext_vector_type(2)));
        PG8_LAS f32x2v* P = (PG8_LAS f32x2v*)lds;
        PG8_LAS f32x2v* S = (PG8_LAS f32x2v*)(lds + 8192);
        PG8_LAS unsigned* flag = (PG8_LAS unsigned*)(lds + 8192 + 2048);
#pragma unroll
        for (int ai = 0; ai < 2; ++ai)
#pragma unroll
            for (int m = 0; m < 4; ++m) {
                float s = 0.f;
#pragma unroll
                for (int bj = 0; bj < 2; ++bj)
#pragma unroll
                    for (int n = 0; n < 2; ++n) { const f32x4 x = v[ai][bj][m][n]; s += (x[0] + x[1]) + (x[2] + x[3]); }
                s += __shfl_xor(s, 16); s += __shfl_xor(s, 32);
                const float mw = s * (1.0f / 64.0f); float q = 0.f;
#pragma unroll
                for (int bj = 0; bj < 2; ++bj)
#pragma unroll
                    for (int n = 0; n < 2; ++n) { const f32x4 d = v[ai][bj][m][n] - mw; q += (d[0] * d[0] + d[1] * d[1]) + (d[2] * d[2] + d[3] * d[3]); }
                q += __shfl_xor(q, 16); q += __shfl_xor(q, 32);
                if (fq == 0) P[(ai * HALF + wr * 64 + m * 16 + fr) * 4 + wc] = (f32x2v){mw, q};
            }
        asm volatile("s_waitcnt lgkmcnt(0)" ::: "memory"); __builtin_amdgcn_s_barrier(); asm volatile("" ::: "memory");
#if defined(BROKEN_EXCHANGE_NO_WAIT)
#warning BROKEN CONTROL BUILD: the row-statistics exchange does not wait; results are wrong by design
        if (blockIdx.x >= 64) { const long long t0_ = clock64(); while (clock64() - t0_ < 60000) __builtin_amdgcn_s_sleep(8); }
#endif
        const int row = wid * 32 + (lane & 31);
        if (lane < 32) {
            const f32x2v a = P[row * 4 + 0], b = P[row * 4 + 1], c = P[row * 4 + 2], d = P[row * 4 + 3];
            const float mt = (a.x + b.x + c.x + d.x) * 0.25f;
            const float da = a.x - mt, db = b.x - mt, dc = c.x - mt, dd = d.x - mt;
            const float m2 = (a.y + b.y) + (c.y + d.y) + 64.0f * ((da * da + db * db) + (dc * dc + dd * dd));
            unsigned long long* slot = (unsigned long long*)xbuf + ((size_t)(u.pm * BM + row) * 4 + u.pn);
            __hip_atomic_store(slot, ((unsigned long long)__float_as_uint(m2) << 32) | __float_as_uint(mt), __ATOMIC_RELAXED, __HIP_MEMORY_SCOPE_AGENT);
        }
        asm volatile("s_waitcnt vmcnt(0)" ::: "memory");
        if (lane == 0) __hip_atomic_fetch_add(cnt + 64 * u.pm, 1u, __ATOMIC_RELAXED, __HIP_MEMORY_SCOPE_AGENT);
        if (wid == 0) {
            bool dead = false; const unsigned long long t0 = __builtin_amdgcn_s_memrealtime(); const unsigned want = 8u * (unsigned)ntn;
            for (;;) {
#if defined(BROKEN_EXCHANGE_NO_WAIT)
                break;
#endif
                if ((unsigned)__builtin_amdgcn_readfirstlane(__hip_atomic_load(cnt + 64 * u.pm, __ATOMIC_RELAXED, __HIP_MEMORY_SCOPE_AGENT)) >= want) break;
                if (__builtin_amdgcn_s_memrealtime() - t0 > 2000000ull) {
                    if (lane == 0) { unsigned expect = 0u; __hip_atomic_compare_exchange_strong(tmo + 1, &expect, code | (unsigned)(u.pm & 0xff), __ATOMIC_RELAXED, __ATOMIC_RELAXED, __HIP_MEMORY_SCOPE_AGENT);
                                     __hip_atomic_store(tmo, 1u, __ATOMIC_RELAXED, __HIP_MEMORY_SCOPE_AGENT); }
                    dead = true; break; }
                __builtin_amdgcn_s_sleep(2);
            }
            __builtin_amdgcn_fence(__ATOMIC_ACQUIRE, "agent");
            if (lane == 0) flag[0] = dead ? 1u : 0u;
        }
        asm volatile("s_waitcnt vmcnt(0) lgkmcnt(0)" ::: "memory"); __builtin_amdgcn_s_barrier(); asm volatile("" ::: "memory");
        const bool bad = flag[0] != 0u;
        if (lane < 32) {
            const unsigned long long* slot = (const unsigned long long*)xbuf + (size_t)(u.pm * BM + row) * 4; float mt[4], m2[4]; float ms = 0.f;
#pragma unroll
            for (int t = 0; t < 4; ++t) { if (t < ntn) { const unsigned long long w = __hip_atomic_load(slot + t, __ATOMIC_RELAXED, __HIP_MEMORY_SCOPE_AGENT); mt[t] = __uint_as_float((unsigned)w); m2[t] = __uint_as_float((unsigned)(w >> 32)); } else { mt[t] = 0.f; m2[t] = 0.f; } ms += mt[t]; }
            const float mean = ms / (float)ntn; float q = 0.f;
#pragma unroll
            for (int t = 0; t < 4; ++t) if (t < ntn) { const float dm = mt[t] - mean; q += m2[t] + 256.0f * dm * dm; }
            S[row] = (f32x2v){mean, 1.0f / sqrtf(q / (256.0f * (float)ntn) + eps)};
        }
        asm volatile("s_waitcnt lgkmcnt(0)" ::: "memory"); __builtin_amdgcn_s_barrier(); asm volatile("" ::: "memory");
        return bad;
    }
};
struct EpiLnRes {
    static constexpr bool PERM = false, AFTER_DRAIN = true;
    const float* base; float* out; int ldc; const float* bias; PanelStats st; unsigned poison;
    __device__ __forceinline__ void fused(f32x4 (&acc)[2][2][4][2], const Unit& u, int wr, int wc, int fr, int fq, PG8_LAS unsigned char* lds, int wid, int lane) const {
        typedef float f32x2v __attribute__((ext_vector_type(2)));
        const PG8_LAS f32x2v* S = (const PG8_LAS f32x2v*)(lds + 8192);
        const int col0 = u.pn * BM + wc * 32 + 4 * fq;
#pragma unroll
        for (int bj = 0; bj < 2; ++bj)
#pragma unroll
            for (int n = 0; n < 2; ++n) { const f32x4 bv = bias ? *(const f32x4*)(bias + col0 + bj * HALF + n * 16) : (f32x4){0.f, 0.f, 0.f, 0.f};
#pragma unroll
                for (int ai = 0; ai < 2; ++ai)
#pragma unroll
                    for (int m = 0; m < 4; ++m) acc[ai][bj][m][n] += bv; }
        f32x4 pre[4][2][2];
#pragma unroll
        for (int m = 0; m < 4; ++m) { const size_t off = (size_t)(u.pm * BM + wr * 64 + m * 16 + fr) * ldc + col0;
#pragma unroll
            for (int bj = 0; bj < 2; ++bj)
#pragma unroll
                for (int n = 0; n < 2; ++n) pre[m][bj][n] = *(const f32x4*)(base + off + bj * HALF + n * 16); }
        const bool bad = st.run(acc, u, wr, wc, fr, fq, lds, wid, lane) || poison != 0u;
        const float qnan = __builtin_nanf("");
#pragma unroll
        for (int ai = 0; ai < 2; ++ai)
#pragma unroll
            for (int m = 0; m < 4; ++m) { const int r = ai * HALF + wr * 64 + m * 16 + fr; const f32x2v sr = S[r]; const size_t off = (size_t)(u.pm * BM + r) * ldc + col0;
#pragma unroll
                for (int bj = 0; bj < 2; ++bj)
#pragma unroll
                    for (int n = 0; n < 2; ++n) { const f32x4 bs = ai == 0 ? pre[m][bj][n] : *(const f32x4*)(base + off + bj * HALF + n * 16); f32x4 o = bs + (acc[ai][bj][m][n] - sr.x) * sr.y;
                        if (bad) o = (f32x4){qnan, qnan, qnan, qnan}; *(f32x4*)(out + off + bj * HALF + n * 16) = o; }
                if (m & 1) asm volatile("" ::: "memory"); }
    }
};
struct EpiLnResLn {
    static constexpr bool PERM = false, AFTER_DRAIN = true;
    const float* base; float* out; bf16_t* xn; int ldc; const float* bias; PanelStats st1, st2; unsigned poison;
    __device__ __forceinline__ void fused(f32x4 (&acc)[2][2][4][2], const Unit& u, int wr, int wc, int fr, int fq, PG8_LAS unsigned char* lds, int wid, int lane) const {
        typedef float f32x2v __attribute__((ext_vector_type(2))); typedef unsigned u32x2v __attribute__((ext_vector_type(2)));
        const PG8_LAS f32x2v* S = (const PG8_LAS f32x2v*)(lds + 8192);
        const int col0 = u.pn * BM + wc * 32 + 4 * fq;
#pragma unroll
        for (int bj = 0; bj < 2; ++bj)
#pragma unroll
            for (int n = 0; n < 2; ++n) { const f32x4 bv = bias ? *(const f32x4*)(bias + col0 + bj * HALF + n * 16) : (f32x4){0.f, 0.f, 0.f, 0.f};
#pragma unroll
                for (int ai = 0; ai < 2; ++ai)
#pragma unroll
                    for (int m = 0; m < 4; ++m) acc[ai][bj][m][n] += bv; }
        bool bad = st1.run(acc, u, wr, wc, fr, fq, lds, wid, lane) || poison != 0u;
        const float qnan = __builtin_nanf("");
#pragma unroll
        for (int ai = 0; ai < 2; ++ai)
#pragma unroll
            for (int m = 0; m < 4; ++m) { const int r = ai * HALF + wr * 64 + m * 16 + fr; const f32x2v sr = S[r]; const size_t off = (size_t)(u.pm * BM + r) * ldc + col0;
#pragma unroll
                for (int bj = 0; bj < 2; ++bj)
#pragma unroll
                    for (int n = 0; n < 2; ++n) { const f32x4 bs = *(const f32x4*)(base + off + bj * HALF + n * 16); acc[ai][bj][m][n] = bs + (acc[ai][bj][m][n] - sr.x) * sr.y; }
                asm volatile("" : "+v"(acc[ai][0][m][0]), "+v"(acc[ai][0][m][1]), "+v"(acc[ai][1][m][0]), "+v"(acc[ai][1][m][1]));
                if (m & 1) asm volatile("" ::: "memory"); }
        const bool bad1 = bad;
        bad = st2.run(acc, u, wr, wc, fr, fq, lds, wid, lane) || bad;
#pragma unroll
        for (int ai = 0; ai < 2; ++ai)
#pragma unroll
            for (int m = 0; m < 4; ++m) { const int r = ai * HALF + wr * 64 + m * 16 + fr; const f32x2v sr = S[r]; const size_t off = (size_t)(u.pm * BM + r) * ldc + col0;
#pragma unroll
                for (int bj = 0; bj < 2; ++bj)
#pragma unroll
                    for (int n = 0; n < 2; ++n) { const f32x4 x1 = acc[ai][bj][m][n]; *(f32x4*)(out + off + bj * HALF + n * 16) = bad1 ? (f32x4){qnan, qnan, qnan, qnan} : x1;
                        const f32x4 o = (x1 - sr.x) * sr.y; u32x2v w; w.x = cvt_pk_bf16(o[0], o[1]); w.y = cvt_pk_bf16(o[2], o[3]);
                        if (bad) { w.x = 0x7fc07fc0u; w.y = 0x7fc07fc0u; } *(u32x2v*)(xn + off + bj * HALF + n * 16) = w; }
                asm volatile("" ::: "memory"); }
    }
};

template <class Epi, class Sched, bool ALIGN_EPI = false, bool SP2 = false>
__device__ __forceinline__ void gemm_phase(PG8_LAS unsigned char* lds, const Gemm g, const Sched& S, const Epi& E, const int tid_in) {
    const int tid = tid_in, wid = __builtin_amdgcn_readfirstlane(tid >> 6), lane = tid & 63, wr = wid >> 2, wc = wid & 3, fr = lane & 15, fq = lane >> 4;
    const int K = g.K, nt = K / BK;
    unsigned voffA[2], voffB[2];
#pragma unroll
    for (int i = 0; i < 2; ++i) { int R, C; stage_rc(tid * 16 + i * 8192, R, C); const int Rb = Epi::PERM ? ((R & ~31) + perm32(R & 31)) : R;
        voffA[i] = (unsigned)(R * K + C) * 2u; voffB[i] = (unsigned)(Rb * K + C) * 2u; }
    const size_t kstep = (size_t)(BK * 2);
    const size_t hstep = (size_t)HALF * K * 2;
    const size_t tstep = 2 * hstep;
    const unsigned ldsw = (unsigned)wid * 1024u;
    const int aoff = lds_byte(wr * 64 + fr, fq * 8), boff = lds_byte(wc * 32 + fr, fq * 8);
#define PG8_SA(b, h) (((b) * 2 + (h)) * HTB)
#define PG8_SB(b, h) ((4 + (b) * 2 + (h)) * HTB)
#define PG8_STAGE(bufoff, gbase, voff) do { _Pragma("unroll") for (int _i = 0; _i < 2; ++_i) \
        __builtin_amdgcn_global_load_lds((const unsigned*)((const char*)(gbase) + (voff)[_i]), (PG8_LAS unsigned*)(lds + (bufoff) + ldsw + _i * 8192), 16, 0, 0); } while (0)
#define PG8_LDA(dst, b, h) do { _Pragma("unroll") for (int m = 0; m < 4; ++m) _Pragma("unroll") for (int k = 0; k < 2; ++k) dst[m][k] = *(const PG8_LAS bf16x8*)(lds + PG8_SA(b, h) + aoff + m * 2048 + k * 1024); } while (0)
#define PG8_LDB(dst, b, h) do { _Pragma("unroll") for (int n = 0; n < 2; ++n) _Pragma("unroll") for (int k = 0; k < 2; ++k) dst[n][k] = *(const PG8_LAS bf16x8*)(lds + PG8_SB(b, h) + boff + n * 2048 + k * 1024); } while (0)
#define PG8_MMA(ai, bj, At, Bt) do { __builtin_amdgcn_s_setprio(1); _Pragma("unroll") for (int m = 0; m < 4; ++m) _Pragma("unroll") for (int n = 0; n < 2; ++n) _Pragma("unroll") for (int k = 0; k < 2; ++k) \
        acc[ai][bj][m][n] = __builtin_amdgcn_mfma_f32_16x16x32_bf16(Bt[n][k], At[m][k], acc[ai][bj][m][n], 0, 0, 0); __builtin_amdgcn_s_setprio(0); } while (0)
#define PG8_WAIT_V(n) asm volatile("s_waitcnt vmcnt(" #n ")" ::: "memory")
#define PG8_WAIT_L(n) asm volatile("s_waitcnt lgkmcnt(" #n ")" ::: "memory")
#define PG8_BAR __builtin_amdgcn_s_barrier()
#define PG8_SCHED __builtin_amdgcn_sched_barrier(0)
    Unit cur, nxt; int ui = 0;
    if (!S.next(0, cur)) return;
    f32x4 acc[2][2][4][2];
#pragma unroll
    for (int a = 0; a < 2; ++a)
#pragma unroll
        for (int b = 0; b < 2; ++b)
#pragma unroll
            for (int m = 0; m < 4; ++m)
#pragma unroll
                for (int n = 0; n < 2; ++n) acc[a][b][m][n] = (f32x4){0.f, 0.f, 0.f, 0.f};
    bf16x8 At[4][2], B0[2][2], B1[2][2];
    const char* cA = (const char*)g.A + (size_t)cur.pm * tstep; const char* cB = (const char*)g.Bt + (size_t)cur.pn * tstep;
    const size_t rotb = (size_t)g.rot * kstep;
    S.a_ready(cur);
    { const char* cA0 = cA; const char* cB0 = cB; cA += rotb; cB += rotb;
    if constexpr (SP2) {
        PG8_STAGE(PG8_SB(0, 0), cB, voffB); PG8_STAGE(PG8_SB(0, 1), cB + hstep, voffB); PG8_STAGE(PG8_SA(0, 0), cA, voffA); PG8_STAGE(PG8_SA(0, 1), cA + hstep, voffA);
        if (wr == 1) PG8_BAR;
        PG8_WAIT_V(2); PG8_BAR;
        PG8_STAGE(PG8_SB(1, 0), cB + kstep, voffB); PG8_STAGE(PG8_SA(1, 0), cA + kstep, voffA); PG8_STAGE(PG8_SB(1, 1), cB + hstep + kstep, voffB);
        PG8_WAIT_V(6); PG8_BAR;
    } else {
        PG8_STAGE(PG8_SB(0, 0), cB, voffB); PG8_STAGE(PG8_SA(0, 0), cA, voffA); PG8_STAGE(PG8_SB(0, 1), cB + hstep, voffB); PG8_STAGE(PG8_SA(0, 1), cA + hstep, voffA);
        if (wr == 1) PG8_BAR;
        PG8_WAIT_V(4); PG8_BAR;
        PG8_STAGE(PG8_SB(1, 0), cB + kstep, voffB); PG8_STAGE(PG8_SA(1, 0), cA + kstep, voffA); PG8_STAGE(PG8_SB(1, 1), cB + hstep + kstep, voffB);
        PG8_WAIT_V(6); PG8_BAR;
    }
    cA = cA0; cB = cB0; }
    for (;;) {
        const bool has_next = S.next(ui + 1, nxt);
        const char* nA = has_next ? (const char*)g.A + (size_t)nxt.pm * tstep : cA; const char* nB = has_next ? (const char*)g.Bt + (size_t)nxt.pn * tstep : cB;
        for (int t = 0; t < nt; t += 2) {
            const bool last = (t == nt - 2);
            int kc = t + g.rot; kc = kc >= nt ? kc - nt : kc; int kn = kc + 2; kn = kn >= nt ? kn - nt : kn;
            const char* a1 = cA + (size_t)(kc + 1) * kstep;
            const char* a2 = last ? nA + rotb : cA + (size_t)kn * kstep; const char* b2 = last ? nB + rotb : cB + (size_t)kn * kstep;
            const char* a3 = a2 + kstep; const char* b3 = b2 + kstep;
            if (last && has_next) S.a_ready(nxt);
            if constexpr (SP2) {
            PG8_LDB(B0, 0, 0); PG8_LDB(B1, 0, 1); PG8_SCHED; PG8_LDA(At, 0, 0); PG8_STAGE(PG8_SA(1, 1), a1 + hstep, voffA);
            PG8_WAIT_V(8); PG8_WAIT_L(0); PG8_BAR; PG8_MMA(0, 0, At, B0); PG8_MMA(0, 1, At, B1); PG8_BAR; PG8_SCHED;
            PG8_LDA(At, 0, 1); PG8_STAGE(PG8_SB(0, 0), b2, voffB); PG8_STAGE(PG8_SB(0, 1), b2 + hstep, voffB); PG8_STAGE(PG8_SA(0, 0), a2, voffA);
            PG8_WAIT_V(8); PG8_WAIT_L(0); PG8_BAR; PG8_MMA(1, 0, At, B0); PG8_MMA(1, 1, At, B1); PG8_BAR; PG8_SCHED;
            PG8_LDB(B0, 1, 0); PG8_LDB(B1, 1, 1); PG8_SCHED; PG8_LDA(At, 1, 0); PG8_STAGE(PG8_SA(0, 1), a2 + hstep, voffA);
            PG8_WAIT_V(8); PG8_WAIT_L(0); PG8_BAR; PG8_MMA(0, 0, At, B0); PG8_MMA(0, 1, At, B1); PG8_BAR; PG8_SCHED;
            PG8_LDA(At, 1, 1); PG8_STAGE(PG8_SB(1, 0), b3, voffB); PG8_STAGE(PG8_SB(1, 1), b3 + hstep, voffB); PG8_STAGE(PG8_SA(1, 0), a3, voffA);
            PG8_WAIT_V(8); PG8_WAIT_L(0); PG8_BAR; PG8_MMA(1, 0, At, B0); PG8_MMA(1, 1, At, B1); PG8_BAR; PG8_SCHED;
            } else {
            PG8_LDB(B0, 0, 0); PG8_SCHED; PG8_LDA(At, 0, 0); PG8_STAGE(PG8_SA(1, 1), a1 + hstep, voffA);
            PG8_WAIT_L(8); PG8_BAR; PG8_WAIT_L(0); PG8_MMA(0, 0, At, B0); PG8_BAR; PG8_SCHED;
            PG8_LDB(B1, 0, 1); PG8_STAGE(PG8_SB(0, 0), b2, voffB);
            PG8_BAR; PG8_WAIT_L(0); PG8_MMA(0, 1, At, B1); PG8_BAR;
            PG8_LDA(At, 0, 1); PG8_STAGE(PG8_SA(0, 0), a2, voffA);
            PG8_BAR; PG8_WAIT_L(0); PG8_MMA(1, 0, At, B0); PG8_BAR; PG8_SCHED;
            PG8_STAGE(PG8_SB(0, 1), b2 + hstep, voffB);
            PG8_WAIT_V(6); PG8_BAR; PG8_MMA(1, 1, At, B1); PG8_BAR;
            PG8_LDB(B0, 1, 0); PG8_SCHED; PG8_LDA(At, 1, 0); PG8_STAGE(PG8_SA(0, 1), a2 + hstep, voffA);
            PG8_WAIT_L(8); PG8_BAR; PG8_WAIT_L(0); PG8_MMA(0, 0, At, B0); PG8_BAR; PG8_SCHED;
            PG8_LDB(B1, 1, 1); PG8_STAGE(PG8_SB(1, 0), b3, voffB);
            PG8_BAR; PG8_WAIT_L(0); PG8_MMA(0, 1, At, B1); PG8_BAR;
            PG8_LDA(At, 1, 1); PG8_STAGE(PG8_SA(1, 0), a3, voffA);
            PG8_BAR; PG8_WAIT_L(0); PG8_MMA(1, 0, At, B0); PG8_BAR; PG8_SCHED;
            PG8_STAGE(PG8_SB(1, 1), b3 + hstep, voffB);
            PG8_WAIT_V(6); PG8_BAR; PG8_MMA(1, 1, At, B1); PG8_BAR;
            }
        }
        if constexpr (ALIGN_EPI) { if (wr == 0) PG8_BAR; }
        if constexpr (!Epi::AFTER_DRAIN) { E(acc, cur, wr, wc, fr, fq); S.done(cur); }
        if (!has_next) break;
#pragma unroll
        for (int a = 0; a < 2; ++a)
#pragma unroll
            for (int b = 0; b < 2; ++b)
#pragma unroll
                for (int m = 0; m < 4; ++m)
#pragma unroll
                    for (int n = 0; n < 2; ++n) acc[a][b][m][n] = (f32x4){0.f, 0.f, 0.f, 0.f};
        cur = nxt; cA = nA; cB = nB; ++ui;
        if constexpr (ALIGN_EPI) { if (wr == 1) PG8_BAR; }
    }
    PG8_WAIT_V(0);
    if constexpr (!ALIGN_EPI) { if (wr == 0) PG8_BAR; }
    PG8_BAR;
    if constexpr (Epi::AFTER_DRAIN) { E.fused(acc, cur, wr, wc, fr, fq, lds, wid, lane); S.done(cur); }
#undef PG8_SA
#undef PG8_SB
#undef PG8_STAGE
#undef PG8_LDA
#undef PG8_LDB
#undef PG8_MMA
#undef PG8_WAIT_V
#undef PG8_WAIT_L
#undef PG8_BAR
#undef PG8_SCHED
}
}

#ifndef PG8_SP2
#define PG8_SP2 true
#endif
#ifndef PG8_ALIGN
#define PG8_ALIGN true
#endif
#include <hip/hip_bf16.h>
#include <cmath>
namespace attn_body {
using bf16=__hip_bfloat16;
using bf16x8=__attribute__((ext_vector_type(8)))short;
using s16x4=__attribute__((ext_vector_type(4)))short;
using f32x16=__attribute__((ext_vector_type(16)))float;
using u32x4=__attribute__((ext_vector_type(4)))unsigned;
constexpr int SEQ=2048,D=64,DM=1024;
constexpr int NW=8,QBLK=32,QB=QBLK*NW,KVBLK=64,NQB=SEQ/QB;
constexpr int ATTN_PITCH=DM, ATTN_UNIT_ROWS=QB;
__device__ __forceinline__ int crow(int r,int hi){return (r&3)+8*(r>>2)+4*hi;}
#define SBAR() __builtin_amdgcn_sched_barrier(0)
__device__ __forceinline__ void cmask(f32x16&p0,f32x16&p1,int jb,int qrel,int hi){
  const float NEG=-INFINITY; int kb=64*jb+4*hi;
  #pragma unroll
  for(int r=0;r<16;++r){int kv=kb+(r&3)+8*(r>>2); if(kv>qrel)p0[r]=NEG; if(kv+32>qrel)p1[r]=NEG;}
}

constexpr int NSLOT=3, SLOTB=8192;
constexpr int LDS_K=0, LDS_V=NSLOT*SLOTB, LDS_WS=2*NSLOT*SLOTB, LDS_OST=LDS_WS+NW*64*4, LDS_BYTES=LDS_OST+NW*4096;
constexpr float C2=0.125f*1.4426950408889634f;
__device__ __forceinline__ void glds16(const void*gsrc,unsigned lds_dst){unsigned keep;
  asm volatile("s_mov_b32 %0, m0\n\ts_mov_b32 m0, %2\n\ts_nop 0\n\tglobal_load_lds_dwordx4 %1, off\n\ts_mov_b32 m0, %0":"=&s"(keep):"v"(gsrc),"s"(lds_dst):"memory");}
__device__ __forceinline__ float max3f(float a,float b,float c){float r;asm("v_max3_f32 %0, %1, %2, %3":"=v"(r):"v"(a),"v"(b),"v"(c));return r;}
__device__ __forceinline__ float max2f(float a,float b){float r;asm("v_max_f32_e32 %0, %1, %2":"=v"(r):"v"(a),"v"(b));return r;}
__device__ __forceinline__ float fadd_s(float a,float b){float r;asm("v_add_f32_e32 %0, %1, %2":"=v"(r):"v"(a),"v"(b));return r;}
__device__ __forceinline__ float fsub_s(float a,float b){float r;asm("v_sub_f32_e32 %0, %1, %2":"=v"(r):"v"(a),"v"(b));return r;}
typedef float f32x2_t __attribute__((ext_vector_type(2))); typedef __bf16 bf16x2_t __attribute__((ext_vector_type(2)));
__device__ __forceinline__ unsigned cvtpk_s(float lo,float hi){f32x2_t v={lo,hi};bf16x2_t b=__builtin_convertvector(v,bf16x2_t);return __builtin_bit_cast(unsigned,b);}
#define WAIT_BAR(N) asm volatile("s_waitcnt vmcnt(" #N ") lgkmcnt(0)\n\ts_barrier":::"memory")

__device__ __forceinline__ void qkt(f32x16&p0,f32x16&p1,const char*Kslot,const bf16x8*qr,const f32x16&negm,int r32,int hi){
  const char*kb=Kslot+hi*1024+r32*16;
  #pragma unroll
  for(int d0=0;d0<4;++d0){
    const bf16x8 b0=*reinterpret_cast<const bf16x8*>(kb+d0*2048);
    const bf16x8 b1=*reinterpret_cast<const bf16x8*>(kb+d0*2048+512);
    if(d0==0){p0=__builtin_amdgcn_mfma_f32_32x32x16_bf16(b0,qr[0],negm,0,0,0);p1=__builtin_amdgcn_mfma_f32_32x32x16_bf16(b1,qr[0],negm,0,0,0);}
    else{p0=__builtin_amdgcn_mfma_f32_32x32x16_bf16(b0,qr[d0],p0,0,0,0);p1=__builtin_amdgcn_mfma_f32_32x32x16_bf16(b1,qr[d0],p1,0,0,0);}}
}
typedef __attribute__((address_space(3))) const char* lds_cptr;
typedef short v4i16_t __attribute__((ext_vector_type(4)));
__device__ __forceinline__ void kload8(bf16x8*kf,lds_cptr kp){
  kf[0]=*(const __attribute__((address_space(3))) bf16x8*)(kp);      kf[1]=*(const __attribute__((address_space(3))) bf16x8*)(kp+512);
  kf[2]=*(const __attribute__((address_space(3))) bf16x8*)(kp+2048); kf[3]=*(const __attribute__((address_space(3))) bf16x8*)(kp+2560);
  kf[4]=*(const __attribute__((address_space(3))) bf16x8*)(kp+4096); kf[5]=*(const __attribute__((address_space(3))) bf16x8*)(kp+4608);
  kf[6]=*(const __attribute__((address_space(3))) bf16x8*)(kp+6144); kf[7]=*(const __attribute__((address_space(3))) bf16x8*)(kp+6656);
}
__device__ __forceinline__ void kload2(bf16x8*kf,lds_cptr kp,int j){ kf[2*j]=*(const __attribute__((address_space(3))) bf16x8*)(kp+j*2048); kf[2*j+1]=*(const __attribute__((address_space(3))) bf16x8*)(kp+j*2048+512); }
__device__ __forceinline__ s16x4 vtr(lds_cptr p){ return __builtin_bit_cast(s16x4,__builtin_amdgcn_ds_read_tr16_b64_v4i16((__attribute__((address_space(3))) v4i16_t*)p)); }
__device__ __forceinline__ float rowmax2(const f32x16&p0,const f32x16&p1,float k32){
  float a=max3f(p0[0],p0[1],p0[2]),b=max3f(p1[0],p1[1],p1[2]);
  #pragma unroll
  for(int r=3;r<15;r+=2){a=max3f(a,p0[r],p0[r+1]);b=max3f(b,p1[r],p1[r+1]);}
  a=max2f(a,p0[15]);b=max2f(b,p1[15]);
  const float m=max2f(a,fadd_s(b,k32));
  auto rr=__builtin_amdgcn_permlane32_swap(__float_as_uint(m),__float_as_uint(m),false,false);
  return max2f(__uint_as_float(rr[0]),__uint_as_float(rr[1]));
}
__device__ __forceinline__ float rowmax(const f32x16&p0,const f32x16&p1){
  float a=max3f(p0[0],p0[1],p1[0]),b=max3f(p0[2],p0[3],p1[1]);a=max3f(a,p1[2],p1[3]);
  #pragma unroll
  for(int r=4;r<16;r+=4){a=max3f(a,p0[r],p0[r+1]);b=max3f(b,p0[r+2],p0[r+3]);a=max3f(a,p1[r],p1[r+1]);b=max3f(b,p1[r+2],p1[r+3]);}
  const float m=max2f(a,b);
  auto rr=__builtin_amdgcn_permlane32_swap(__float_as_uint(m),__float_as_uint(m),false,false);
  return max2f(__uint_as_float(rr[0]),__uint_as_float(rr[1]));
}
__device__ __forceinline__ void pv(f32x16*o,int vb,bf16x8 pa0,bf16x8 pa1,bf16x8 pa2,bf16x8 pa3){
  #pragma unroll
  for(int d0=0;d0<2;++d0){s16x4 lo[4],hi[4];
    #pragma unroll
    for(int ks=0;ks<4;++ks){
      asm volatile("ds_read_b64_tr_b16 %0,%1 offset:%c2":"=&v"(lo[ks]):"v"(vb),"i"(d0*4096+ks*1024):"memory");
      asm volatile("ds_read_b64_tr_b16 %0,%1 offset:%c2":"=&v"(hi[ks]):"v"(vb),"i"(d0*4096+ks*1024+512):"memory");}
    asm volatile("s_waitcnt lgkmcnt(0)":::"memory");SBAR();
    #define PK(k) (bf16x8){lo[k][0],lo[k][1],lo[k][2],lo[k][3],hi[k][0],hi[k][1],hi[k][2],hi[k][3]}
    o[d0]=__builtin_amdgcn_mfma_f32_32x32x16_bf16(pa0,PK(0),o[d0],0,0,0);
    o[d0]=__builtin_amdgcn_mfma_f32_32x32x16_bf16(pa1,PK(1),o[d0],0,0,0);
    o[d0]=__builtin_amdgcn_mfma_f32_32x32x16_bf16(pa2,PK(2),o[d0],0,0,0);
    o[d0]=__builtin_amdgcn_mfma_f32_32x32x16_bf16(pa3,PK(3),o[d0],0,0,0);
    #undef PK
  }
}

#ifndef ATTN_STORE16
#define ATTN_STORE16(p,v) (*(u32x4*)(p)=(v))
#endif
template<int THRL> __device__ __forceinline__ void attn_unit(int b,int h,int qb,const bf16*Q,const bf16*__restrict__ K,const bf16*__restrict__ V,bf16*O,float sl2,char*shm,int tid_in){
  const int tid=tid_in,lane=tid&63,r32=lane&31,hi=lane>>5; const int wid=__builtin_amdgcn_readfirstlane(tid>>6);
  const long rowbase=(long)b*SEQ; const int q0=qb*QB;
  const bf16*Qw=Q+(rowbase+q0+wid*QBLK)*DM+h*D;
  const bf16*Kh=K+rowbase*DM+h*D,*Vh=V+rowbase*DM+h*D;
  const unsigned lds0=(unsigned)(uintptr_t)shm;
  float*wsf=(float*)(shm+LDS_WS)+wid*64;
  const bf16*ksrc=Kh+(long)lane*DM+wid*8;
  const bf16*vsrc=Vh+(long)(16*(wid&3)+(lane>>2))*DM+(wid>>2)*32+(lane&3)*8;
  const unsigned kdst=lds0+LDS_K+wid*1024, vdst=lds0+LDS_V+wid*1024;
  #define DMA_K(t,slot) glds16(ksrc+(long)(t)*KVBLK*DM,(unsigned)__builtin_amdgcn_readfirstlane(kdst+(slot)))
  #define DMA_V(t,slot) glds16(vsrc+(long)(t)*KVBLK*DM,(unsigned)__builtin_amdgcn_readfirstlane(vdst+(slot)))
  const int vb0=(int)(lds0+LDS_V)+((lane>>4)&1)*32+(lane&3)*8+(4*hi+((lane&15)>>2))*64;
  const char*Kbase=shm+LDS_K; bf16x8 kf[8];
  const lds_cptr shm3=(lds_cptr)shm; const lds_cptr kp0=shm3+LDS_K+hi*1024+r32*16; const lds_cptr vp0=shm3+LDS_V+((lane>>4)&1)*32+(lane&3)*8+(4*hi+((lane&15)>>2))*64;
  const int NT=(q0+QB)/KVBLK;
  DMA_K(0,0);DMA_V(0,0);DMA_K(1,SLOTB);
  bf16x8 qr[4];
  #pragma unroll
  for(int d0=0;d0<4;++d0)qr[d0]=*reinterpret_cast<const bf16x8*>(&Qw[(long)r32*DM+d0*16+hi*8]);
  float mhat=0.f,l_reg=0.f;f32x16 o[2];o[0]=f32x16{};o[1]=f32x16{};const float k32=32.f*sl2,k64=64.f*sl2; f32x16 negm; { const float lb=sl2*(float)(4*hi-(q0+wid*QBLK+r32)); _Pragma("unroll") for(int r=0;r<16;++r)negm[r]=sl2*(float)((r&3)+8*(r>>2))+lb; } asm volatile("":"+v"(negm));
  const int qrel=wid*QBLK+r32;
  #define CMASK(P0,P1,t) do{int jb_=(t)-(NT-4); if(jb_>=0)cmask(P0,P1,jb_,qrel,hi);}while(0)
  bool resc=false;
  #define START(P0,P1) do{ const float rm=rowmax2(P0,P1,k32); resc=false; \
    { const float dl=max2f(rm,0.f),dl1=fsub_s(dl,k32); mhat=fadd_s(mhat,dl); \
      _Pragma("unroll") for(int r=0;r<16;++r){P0[r]=fsub_s(P0[r],dl);P1[r]=fsub_s(P1[r],dl1);} \
      _Pragma("unroll") for(int r=0;r<16;++r)negm[r]=fadd_s(negm[r],fsub_s(k64,dl)); asm volatile("":"+v"(negm)); } \
    _Pragma("unroll") for(int r=0;r<16;++r)P0[r]=__builtin_amdgcn_exp2f(P0[r]); }while(0)
  #define RESC() do{ if(resc){ asm volatile("s_waitcnt lgkmcnt(0)":::"memory"); \
      _Pragma("unroll") for(int d_=0;d_<2;++d_) _Pragma("unroll") for(int r=0;r<16;++r)o[d_][r]*=wsf[crow(r,hi)]; } }while(0)
  f32x16 pA0,pA1,pB0,pB1;
  int sl_prev=0,sl_cur=0,sl_next=SLOTB;
  #define ROT() do{sl_prev=sl_cur;sl_cur=sl_next;sl_next=(sl_next==(NSLOT-1)*SLOTB)?0:sl_next+SLOTB;}while(0)
  DMA_K(2,2*SLOTB);
  WAIT_BAR(3);
  qkt(pA0,pA1,Kbase,qr,negm,r32,hi);asm volatile("s_nop 15\n\ts_nop 7":"+v"(pA0),"+v"(pA1));CMASK(pA0,pA1,0);
  START(pA0,pA1);
  _Pragma("unroll") for(int r=0;r<16;++r)pA1[r]=__builtin_amdgcn_exp2f(pA1[r]);
  WAIT_BAR(0);
  DMA_K(3,0);DMA_V(1,SLOTB);
  ROT();
  kload8(kf,kp0+sl_cur);
  WAIT_BAR(2);
  s16x4 vlo[8],vhi[8]; u32x4 pw0,pw1,pw2,pw3;
  #define PKW(P,B) cvtpk_s(P[B],P[B+1])
  #define PAF(k) __builtin_bit_cast(bf16x8,pw##k)
  #define VFR(i) (bf16x8){vlo[i][0],vlo[i][1],vlo[i][2],vlo[i][3],vhi[i][0],vhi[i][1],vhi[i][2],vhi[i][3]}
  #define PIN(x) asm volatile("":"+v"(x))
  #define MX3(a,b,c) __builtin_fmaxf(__builtin_fmaxf((a),(b)),(c))
  #define GAPA(MF,A0,A1,A2,A3,W0,W1,PW) do{ MF; sacc+=A0; sacc+=A1; sacc+=A2; sacc+=A3; PIN(sacc); W0; W1; PIN(PW); SBAR(); }while(0)
  #define EX(v) __builtin_amdgcn_exp2f(v)
  #define GAPB(MF,X,B) do{ MF; X[B]=EX(X[B]); X[B+1]=EX(X[B+1]); X[B+2]=EX(X[B+2]); X[B+3]=EX(X[B+3]); PIN(X); SBAR(); }while(0)
  #define GAPB1(MF,X,B) do{ MF; X[B]=EX(X[B]+k32); X[B+1]=EX(X[B+1]+k32); X[B+2]=EX(X[B+2]+k32); X[B+3]=EX(X[B+3]+k32); PIN(X); SBAR(); }while(0)
  #define VRD(i) do{ vlo[i]=vtr(vp_+(((i)>>2)*4096+((i)&3)*1024)); vhi[i]=vtr(vp_+(((i)>>2)*4096+((i)&3)*1024+512)); }while(0)
  #define KRD(G,j) do{ if(G){ kload2(kf,kp0+sl_next,j); SBAR(); } }while(0)
  #define STEP(C0,C1,P0,P1,t,GK,GV,GL) do{ SBAR(); \
    const lds_cptr vp_=vp0+sl_prev; \
    VRD(0); SBAR(); float sacc=(P0[0]+P0[1]); \
    GAPA(C0=__builtin_amdgcn_mfma_f32_32x32x16_bf16(kf[0],qr[0],negm,0,0,0), P0[2],P0[3],P0[4],P0[5],     pw0[0]=PKW(P0,0), pw0[1]=PKW(P0,2), pw0); \
    VRD(4); SBAR(); GAPA(C1=__builtin_amdgcn_mfma_f32_32x32x16_bf16(kf[1],qr[0],negm,0,0,0), P0[6],P0[7],P0[8],P0[9],     pw0[2]=PKW(P0,4), pw0[3]=PKW(P0,6), pw0); \
    VRD(1); SBAR(); GAPA(C0=__builtin_amdgcn_mfma_f32_32x32x16_bf16(kf[2],qr[1],C0,0,0,0),   P0[10],P0[11],P0[12],P0[13], pw1[0]=PKW(P0,8), pw1[1]=PKW(P0,10), pw1); \
    VRD(5); SBAR(); GAPA(C1=__builtin_amdgcn_mfma_f32_32x32x16_bf16(kf[3],qr[1],C1,0,0,0),   P0[14],P0[15],P1[0],P1[1],   pw1[2]=PKW(P0,12),pw1[3]=PKW(P0,14), pw1); \
    VRD(2); SBAR(); GAPA(C0=__builtin_amdgcn_mfma_f32_32x32x16_bf16(kf[4],qr[2],C0,0,0,0),   P1[2],P1[3],P1[4],P1[5],     pw2[0]=PKW(P1,0), pw2[1]=PKW(P1,2), pw2); \
    VRD(6); SBAR(); GAPA(C1=__builtin_amdgcn_mfma_f32_32x32x16_bf16(kf[5],qr[2],C1,0,0,0),   P1[6],P1[7],P1[8],P1[9],     pw2[2]=PKW(P1,4), pw2[3]=PKW(P1,6), pw2); \
    VRD(3); SBAR(); GAPA(C0=__builtin_amdgcn_mfma_f32_32x32x16_bf16(kf[6],qr[3],C0,0,0,0),   P1[10],P1[11],P1[12],P1[13], pw3[0]=PKW(P1,8), pw3[1]=PKW(P1,10), pw3); \
    VRD(7); SBAR(); GAPA(C1=__builtin_amdgcn_mfma_f32_32x32x16_bf16(kf[7],qr[3],C1,0,0,0),   P1[14],P1[15],0.f,0.f,       pw3[2]=PKW(P1,12),pw3[3]=PKW(P1,14), pw3); \
    l_reg+=sacc; \
    if(GK){DMA_K((t)+3,sl_cur);} if(GV){DMA_V((t)+1,sl_next);} \
    CMASK(C0,C1,t); \
    { float a=MX3(C0[0],C0[1],C0[2]),b=MX3(C1[0],C1[1],C1[2]); \
      _Pragma("unroll") for(int r=3;r<15;r+=2){a=MX3(a,C0[r],C0[r+1]);b=MX3(b,C1[r],C1[r+1]);} \
      a=__builtin_fmaxf(a,C0[15]); b=__builtin_fmaxf(b,C1[15]); \
      float rm=__builtin_fmaxf(a,b+k32); { auto rr=__builtin_amdgcn_permlane32_swap(__float_as_uint(rm),__float_as_uint(rm),false,false); rm=__builtin_fmaxf(__uint_as_float(rr[0]),__uint_as_float(rr[1])); } \
      resc=false; float tadv=k64; \
      if(__builtin_expect(__any(rm>(float)THRL),0)){ const float dl=__builtin_fmaxf(rm,0.f); mhat+=dl; tadv=k64-dl; \
        _Pragma("unroll") for(int r=0;r<16;++r){C0[r]-=dl;C1[r]-=dl;} \
        const float f=__builtin_amdgcn_exp2f(-dl); l_reg*=f; if(hi==0)wsf[r32]=f; resc=true; } \
      _Pragma("unroll") for(int r=0;r<16;++r)negm[r]+=tadv; asm volatile("":"+v"(negm)); } \
    SBAR(); \
    GAPB(o[0]=__builtin_amdgcn_mfma_f32_32x32x16_bf16(PAF(0),VFR(0),o[0],0,0,0), C0,0); \
    GAPB(o[1]=__builtin_amdgcn_mfma_f32_32x32x16_bf16(PAF(0),VFR(4),o[1],0,0,0), C0,4); \
    KRD(GL,0); GAPB(o[0]=__builtin_amdgcn_mfma_f32_32x32x16_bf16(PAF(1),VFR(1),o[0],0,0,0), C0,8); \
    KRD(GL,1); GAPB(o[1]=__builtin_amdgcn_mfma_f32_32x32x16_bf16(PAF(1),VFR(5),o[1],0,0,0), C0,12); \
    KRD(GL,2); GAPB1(o[0]=__builtin_amdgcn_mfma_f32_32x32x16_bf16(PAF(2),VFR(2),o[0],0,0,0), C1,0); \
    KRD(GL,3); GAPB1(o[1]=__builtin_amdgcn_mfma_f32_32x32x16_bf16(PAF(2),VFR(6),o[1],0,0,0), C1,4); \
    GAPB1(o[0]=__builtin_amdgcn_mfma_f32_32x32x16_bf16(PAF(3),VFR(3),o[0],0,0,0), C1,8); \
    GAPB1(o[1]=__builtin_amdgcn_mfma_f32_32x32x16_bf16(PAF(3),VFR(7),o[1],0,0,0), C1,12); \
    }while(0)
  int t=1;
  #undef CMASK
  #define CMASK(P0,P1,t) do{}while(0)
  for(;t+5<NT;t+=2){
    STEP(pB0,pB1,pA0,pA1,t,true,true,true);     WAIT_BAR(2); RESC(); ROT();
    STEP(pA0,pA1,pB0,pB1,t+1,true,true,true);   WAIT_BAR(2); RESC(); ROT();
  }
  #undef CMASK
  #define CMASK(P0,P1,t) do{int jb_=(t)-(NT-4); if(jb_>=0)cmask(P0,P1,jb_,qrel,hi);}while(0)
  #define ENDW(tt) do{ if((tt)+3<NT){WAIT_BAR(2);} else if((tt)+2<NT){WAIT_BAR(1);} else {WAIT_BAR(0);} }while(0)
  for(;t+1<NT;t+=2){
    STEP(pB0,pB1,pA0,pA1,t,(t+3<NT),(t+1<NT),(t+1<NT));       ENDW(t);   RESC(); ROT();
    STEP(pA0,pA1,pB0,pB1,t+1,(t+4<NT),(t+2<NT),(t+2<NT));     ENDW(t+1); RESC(); ROT();
  }
  STEP(pB0,pB1,pA0,pA1,NT-1,false,false,false); RESC();
  { float sacc=pB0[0]+pB0[1]; _Pragma("unroll") for(int r=2;r<16;++r)sacc+=pB0[r]; _Pragma("unroll") for(int r=0;r<16;++r)sacc+=pB1[r]; l_reg+=sacc;
    pw0=(u32x4){PKW(pB0,0),PKW(pB0,2),PKW(pB0,4),PKW(pB0,6)};pw1=(u32x4){PKW(pB0,8),PKW(pB0,10),PKW(pB0,12),PKW(pB0,14)};pw2=(u32x4){PKW(pB1,0),PKW(pB1,2),PKW(pB1,4),PKW(pB1,6)};pw3=(u32x4){PKW(pB1,8),PKW(pB1,10),PKW(pB1,12),PKW(pB1,14)};
    SBAR(); pv(o,vb0+sl_cur,PAF(0),PAF(1),PAF(2),PAF(3)); }
  #undef PKW
  #undef PAF
  #undef VFR
  #undef PIN
  #undef MX3
  #undef GAPA
  #undef GAPB
  #undef GAPB1
  #undef EX
  #undef VRD
  #undef KRD
  #undef STEP
  #undef ENDW
  {auto rr=__builtin_amdgcn_permlane32_swap(__float_as_uint(l_reg),__float_as_uint(l_reg),false,false);l_reg=__uint_as_float(rr[0])+__uint_as_float(rr[1]);}
  if(hi==0)wsf[32+r32]=l_reg;asm volatile("s_waitcnt lgkmcnt(0)":::"memory");
  float rli[16];
  #pragma unroll
  for(int r=0;r<16;++r)rli[r]=__builtin_amdgcn_rcpf(wsf[32+crow(r,hi)]);
  bf16*Ow=O+(rowbase+q0+wid*QBLK)*DM+h*D;
  { bf16*stg=(bf16*)(shm+LDS_OST)+wid*2048;
    #pragma unroll
    for(int r=0;r<16;++r){const int orow=crow(r,hi);
      #pragma unroll
      for(int d0=0;d0<2;++d0)stg[orow*64+d0*32+r32]=__float2bfloat16(o[d0][r]*rli[r]);}
    asm volatile("s_waitcnt lgkmcnt(0)":::"memory");
    #pragma unroll
    for(int i=0;i<4;++i){const int row=i*8+(lane>>3),ch=lane&7; const u32x4 v=*(const u32x4*)(stg+row*64+ch*8); ATTN_STORE16(Ow+(long)row*DM+ch*8,v);} }
  asm volatile("s_waitcnt lgkmcnt(0)\n\ts_barrier":::"memory");
  #undef DMA_K
  #undef DMA_V
  #undef CMASK
  #undef START
  #undef RESC
  #undef ROT
}
constexpr int ATTN_LDS_BYTES=LDS_BYTES;
#undef SBAR
#undef WAIT_BAR
}
#define GAS __attribute__((address_space(1)))
#define LAS __attribute__((address_space(3)))
typedef unsigned short bf16;
typedef unsigned v4u __attribute__((ext_vector_type(4)));
typedef float f32x4 __attribute__((ext_vector_type(4)));
typedef short bf16x8 __attribute__((ext_vector_type(8)));
typedef GAS unsigned gu32;
typedef GAS unsigned long long gu64;
#define RLX_AGENT __ATOMIC_RELAXED, __HIP_MEMORY_SCOPE_AGENT
#define LDS_WAIT() asm volatile("s_waitcnt lgkmcnt(0)" ::: "memory")
#define VM_WAIT() asm volatile("s_waitcnt vmcnt(0)" ::: "memory")
__device__ __forceinline__ unsigned long long rt() { return __builtin_amdgcn_s_memrealtime(); }
typedef float hw_f32x2 __attribute__((ext_vector_type(2))); typedef __bf16 hw_bf16x2 __attribute__((ext_vector_type(2)));
__device__ __forceinline__ unsigned pk2(float lo, float hi) { const hw_f32x2 v = {lo, hi}; return __builtin_bit_cast(unsigned, __builtin_convertvector(v, hw_bf16x2)); }
__device__ __forceinline__ unsigned f2bf(float f) { return pk2(f, 0.f) & 0xffffu; }

#define XB_TMO      128
#define XB_XCNT(j)  (256  + 64 * (j))
#define XB_XSUB(j)  (1280 + 64 * (j))
#define XB_XGEN(j)  (2304 + 64 * (j))
#define XB_TOP      3328
#define XB_TOPGEN   3392
#define XCD_BAR_WORDS 3456
#define XB_SPIN_CAP (1u << 18)

__device__ __forceinline__ unsigned xb_ld(unsigned* p)              { return __hip_atomic_load(p, __ATOMIC_RELAXED, __HIP_MEMORY_SCOPE_AGENT); }
__device__ __forceinline__ unsigned xb_add(unsigned* p, unsigned v) { return __hip_atomic_fetch_add(p, v, __ATOMIC_RELAXED, __HIP_MEMORY_SCOPE_AGENT); }
__device__ __forceinline__ unsigned xb_xcc_id() { return (unsigned)__builtin_amdgcn_s_getreg((3 << 11) | 20) & 0xFu; }
#define XB_SPIN(cond, bar) do { unsigned _sp = 0; while (cond) { __builtin_amdgcn_s_sleep(1); \
    if ((++_sp & 255u) == 0u) { if (xb_ld(&(bar)[XB_TMO])) break; if (_sp > XB_SPIN_CAP) { atomicAdd(&(bar)[XB_TMO], 1u); break; } } } } while (0)

struct XcdBarrier {
    unsigned* bar; unsigned x;
    volatile LAS unsigned* st;
};

__device__ __forceinline__ XcdBarrier xcd_barrier_post(unsigned* bar, volatile LAS unsigned* st, bool leader) {
    XcdBarrier b; b.bar = bar; b.x = xb_xcc_id(); b.st = st;
    if (leader) (void)xb_add(&bar[XB_XCNT(b.x)], 1u);
    return b;
}
__device__ __forceinline__ void xcd_barrier_complete(unsigned* bar, unsigned x, unsigned& nloc, unsigned& nx) {
    const unsigned G = gridDim.x * gridDim.y * gridDim.z;
    unsigned sum, cnt, mine, sp = 0u;
    for (;;) {
        sum = 0u; cnt = 0u; mine = 0u;
#pragma unroll
        for (unsigned j = 0; j < 16; ++j) { const unsigned c = xb_ld(&bar[XB_XCNT(j)]); sum += c; cnt += (c > 0u) ? 1u : 0u; mine = (j == x) ? c : mine; }
        if (sum == G) break;
        __builtin_amdgcn_s_sleep(1);
        if ((++sp & 255u) == 0u) { if (xb_ld(&bar[XB_TMO])) break; if (sp > XB_SPIN_CAP) { atomicAdd(&bar[XB_TMO], 1u); break; } }
    }
    nloc = mine > 0u ? mine : 1u; nx = cnt > 0u ? cnt : 1u;
}

__device__ __forceinline__ void xcd_barrier(const XcdBarrier& b, bool leader) {
    asm volatile("s_waitcnt vmcnt(0)" ::: "memory");
    __syncthreads();
    if (leader) {
        unsigned* bar = b.bar;
        __builtin_amdgcn_s_waitcnt(0);
        unsigned nloc = b.st[0], nx = b.st[1];
        if (nloc == 0u) { xcd_barrier_complete(bar, b.x, nloc, nx); b.st[0] = nloc; b.st[1] = nx; }
        const unsigned old = xb_add(&bar[XB_XSUB(b.x)], 1u);
        const unsigned gen = old / nloc;
        if (old + 1u == (gen + 1u) * nloc) {
            __builtin_amdgcn_fence(__ATOMIC_RELEASE, "agent");
            asm volatile("s_waitcnt vmcnt(0)" ::: "memory");
            const unsigned og = xb_add(&bar[XB_TOP], 1u);
            const unsigned tg = og / nx;
            if (og + 1u == (tg + 1u) * nx) xb_add(&bar[XB_TOPGEN], 1u);
            else XB_SPIN(xb_ld(&bar[XB_TOPGEN]) == tg, bar);
            __builtin_amdgcn_fence(__ATOMIC_ACQUIRE, "agent");
            xb_add(&bar[XB_XGEN(b.x)], 1u);
            asm volatile("s_waitcnt vmcnt(0)" ::: "memory");
        } else {
            XB_SPIN(xb_ld(&bar[XB_XGEN(b.x)]) == gen, bar);
            __builtin_amdgcn_fence(__ATOMIC_ACQUIRE, "agent");
            asm volatile("s_waitcnt vmcnt(0)" ::: "memory");
        }
    }
    __syncthreads();
}
constexpr int DM = 2048, SEQ = 2048, NBP = 4, MP = NBP * SEQ, NBS = 8, TS = 8, MS = NBS * TS, M_ALL = MP + MS, M_PAD = 8448;
constexpr int PAST = 16384, PAGE = 128, NPAGES = PAST / PAGE;
constexpr int NH = 8, HD = 128;
constexpr int CONVD = 3072, INW = 7184, INW_PAD = 7424, FF = 5632, GU = 2 * FF;
constexpr int C_K = 1024, C_V = 2048, C_QKVB = 3072, C_Z = 6144, C_B = 7168, C_A = 7176;
constexpr float EPS = 1e-6f, LOG2E = 1.4426950408889634f, C2 = 0.125f * LOG2E;
constexpr int NWAVES = 8, NTHREADS = NWAVES * 64;
constexpr int PGU = 4, NSPLIT = NPAGES / PGU, NSP = NSPLIT + 1;
constexpr int NCHUNK_P = NBP * NH * (SEQ / 64), NCHUNK = NCHUNK_P + NBS * NH;
constexpr size_t OUT_Y = 0, OUT_KP = (size_t)M_ALL * DM, OUT_VP = OUT_KP + (size_t)MP * 1024, OUT_SSMP = OUT_VP + (size_t)MP * 1024,
                 OUT_CONVP = OUT_SSMP + (size_t)NBP * NH * 16384, OUT_KS = OUT_CONVP + (size_t)NBP * 3 * CONVD, OUT_VS = OUT_KS + (size_t)MS * 1024,
                 OUT_SSMS = OUT_VS + (size_t)MS * 1024, OUT_CONVS = OUT_SSMS + (size_t)NBS * NH * 16384, OUT_END = OUT_CONVS + (size_t)NBS * 3 * CONVD;
constexpr size_t MiB = 1u << 20;
constexpr size_t WS_CTL = 0, CTL_ZERO_BYTES = 1 * MiB;
constexpr size_t WS_W1GU = 16 * MiB, WS_W1D = 60 * MiB, WS_WIN = 82 * MiB, WS_WOUT = 111 * MiB, WS_W2GU = 119 * MiB, WS_W2D = 163 * MiB;
constexpr size_t WS_XN = 192 * MiB, WS_ACT = 226 * MiB, WS_F = 320 * MiB, WS_X1 = 388 * MiB, WS_X2 = 456 * MiB, WS_C1 = 528 * MiB, WS_H = 896 * MiB;
constexpr size_t WS_QKVB = 896 * MiB, WS_Z = 946 * MiB, WS_BA = 963 * MiB, WS_HS = 964 * MiB;
constexpr size_t WS_QB = 1136 * MiB, WS_KB = 1153 * MiB, WS_VB = 1170 * MiB;
constexpr size_t WS_UT = 1322 * MiB, WS_WC = 1356 * MiB, WS_QG = 1373 * MiB, WS_KDT = 1390 * MiB, WS_QKC = 1407 * MiB, WS_EGL = 1416 * MiB, WS_OG = 1424 * MiB, WS_O1 = 1458 * MiB, WS_O2 = 1491 * MiB, WS_MIX = 1526 * MiB, WS_PM = 1560 * MiB, WS_PL = 1561 * MiB, WS_PO = 1562 * MiB, WS_END = 1600 * MiB;
static_assert(WS_QKVB + (size_t)M_ALL * CONVD * 2 <= WS_Z && WS_Z + (size_t)M_ALL * 1024 * 2 <= WS_BA && WS_BA + (size_t)M_ALL * 16 * 4 <= WS_HS && WS_HS + (size_t)MS * INW_PAD * 4 <= WS_QB, "d_ws map 2");
static_assert(WS_W1GU + (size_t)GU * DM * 2 <= WS_W1D && WS_W1D + (size_t)DM * FF * 2 <= WS_WIN && WS_WIN + (size_t)INW_PAD * DM * 2 <= WS_WOUT && WS_WOUT + (size_t)DM * DM * 2 <= WS_W2GU &&
              WS_W2GU + (size_t)GU * DM * 2 <= WS_W2D && WS_W2D + (size_t)DM * FF * 2 <= WS_XN && WS_XN + (size_t)M_PAD * DM * 2 <= WS_ACT && WS_ACT + (size_t)M_PAD * FF * 2 <= WS_F &&
              WS_F + (size_t)M_PAD * DM * 4 <= WS_X1 && WS_X1 + (size_t)M_ALL * DM * 4 <= WS_X2 && WS_X2 + (size_t)M_ALL * DM * 4 <= WS_C1 && WS_C1 + (size_t)M_PAD * GU * 4 <= WS_H &&
              WS_H + (size_t)M_PAD * INW_PAD * 4 <= WS_QB && WS_QB + (size_t)M_PAD * 1024 * 2 <= WS_KB && WS_VB + (size_t)M_PAD * 1024 * 2 <= WS_UT && WS_UT + (size_t)NCHUNK * 8192 * 4 <= WS_WC && WS_WC + (size_t)NCHUNK * 8192 * 2 <= WS_QG && WS_QG + (size_t)NCHUNK * 8192 * 2 <= WS_KDT &&
              WS_KDT + (size_t)NCHUNK * 8192 * 2 <= WS_QKC && WS_QKC + (size_t)NCHUNK * 4096 * 2 <= WS_EGL && WS_EGL + (size_t)NCHUNK * 4 <= WS_OG && WS_OG + (size_t)M_ALL * 1024 * 4 <= WS_O1 && WS_O1 + (size_t)M_ALL * 1024 * 4 <= WS_O2 && WS_O2 + (size_t)M_ALL * 1024 * 4 <= WS_MIX &&
              WS_MIX + (size_t)M_PAD * DM * 2 <= WS_PM && WS_PO + (size_t)NBS * NH * NSP * 16 * 128 * 4 <= WS_END, "d_ws map");
constexpr int CW_QCTR = 64;
constexpr int CW_BAR = 4096;
constexpr int RING_OFF = 0, RING_BYTES = 131072, LDSCTL_OFF = RING_BYTES, LDS_BYTES = 147456, MISC_OFF = LDS_BYTES - 256;

#ifndef NT_WSTORE
#define NT_WSTORE 0
#endif
#ifndef CONV_NFAST
#define CONV_NFAST 1
#endif
#ifndef THIN_PIPE
#define THIN_PIPE 0
#endif
#ifndef CONV_PIPE
#define CONV_PIPE 1
#endif
#ifndef NT_OUT
#define NT_OUT 0
#endif
#ifndef CONV_TAILS
#define CONV_TAILS 0
#endif
#ifndef REP_PRO
#define REP_PRO 1
#endif
#ifndef REP_PREP
#define REP_PREP 1
#endif
#ifndef REP_SCAN
#define REP_SCAN 1
#endif
#ifndef REP_SATT
#define REP_SATT 1
#endif
#ifndef REP_FLASH
#define REP_FLASH 1
#endif
#ifndef REP_THIN
#define REP_THIN 1
#endif
#ifndef REP_G1
#define REP_G1 1
#endif
#ifndef MK_N_LAUNCHES
#define MK_N_LAUNCHES 1
#endif
constexpr int NPHASE = 13;

struct Args { const void* in[30]; float* out; unsigned char* ws; int ph_lo, ph_hi; };
struct Frame {
    const Args& A;
    LAS unsigned char* lds; volatile LAS unsigned* MISC; gu32* ctl; char* lds_g;
    int tid, lane, wave, G, gw, NGW, z; unsigned char* ws;
    __device__ __forceinline__ Frame(const Args& a) : A(a) {}
    __device__ __forceinline__ const float* xp() const { return (const float*)A.in[0 + z]; }
    __device__ __forceinline__ const float* xs() const { return (const float*)A.in[1 + z]; }
    __device__ __forceinline__ const float* cache_k() const { return (const float*)A.in[2 + z]; }
    __device__ __forceinline__ const float* cache_v() const { return (const float*)A.in[3 + z]; }
    __device__ __forceinline__ const float* state_ssm() const { return (const float*)A.in[4 + z]; }
    __device__ __forceinline__ const float* state_conv() const { return (const float*)A.in[5 + z]; }
    __device__ __forceinline__ const int* page_table() const { return (const int*)A.in[6 + z]; }
    __device__ __forceinline__ const float* ffn1_pre() const { return (const float*)A.in[7 + z]; }
    __device__ __forceinline__ const float* ffn1_post() const { return (const float*)A.in[8 + z]; }
    __device__ __forceinline__ const float* gate1() const { return (const float*)A.in[9 + z]; }
    __device__ __forceinline__ const float* up1() const { return (const float*)A.in[10 + z]; }
    __device__ __forceinline__ const float* down1() const { return (const float*)A.in[11 + z]; }
    __device__ __forceinline__ const float* mix_pre() const { return (const float*)A.in[12 + z]; }
    __device__ __forceinline__ const float* mix_post() const { return (const float*)A.in[13 + z]; }
    __device__ __forceinline__ const float* w_in() const { return (const float*)A.in[14 + z]; }
    __device__ __forceinline__ const float* conv_w() const { return (const float*)A.in[15 + z]; }
    __device__ __forceinline__ const float* a_log() const { return (const float*)A.in[16 + z]; }
    __device__ __forceinline__ const float* dt_bias() const { return (const float*)A.in[17 + z]; }
    __device__ __forceinline__ const float* dnorm_w() const { return (const float*)A.in[18 + z]; }
    __device__ __forceinline__ const float* lq1() const { return (const float*)A.in[19 + z]; }
    __device__ __forceinline__ const float* lk1() const { return (const float*)A.in[20 + z]; }
    __device__ __forceinline__ const float* lq2() const { return (const float*)A.in[21 + z]; }
    __device__ __forceinline__ const float* lk2() const { return (const float*)A.in[22 + z]; }
    __device__ __forceinline__ const float* subln_w() const { return (const float*)A.in[23 + z]; }
    __device__ __forceinline__ const float* w_out() const { return (const float*)A.in[24 + z]; }
    __device__ __forceinline__ const float* ffn2_pre() const { return (const float*)A.in[25 + z]; }
    __device__ __forceinline__ const float* ffn2_post() const { return (const float*)A.in[26 + z]; }
    __device__ __forceinline__ const float* gate2() const { return (const float*)A.in[27 + z]; }
    __device__ __forceinline__ const float* up2() const { return (const float*)A.in[28 + z]; }
    __device__ __forceinline__ const float* down2() const { return (const float*)A.in[29 + z]; }
    __device__ __forceinline__ float* out() const { return A.out; }
    __device__ __forceinline__ bf16* F16() const { return (bf16*)(ws + WS_C1); }
    __device__ __forceinline__ bf16* X1h() const { return (bf16*)(ws + WS_X1); }
    __device__ __forceinline__ bf16* X2h() const { return (bf16*)(ws + WS_X2); }
    __device__ __forceinline__ bf16* QKVB() const { return (bf16*)(ws + WS_QKVB); }
    __device__ __forceinline__ bf16* Zb() const { return (bf16*)(ws + WS_Z); }
    __device__ __forceinline__ float* BA() const { return (float*)(ws + WS_BA); }
    __device__ __forceinline__ float* HS() const { return (float*)(ws + WS_HS); }
    __device__ __forceinline__ float* PM() const { return (float*)(ws + WS_PM); }
    __device__ __forceinline__ float* PL() const { return (float*)(ws + WS_PL); }
    __device__ __forceinline__ float* PO() const { return (float*)(ws + WS_PO); }
    __device__ __forceinline__ bf16* W1GU() const { return (bf16*)(ws + WS_W1GU); }
    __device__ __forceinline__ bf16* W1D() const { return (bf16*)(ws + WS_W1D); }
    __device__ __forceinline__ bf16* WIN() const { return (bf16*)(ws + WS_WIN); }
    __device__ __forceinline__ bf16* WOUT() const { return (bf16*)(ws + WS_WOUT); }
    __device__ __forceinline__ bf16* W2GU() const { return (bf16*)(ws + WS_W2GU); }
    __device__ __forceinline__ bf16* W2D() const { return (bf16*)(ws + WS_W2D); }
    __device__ __forceinline__ bf16* X0h() const { return (bf16*)(ws + WS_XN); }
    __device__ __forceinline__ float* RS() const { return (float*)(ws + WS_CTL + 512 * 1024); }
    __device__ __forceinline__ bf16* ACT() const { return (bf16*)(ws + WS_ACT); }
    __device__ __forceinline__ bf16* QB() const { return (bf16*)(ws + WS_QB); }
    __device__ __forceinline__ bf16* KB() const { return (bf16*)(ws + WS_KB); }
    __device__ __forceinline__ bf16* VB() const { return (bf16*)(ws + WS_VB); }
    __device__ __forceinline__ bf16* MIX() const { return (bf16*)(ws + WS_MIX); }
    __device__ __forceinline__ bf16* O1b() const { return (bf16*)(ws + WS_O1); }
    __device__ __forceinline__ bf16* O2b() const { return (bf16*)(ws + WS_O2); }
    __device__ __forceinline__ bf16* WC() const { return (bf16*)(ws + WS_WC); }
    __device__ __forceinline__ bf16* QGc() const { return (bf16*)(ws + WS_QG); }
    __device__ __forceinline__ bf16* KDTc() const { return (bf16*)(ws + WS_KDT); }
    __device__ __forceinline__ bf16* QKc() const { return (bf16*)(ws + WS_QKC); }
    __device__ __forceinline__ float* Fb() const { return (float*)(ws + WS_F); }
    __device__ __forceinline__ float* X1() const { return (float*)(ws + WS_X1); }
    __device__ __forceinline__ float* X2() const { return (float*)(ws + WS_X2); }
    __device__ __forceinline__ float* C1() const { return (float*)(ws + WS_C1); }
    __device__ __forceinline__ float* H() const { return (float*)(ws + WS_H); }
    __device__ __forceinline__ float* UT() const { return (float*)(ws + WS_UT); }
    __device__ __forceinline__ float* EGL() const { return (float*)(ws + WS_EGL); }
    __device__ __forceinline__ bf16* OG() const { return (bf16*)(ws + WS_OG); }
};

#define LDS_BARRIER() asm volatile("s_waitcnt lgkmcnt(0)\n\ts_barrier" ::: "memory")
__device__ __forceinline__ int lane_id() { int r; asm volatile("v_mbcnt_lo_u32_b32 %0, -1, 0\n\tv_mbcnt_hi_u32_b32 %0, -1, %0" : "=v"(r)); return r; }
template <int X> __device__ __forceinline__ float xor_lane(float v) {
    if (X < 32) return __int_as_float(__builtin_amdgcn_ds_swizzle(__float_as_int(v), (X << 10) | 0x1f));
    else { auto rr = __builtin_amdgcn_permlane32_swap(__float_as_uint(v), __float_as_uint(v), false, false); return __uint_as_float(rr[0]) == v ? __uint_as_float(rr[1]) : __uint_as_float(rr[0]); }
}
__device__ __forceinline__ float xor32_sum(float v) { auto rr = __builtin_amdgcn_permlane32_swap(__float_as_uint(v), __float_as_uint(v), false, false); return __uint_as_float(rr[0]) + __uint_as_float(rr[1]); }
__device__ __forceinline__ float xor32_max(float v) { auto rr = __builtin_amdgcn_permlane32_swap(__float_as_uint(v), __float_as_uint(v), false, false); return fmaxf(__uint_as_float(rr[0]), __uint_as_float(rr[1])); }
__device__ __forceinline__ float sum16(float v) { v += xor_lane<1>(v); v += xor_lane<2>(v); v += xor_lane<4>(v); v += xor_lane<8>(v); return v; }
__device__ __forceinline__ float max16(float v) { v = fmaxf(v, xor_lane<1>(v)); v = fmaxf(v, xor_lane<2>(v)); v = fmaxf(v, xor_lane<4>(v)); v = fmaxf(v, xor_lane<8>(v)); return v; }
__device__ __forceinline__ float wave_sum(float v) { v = sum16(v); v += xor_lane<16>(v); return xor32_sum(v); }
__device__ __forceinline__ float wave_max(float v) { v = max16(v); v = fmaxf(v, xor_lane<16>(v)); return xor32_max(v); }
__device__ __forceinline__ float bf2f(unsigned short b) { return __uint_as_float(((unsigned)b) << 16); }
__device__ __forceinline__ float silu_f(float x) { return x * __builtin_amdgcn_rcpf(1.f + __expf(-x)); }
__device__ __forceinline__ float sigmoid_f(float x) { return __builtin_amdgcn_rcpf(1.f + __expf(-x)); }
__device__ __forceinline__ float softplus_f(float x) { return x > 20.f ? x : __logf(1.f + __expf(x)); }

struct EpiF32 {
    static constexpr bool PERM = false, AFTER_DRAIN = false;
    float* C; int ldc;
    __device__ __forceinline__ void operator()(const pg8::f32x4 (&acc)[2][2][4][2], const pg8::Unit& u, int wr, int wc, int fr, int fq) const {
        const int col0 = u.pn * pg8::BM + wc * 32 + 4 * fq;
#pragma unroll
        for (int ai = 0; ai < 2; ++ai)
#pragma unroll
            for (int m = 0; m < 4; ++m) {
                const int r = u.pm * pg8::BM + ai * pg8::HALF + wr * 64 + m * 16 + fr;
                float* rowp = C + (size_t)r * ldc + col0;
#pragma unroll
                for (int bj = 0; bj < 2; ++bj)
#pragma unroll
                    for (int n = 0; n < 2; ++n) *(pg8::f32x4*)(rowp + bj * pg8::HALF + n * 16) = acc[ai][bj][m][n];
            }
    }
};

struct EpiBf {
    static constexpr bool PERM = true, AFTER_DRAIN = false;
    bf16* O;
    __device__ __forceinline__ void operator()(const pg8::f32x4 (&acc)[2][2][4][2], const pg8::Unit& u, int wr, int wc, int fr, int fq) const {
        const int col0 = u.pn * pg8::BM + wc * 32 + 8 * fq;
#pragma unroll
        for (int ai = 0; ai < 2; ++ai)
#pragma unroll
            for (int m = 0; m < 4; ++m) { bf16* rowp = O + (size_t)(u.pm * pg8::BM + ai * pg8::HALF + wr * 64 + m * 16 + fr) * DM + col0;
#pragma unroll
                for (int bj = 0; bj < 2; ++bj) { const pg8::f32x4 v0 = acc[ai][bj][m][0], v1 = acc[ai][bj][m][1];
                    pg8::u32x4 w; w.x = pg8::cvt_pk_bf16(v0[0], v0[1]); w.y = pg8::cvt_pk_bf16(v0[2], v0[3]); w.z = pg8::cvt_pk_bf16(v1[0], v1[1]); w.w = pg8::cvt_pk_bf16(v1[2], v1[3]);
                    *(pg8::u32x4*)(rowp + bj * pg8::HALF) = w; } }
    }
};
struct EpiAct {
    static constexpr bool PERM = true, AFTER_DRAIN = false;
    bf16* O; const float* RS;
    __device__ __forceinline__ void operator()(const pg8::f32x4 (&acc)[2][2][4][2], const pg8::Unit& u, int wr, int wc, int fr, int fq) const {
        const int col0 = u.pn * 128 + wc * 32 + 8 * fq;
#pragma unroll
        for (int ai = 0; ai < 2; ++ai)
#pragma unroll
            for (int m = 0; m < 4; ++m) {
                const int r = u.pm * pg8::BM + ai * pg8::HALF + wr * 64 + m * 16 + fr;
                const float rs = RS[r];
                const pg8::f32x4 g0 = acc[ai][0][m][0] * rs, g1 = acc[ai][0][m][1] * rs, u0 = acc[ai][1][m][0] * rs, u1 = acc[ai][1][m][1] * rs;
                pg8::u32x4 w;
                w.x = pg8::cvt_pk_bf16(silu_f(g0[0]) * u0[0], silu_f(g0[1]) * u0[1]); w.y = pg8::cvt_pk_bf16(silu_f(g0[2]) * u0[2], silu_f(g0[3]) * u0[3]);
                w.z = pg8::cvt_pk_bf16(silu_f(g1[0]) * u1[0], silu_f(g1[1]) * u1[1]); w.w = pg8::cvt_pk_bf16(silu_f(g1[2]) * u1[2], silu_f(g1[3]) * u1[3]);
                *(pg8::u32x4*)(O + (size_t)r * FF + col0) = w;
            }
    }
};
struct EpiIn {
    static constexpr bool PERM = true, AFTER_DRAIN = false;
    bf16 *QBp, *KBp, *VBp, *QKVBp, *Zp; float *BAp, *out; const float* RS;
    __device__ __forceinline__ void operator()(const pg8::f32x4 (&acc)[2][2][4][2], const pg8::Unit& u, int wr, int wc, int fr, int fq) const {
        const int pn = u.pn;
#pragma unroll
        for (int ai = 0; ai < 2; ++ai)
#pragma unroll
            for (int m = 0; m < 4; ++m) {
                const int r = u.pm * pg8::BM + ai * pg8::HALF + wr * 64 + m * 16 + fr; const float rs = RS[r];
#pragma unroll
                for (int bj = 0; bj < 2; ++bj) {
                    const int c8 = pn * 256 + bj * 128 + wc * 32 + 8 * fq;
                    pg8::f32x4 v0 = acc[ai][bj][m][0] * rs, v1 = acc[ai][bj][m][1] * rs;
                    if (pn == 28) { if (c8 < C_B + 16) { *(pg8::f32x4*)(BAp + (size_t)r * 16 + (c8 - C_B)) = v0; *(pg8::f32x4*)(BAp + (size_t)r * 16 + (c8 - C_B) + 4) = v1; } continue; }
                    bf16* dst;
                    if (pn < 4) { dst = QBp + (size_t)r * 1024 + c8; v0 = v0 * C2; v1 = v1 * C2; }
                    else if (pn < 8) { dst = KBp + (size_t)r * 1024 + (c8 - C_K); float* o = out + OUT_KP + (size_t)r * 1024 + (c8 - C_K); if (NT_OUT) { __builtin_nontemporal_store(v0, (pg8::f32x4*)o); __builtin_nontemporal_store(v1, (pg8::f32x4*)(o + 4)); } else { *(pg8::f32x4*)o = v0; *(pg8::f32x4*)(o + 4) = v1; } }
                    else if (pn < 12) { dst = VBp + (size_t)r * 1024 + (c8 - C_V); float* o = out + OUT_VP + (size_t)r * 1024 + (c8 - C_V); if (NT_OUT) { __builtin_nontemporal_store(v0, (pg8::f32x4*)o); __builtin_nontemporal_store(v1, (pg8::f32x4*)(o + 4)); } else { *(pg8::f32x4*)o = v0; *(pg8::f32x4*)(o + 4) = v1; } }
                    else if (pn < 24) { dst = QKVBp + (size_t)r * CONVD + (c8 - C_QKVB); const int t = r & (SEQ - 1);
                        if (t >= SEQ - 3) { float* o = out + OUT_CONVP + (size_t)((r >> 11) * 3 + (t - (SEQ - 3))) * CONVD + (c8 - C_QKVB); *(pg8::f32x4*)o = v0; *(pg8::f32x4*)(o + 4) = v1; } }
                    else { dst = Zp + (size_t)r * 1024 + (c8 - C_Z); }
                    pg8::u32x4 w; w.x = pg8::cvt_pk_bf16(v0[0], v0[1]); w.y = pg8::cvt_pk_bf16(v0[2], v0[3]); w.z = pg8::cvt_pk_bf16(v1[0], v1[1]); w.w = pg8::cvt_pk_bf16(v1[2], v1[3]);
                    *(pg8::u32x4*)dst = w;
                }
            }
    }
};
struct SkEpiF32 { float* C; __device__ __forceinline__ float rowscale(int) const { return 1.f; } __device__ __forceinline__ void operator()(int row, int c, float v0, float, float) const { C[(size_t)row * DM + c] = v0; } };
struct SkEpiAct { bf16* O; const float* RS; __device__ __forceinline__ float rowscale(int row) const { return RS[row]; } __device__ __forceinline__ void operator()(int row, int c, float g, float u, float rs) const { O[(size_t)row * FF + c] = (bf16)f2bf(silu_f(g * rs) * (u * rs)); } };
struct SkEpiIn {
    bf16 *QBp, *KBp, *VBp, *QKVBp, *Zp; float *BAp, *out; const float* RS;
    __device__ __forceinline__ float rowscale(int row) const { return RS[row]; }
    __device__ __forceinline__ void operator()(int ms, int c, float v, float, float rs) const {
        v *= rs;
        if (c < C_K) QBp[(size_t)ms * 1024 + c] = (bf16)f2bf(v * C2);
        else if (c < C_V) { KBp[(size_t)ms * 1024 + (c - C_K)] = (bf16)f2bf(v); out[OUT_KS + (size_t)ms * 1024 + (c - C_K)] = v; }
        else if (c < C_QKVB) { VBp[(size_t)ms * 1024 + (c - C_V)] = (bf16)f2bf(v); out[OUT_VS + (size_t)ms * 1024 + (c - C_V)] = v; }
        else if (c < C_Z) { QKVBp[(size_t)ms * CONVD + (c - C_QKVB)] = (bf16)f2bf(v); const int t = ms % TS;
            if (t >= TS - 3) out[OUT_CONVS + (size_t)((ms / TS) * 3 + (t - (TS - 3))) * CONVD + (c - C_QKVB)] = v; }
        else if (c < C_B) Zp[(size_t)ms * 1024 + (c - C_Z)] = (bf16)f2bf(v);
        else if (c < INW) BAp[(size_t)ms * 16 + (c - C_B)] = v;
    }
};
struct SkEpiAddF32 { float* C; __device__ __forceinline__ float rowscale(int) const { return 1.f; } __device__ __forceinline__ void operator()(int row, int c, float v0, float, float) const { __hip_atomic_fetch_add(C + (size_t)row * DM + c, v0, __ATOMIC_RELAXED, __HIP_MEMORY_SCOPE_AGENT); } };
template <int NB, int KS, class Epi, int GOFF = 128, bool PAIR = true> __device__ __forceinline__ void skinny_phase(Frame& F, const bf16* A, const bf16* Bt, int K, int ncu, const Epi& E, int wg_lo) {
    if ((int)blockIdx.x < wg_lo) return;
    int lane = lane_id(); asm volatile("" : "+v"(lane));
    const int w = F.wave, n = lane & 15, kq = lane >> 4, kw = K / (8 * KS), tid = 64 * w + lane;
    LAS float* red = (LAS float*)(F.lds + RING_OFF);
    const int ust = F.G - wg_lo, nu = ncu * KS;
    const float rs0 = E.rowscale(tid >> 4), rs1 = E.rowscale(32 + (tid >> 4));
#define SK_PTRS(u_, bp_, ap_, c0_) do { const int cu_ = (u_) / KS, kp_ = (u_) % KS; c0_ = (PAIR ? 16 : 16 * NB) * cu_; \
        const int br0_ = (NB == 1 || !PAIR) ? c0_ : 256 * (c0_ >> 7) + (c0_ & 127);       \
        bp_ = Bt + (size_t)(br0_ + n) * K + (kp_ * 8 + w) * kw + 8 * kq; ap_ = A + (size_t)n * K + (kp_ * 8 + w) * kw + 8 * kq; } while (0)
#define SK_LOAD(bb, aa, bp_, ap_, k_) do { _Pragma("unroll") for (int s2 = 0; s2 < 2; ++s2) if ((k_) + 32 * s2 < kw) { \
        _Pragma("unroll") for (int g = 0; g < NB; ++g) bb[s2][g] = *(const GAS bf16x8*)((bp_) + (size_t)(GOFF * g) * K + (k_) + 32 * s2); \
        _Pragma("unroll") for (int rt = 0; rt < 4; ++rt) aa[s2][rt] = *(const GAS bf16x8*)((ap_) + (size_t)(16 * rt) * K + (k_) + 32 * s2); } } while (0)
#define SK_MMA(bb, aa, k_) do { _Pragma("unroll") for (int s2 = 0; s2 < 2; ++s2) if ((k_) + 32 * s2 < kw) { \
        _Pragma("unroll") for (int rt = 0; rt < 4; ++rt) _Pragma("unroll") for (int g = 0; g < NB; ++g) acc[g][rt] = __builtin_amdgcn_mfma_f32_16x16x32_bf16(aa[s2][rt], bb[s2][g], acc[g][rt], 0, 0, 0); } } while (0)
    bf16x8 bA[2][NB], aA[2][4], bB[2][NB], aB[2][4];
    int u = (int)blockIdx.x - wg_lo, c0 = 0; const bf16* bp = Bt; const bf16* ap = A;
    if (u < nu) { SK_PTRS(u, bp, ap, c0); SK_LOAD(bA, aA, bp, ap, 0); }
    while (u < nu) {
        f32x4 acc[NB][4];
#pragma unroll
        for (int g = 0; g < NB; ++g)
#pragma unroll
            for (int rt = 0; rt < 4; ++rt) acc[g][rt] = (f32x4){0.f, 0.f, 0.f, 0.f};
        for (int k = 0; k < kw; k += 128) {
            if (k + 64 < kw) SK_LOAD(bB, aB, bp, ap, k + 64);
            SK_MMA(bA, aA, k);
            if (k + 128 < kw) SK_LOAD(bA, aA, bp, ap, k + 128);
            if (k + 64 < kw) SK_MMA(bB, aB, k + 64);
        }
        const int un = u + ust, c0_cur = c0;
        if (un < nu) { SK_PTRS(un, bp, ap, c0); SK_LOAD(bA, aA, bp, ap, 0); }
#pragma unroll
        for (int g = 0; g < NB; ++g)
#pragma unroll
            for (int rt = 0; rt < 4; ++rt)
#pragma unroll
                for (int r = 0; r < 4; ++r) red[((g * 8 + w) * 64 + 16 * rt + 4 * kq + r) * 16 + n] = acc[g][rt][r];
        __syncthreads();
#pragma unroll
        for (int q = 0; q < 2; ++q) { const int o = tid + 512 * q; const float rsq = q ? rs1 : rs0; float s0 = 0.f, s1 = 0.f;
#pragma unroll
            for (int ww = 0; ww < 8; ++ww) { s0 += red[ww * 1024 + o]; if (NB == 2) s1 += red[(8 + ww) * 1024 + o]; }
            if (PAIR) E(o >> 4, c0_cur + (o & 15), s0, s1, rsq); else { E(o >> 4, c0_cur + (o & 15), s0, 0.f, rsq); if (NB == 2) E(o >> 4, c0_cur + GOFF + (o & 15), s1, 0.f, rsq); } }
        __syncthreads();
        u = un;
    }
#undef SK_PTRS
#undef SK_LOAD
#undef SK_MMA
}
__device__ __forceinline__ void transpose_item(const float* W, int N, int k0, int n0, bf16* WT, int K, int drow0, LAS float* scr, int lane, const float* ks = nullptr) {
    const int cc = n0 + (lane & 31);
    float ld[32];
#pragma unroll
    for (int i = 0; i < 32; ++i) ld[i] = (cc < N) ? W[(size_t)(k0 + 2 * i + (lane >> 5)) * N + cc] : 0.f;
    if (ks) {
#pragma unroll
        for (int i = 0; i < 32; ++i) ld[i] *= ks[k0 + 2 * i + (lane >> 5)]; }
#pragma unroll
    for (int i = 0; i < 32; ++i) scr[(2 * i + (lane >> 5)) * 33 + (lane & 31)] = ld[i];
    LDS_WAIT(); asm volatile("" ::: "memory");
    const int c = lane & 7;
#pragma unroll
    for (int j = 0; j < 4; ++j) { const int n = (lane >> 3) + 8 * j; const LAS float* s = scr + (8 * c) * 33 + n;
        v4u o; o.x = pk2(s[0 * 33], s[1 * 33]); o.y = pk2(s[2 * 33], s[3 * 33]); o.z = pk2(s[4 * 33], s[5 * 33]); o.w = pk2(s[6 * 33], s[7 * 33]);
#if NT_WSTORE
        __builtin_nontemporal_store(o, (GAS v4u*)(WT + (size_t)(drow0 + n) * K + k0 + 8 * c)); }
#else
        *(GAS v4u*)(WT + (size_t)(drow0 + n) * K + k0 + 8 * c) = o; }
#endif
    LDS_WAIT(); asm volatile("" ::: "memory");
}
__device__ __forceinline__ void tr_gu(const float* W, bf16* WT, int half, int r, LAS float* scr, int lane) {
    constexpr int nblk = FF / 32; const int kb = r / nblk, nb = r % nblk, n0 = 32 * nb;
    transpose_item(W, FF, 64 * kb, n0, WT, DM, 256 * (n0 >> 7) + 128 * half + (n0 & 127), scr, lane);
}
__device__ __forceinline__ void tr_plain(const float* W, int K, int N, int nblk, bf16* WT, int r, LAS float* scr, int lane) {
    const int kb = r / nblk, nb = r % nblk;
    transpose_item(W, N, 64 * kb, 32 * nb, WT, K, 32 * nb, scr, lane);
}
__device__ __forceinline__ f32x4 ld_bf16x4(const bf16* p) { const unsigned long long w = *(const GAS unsigned long long*)p; const unsigned lo = (unsigned)w, hi = (unsigned)(w >> 32);
    return (f32x4){__uint_as_float(lo << 16), __uint_as_float(lo & 0xffff0000u), __uint_as_float(hi << 16), __uint_as_float(hi & 0xffff0000u)}; }
__device__ __forceinline__ void st_bf16x4(bf16* p, f32x4 v) { *(GAS unsigned long long*)p = (unsigned long long)pk2(v.x, v.y) | ((unsigned long long)pk2(v.z, v.w) << 32); }
__device__ __forceinline__ void thin_finish(Frame& F, f32x4 (&v)[8], const f32x4 (&g)[8], bool has_f, int m, float scale, const float* post_w, bf16* xout16, float* xout32, float* rs_out) {
    const int lane = F.lane;
    if (has_f) {
        float ss = 0.f;
#pragma unroll
        for (int j = 0; j < 8; ++j) ss += (g[j].x * g[j].x + g[j].y * g[j].y) + (g[j].z * g[j].z + g[j].w * g[j].w);
        const float rs = scale * rsqrtf(wave_sum(ss) * (1.f / DM) + EPS);
        const GAS f32x4* w4 = (const GAS f32x4*)post_w + lane;
#pragma unroll
        for (int j = 0; j < 8; ++j) { const f32x4 w = w4[64 * j]; v[j] = v[j] + g[j] * w * rs; }
    }
    if (xout16) {
#pragma unroll
        for (int j = 0; j < 8; ++j) st_bf16x4(xout16 + (size_t)m * DM + 4 * (64 * j + lane), v[j]); }
    if (xout32) { GAS f32x4* o4 = (GAS f32x4*)(xout32 + (size_t)m * DM) + lane;
#pragma unroll
        for (int j = 0; j < 8; ++j) { if (NT_OUT) __builtin_nontemporal_store(v[j], o4 + 64 * j); else o4[64 * j] = v[j]; } }
    if (rs_out) {
        float ss = 0.f;
#pragma unroll
        for (int j = 0; j < 8; ++j) ss += (v[j].x * v[j].x + v[j].y * v[j].y) + (v[j].z * v[j].z + v[j].w * v[j].w);
        const float rs = rsqrtf(wave_sum(ss) * (1.f / DM) + EPS);
        if (lane == 0) rs_out[m] = rs;
    }
}
__device__ __forceinline__ void thin_rows(Frame& F, const bf16* xin16, const bf16* f16, float* fs, float scale, const float* post_w, bf16* xout16, float* xout32, float* rs_out) {
    const int lane = F.lane;
    const bool pipe = THIN_PIPE && xin16 && f16;
    if (pipe) {
        typedef unsigned long long u64t;
        u64t ax[8], aq[8], bx[8], bq[8];
#define TH_LOAD(X, Q, m_) do { _Pragma("unroll") for (int j = 0; j < 8; ++j) { X[j] = *(const GAS u64t*)(xin16 + (size_t)(m_) * DM + 4 * (64 * j + lane)); Q[j] = *(const GAS u64t*)(f16 + (size_t)(m_) * DM + 4 * (64 * j + lane)); } } while (0)
#define TH_UNPK(w_) (f32x4){__uint_as_float((unsigned)(w_) << 16), __uint_as_float((unsigned)(w_) & 0xffff0000u), __uint_as_float((unsigned)((w_) >> 32) << 16), __uint_as_float((unsigned)((w_) >> 32) & 0xffff0000u)}
#define TH_FIN(X, Q, m_) do { f32x4 v[8], g[8]; _Pragma("unroll") for (int j = 0; j < 8; ++j) { v[j] = TH_UNPK(X[j]); g[j] = TH_UNPK(Q[j]); } thin_finish(F, v, g, true, m_, scale, post_w, xout16, xout32, rs_out); } while (0)
        int m = F.gw;
        if (m < MP) TH_LOAD(ax, aq, m);
        while (m < MP) {
            const int m2 = m + F.NGW, m3 = m2 + F.NGW;
            if (m2 < MP) TH_LOAD(bx, bq, m2);
            TH_FIN(ax, aq, m);
            if (m3 < MP) TH_LOAD(ax, aq, m3);
            if (m2 < MP) TH_FIN(bx, bq, m2);
            m = m3;
        }
#undef TH_LOAD
#undef TH_UNPK
#undef TH_FIN
    }
    for (int m = F.gw; m < M_ALL; m += F.NGW) {
        if (pipe && m < MP) continue;
        f32x4 v[8], g[8];
        if (xin16) {
#pragma unroll
            for (int j = 0; j < 8; ++j) v[j] = ld_bf16x4(xin16 + (size_t)m * DM + 4 * (64 * j + lane));
        } else { const GAS f32x4* x4 = (const GAS f32x4*)(m < MP ? F.xp() + (size_t)m * DM : F.xs() + (size_t)(m - MP) * DM) + lane;
#pragma unroll
            for (int j = 0; j < 8; ++j) v[j] = x4[64 * j]; }
        if (f16) {
            if (m < MP) {
#pragma unroll
                for (int j = 0; j < 8; ++j) g[j] = ld_bf16x4(f16 + (size_t)m * DM + 4 * (64 * j + lane));
            } else { GAS f32x4* f4 = (GAS f32x4*)(fs + (size_t)m * DM) + lane;
#pragma unroll
                for (int j = 0; j < 8; ++j) { g[j] = f4[64 * j]; f4[64 * j] = (f32x4){0.f, 0.f, 0.f, 0.f}; } }
        } else {
#pragma unroll
            for (int j = 0; j < 8; ++j) g[j] = (f32x4){0.f, 0.f, 0.f, 0.f}; }
        thin_finish(F, v, g, f16 != nullptr, m, scale, post_w, xout16, xout32, rs_out);
    }
}
__device__ __forceinline__ void transpose_item64(const float* W, int N, int k0, int n0, bf16* WT, int K, int drow0, LAS float* scr, int lane) {
    const int kr = lane >> 4, c = lane & 15, nr = lane >> 2, kc = lane & 3; const bool inb = n0 + 4 * c < N;
#pragma unroll
    for (int half = 0; half < 2; ++half) {
        f32x4 v[8];
#pragma unroll
        for (int i = 0; i < 8; ++i) v[i] = inb ? *(const GAS f32x4*)(W + (size_t)(k0 + 32 * half + 4 * i + kr) * N + n0 + 4 * c) : (f32x4){0.f, 0.f, 0.f, 0.f};
#pragma unroll
        for (int i = 0; i < 8; ++i) *(LAS f32x4*)(scr + (4 * i + kr) * 68 + 4 * c) = v[i];
        LDS_WAIT(); asm volatile("" ::: "memory");
#pragma unroll
        for (int it = 0; it < 4; ++it) { const int n = nr + 16 * it; const LAS float* sp = scr + (8 * kc) * 68 + n;
            v4u o; o.x = pk2(sp[0 * 68], sp[1 * 68]); o.y = pk2(sp[2 * 68], sp[3 * 68]); o.z = pk2(sp[4 * 68], sp[5 * 68]); o.w = pk2(sp[6 * 68], sp[7 * 68]);
            *(GAS v4u*)(WT + (size_t)(drow0 + n) * K + k0 + 32 * half + 8 * kc) = o; }
        LDS_WAIT(); asm volatile("" ::: "memory");
    }
}
__device__ __forceinline__ void convert_matrix(Frame& F, const float* W, int K, int N, int Npad, bf16* WT, int mode, int wg_lo, const float* ks = nullptr) {
    if ((int)blockIdx.x < wg_lo) return;
    LAS float* scr = (LAS float*)(F.lds + RING_OFF + F.wave * 16384);
    const int nkb = K / 64, nit = nkb * (Npad / 32), wv = ((int)blockIdx.x - wg_lo) * NWAVES + F.wave, nwv = (F.G - wg_lo) * NWAVES;
    for (int it = wv; it < nit; it += nwv) {
#if CONV_NFAST
        const int nnb = Npad / 32, n0 = 32 * (it % nnb), kb = it / nnb;
#else
        const int kb = it % nkb, n0 = 32 * (it / nkb);
#endif
        const int drow0 = mode == 0 ? n0 : 256 * (n0 >> 7) + 128 * (mode - 1) + (n0 & 127);
        transpose_item(W, N, 64 * kb, n0, WT, K, drow0, scr, F.lane, ks);
    }
}
struct ConvItem { const float* src; bf16* dst; const float* ks; int N, K, cc, k0; };
constexpr int CV_GU = (DM / 64) * (FF / 32), CV_IN = (DM / 64) * (INW_PAD / 32), CV_OUT = (DM / 64) * (DM / 32), CV_DN = (FF / 64) * (DM / 32);
constexpr int CV_E0 = CV_GU, CV_E1 = CV_E0 + CV_GU, CV_E2 = CV_E1 + CV_GU, CV_E3 = CV_E2 + CV_GU, CV_E4 = CV_E3 + CV_IN, CV_E5 = CV_E4 + CV_OUT, CV_E6 = CV_E5 + CV_DN, CV_TOT = CV_E6 + CV_DN;
__device__ __forceinline__ void conv_decode(const Frame& F, int g, int lane, ConvItem& c) {
    const float* W; bf16* WT; const float* ks; int K, N, Npad, mode, it;
    if (g < CV_E0)      { W = F.gate1(); WT = F.W1GU(); ks = F.ffn1_pre(); K = DM; N = FF; Npad = FF; mode = 1; it = g; }
    else if (g < CV_E1) { W = F.up1();   WT = F.W1GU(); ks = F.ffn1_pre(); K = DM; N = FF; Npad = FF; mode = 2; it = g - CV_E0; }
    else if (g < CV_E2) { W = F.gate2(); WT = F.W2GU(); ks = F.ffn2_pre(); K = DM; N = FF; Npad = FF; mode = 1; it = g - CV_E1; }
    else if (g < CV_E3) { W = F.up2();   WT = F.W2GU(); ks = F.ffn2_pre(); K = DM; N = FF; Npad = FF; mode = 2; it = g - CV_E2; }
    else if (g < CV_E4) { W = F.w_in();  WT = F.WIN();  ks = F.mix_pre();  K = DM; N = INW; Npad = INW_PAD; mode = 0; it = g - CV_E3; }
    else if (g < CV_E5) { W = F.w_out(); WT = F.WOUT(); ks = nullptr;      K = DM; N = DM; Npad = DM; mode = 0; it = g - CV_E4; }
    else if (g < CV_E6) { W = F.down1(); WT = F.W1D();  ks = nullptr;      K = FF; N = DM; Npad = DM; mode = 0; it = g - CV_E5; }
    else                { W = F.down2(); WT = F.W2D();  ks = nullptr;      K = FF; N = DM; Npad = DM; mode = 0; it = g - CV_E6; }
    const int nnb = Npad / 32, n0 = 32 * (it % nnb), kb = it / nnb;
    const int drow0 = mode == 0 ? n0 : 256 * (n0 >> 7) + 128 * (mode - 1) + (n0 & 127);
    c.N = N; c.K = K; c.k0 = 64 * kb; c.cc = n0 + (lane & 31); c.ks = ks;
    c.src = W + (size_t)(64 * kb + (lane >> 5)) * N + c.cc;
    c.dst = WT + (size_t)(drow0 + (lane >> 3)) * K + 64 * kb + 8 * (lane & 7);
}
#define CV_LOAD(ld, kv0, kv1, c) do { \
        _Pragma("unroll") for (int i = 0; i < 32; ++i) ld[i] = ((c).cc < (c).N) ? (c).src[(size_t)(2 * i) * (c).N] : 0.f; \
        if ((c).ks) { kv0 = *(const GAS f32x4*)((c).ks + (c).k0 + 8 * (lane & 7)); kv1 = *(const GAS f32x4*)((c).ks + (c).k0 + 8 * (lane & 7) + 4); } \
        else { kv0 = (f32x4){1.f, 1.f, 1.f, 1.f}; kv1 = kv0; } } while (0)
#define CV_STORE(ld, kv0, kv1, c) do { \
        _Pragma("unroll") for (int i = 0; i < 32; ++i) scr[(2 * i + (lane >> 5)) * 33 + (lane & 31)] = ld[i]; \
        LDS_WAIT(); asm volatile("" ::: "memory"); \
        _Pragma("unroll") for (int j = 0; j < 4; ++j) { const LAS float* s_ = scr + (8 * (lane & 7)) * 33 + (lane >> 3) + 8 * j; \
            v4u o_; o_.x = pk2(s_[0 * 33] * kv0.x, s_[1 * 33] * kv0.y); o_.y = pk2(s_[2 * 33] * kv0.z, s_[3 * 33] * kv0.w); o_.z = pk2(s_[4 * 33] * kv1.x, s_[5 * 33] * kv1.y); o_.w = pk2(s_[6 * 33] * kv1.z, s_[7 * 33] * kv1.w); \
            *(GAS v4u*)((c).dst + (size_t)(8 * j) * (c).K) = o_; } \
        LDS_WAIT(); asm volatile("" ::: "memory"); } while (0)
__device__ __forceinline__ void convert_all(Frame& F) {
    LAS float* scr = (LAS float*)(F.lds + RING_OFF + F.wave * 16384);
    const int lane = F.lane, wv = (int)blockIdx.x * NWAVES + F.wave, nwv = F.G * NWAVES;
    float ldA[32], ldB[32], ldC[32]; f32x4 kA0, kA1, kB0, kB1, kC0, kC1; ConvItem cA, cB, cC;
    const int g0 = wv;
    if (g0 < CV_TOT) { conv_decode(F, g0, lane, cA); CV_LOAD(ldA, kA0, kA1, cA); }
    if (g0 + nwv < CV_TOT) { conv_decode(F, g0 + nwv, lane, cB); CV_LOAD(ldB, kB0, kB1, cB); }
    for (int g = g0; g < CV_TOT; g += 3 * nwv) {
        if (g + 2 * nwv < CV_TOT) { conv_decode(F, g + 2 * nwv, lane, cC); CV_LOAD(ldC, kC0, kC1, cC); }
        CV_STORE(ldA, kA0, kA1, cA);
        if (g + 3 * nwv < CV_TOT) { conv_decode(F, g + 3 * nwv, lane, cA); CV_LOAD(ldA, kA0, kA1, cA); }
        if (g + nwv < CV_TOT) CV_STORE(ldB, kB0, kB1, cB);
        if (g + 4 * nwv < CV_TOT) { conv_decode(F, g + 4 * nwv, lane, cB); CV_LOAD(ldB, kB0, kB1, cB); }
        if (g + 2 * nwv < CV_TOT) CV_STORE(ldC, kC0, kC1, cC);
    }
}
__device__ __forceinline__ void p0_prologue(Frame& F) {
#if CONV_PIPE
    convert_all(F);
#else
    convert_matrix(F, F.gate1(), DM, FF, FF, F.W1GU(), 1, 0, F.ffn1_pre());
    convert_matrix(F, F.up1(), DM, FF, FF, F.W1GU(), 2, 0, F.ffn1_pre());
    convert_matrix(F, F.up2(), DM, FF, FF, F.W2GU(), 2, 0, F.ffn2_pre());
    convert_matrix(F, F.w_in(), DM, INW, INW_PAD, F.WIN(), 0, 0, F.mix_pre()); convert_matrix(F, F.w_out(), DM, DM, DM, F.WOUT(), 0, 0);
    convert_matrix(F, F.gate2(), DM, FF, FF, F.W2GU(), 1, 0, F.ffn2_pre());
#if !CONV_TAILS
    convert_matrix(F, F.down1(), FF, DM, DM, F.W1D(), 0, 0); convert_matrix(F, F.down2(), FF, DM, DM, F.W2D(), 0, 0);
#endif
#endif
    thin_rows(F, nullptr, nullptr, nullptr, 0.f, nullptr, F.X0h(), nullptr, F.RS());
    { const int gt = (int)blockIdx.x * NTHREADS + F.tid, NT = F.G * NTHREADS; GAS f32x4* z = (GAS f32x4*)(F.Fb() + (size_t)MP * DM);
      for (int i = gt; i < MS * DM / 4; i += NT) z[i] = (f32x4){0.f, 0.f, 0.f, 0.f}; }
}
constexpr int G1_R = 0, G1_Q = 65536, G1_K = G1_Q + 17408, G1_KDT = G1_K + 17408, G1_SM = G1_KDT + 18432, G1_CW = G1_SM + 1024, G1_END = G1_CW + 6144, QS = 136, TS72 = 72;
static_assert(G1_END <= RING_BYTES, "G1 LDS");
__device__ __forceinline__ void gdn_chunk_prep(Frame& F, int ci_lo, int ci_hi, int ci_step) {
    typedef float f32x2 __attribute__((ext_vector_type(2)));
    LAS float* R = (LAS float*)(F.lds + G1_R); LAS bf16* QI = (LAS bf16*)(F.lds + G1_Q); LAS float* Lm = (LAS float*)(F.lds + G1_Q);
    LAS bf16* KI = (LAS bf16*)(F.lds + G1_K); LAS bf16* KD = (LAS bf16*)(F.lds + G1_KDT); LAS float* SM = (LAS float*)(F.lds + G1_SM); LAS float* CW = (LAS float*)(F.lds + G1_CW);
    const int w = F.wave; int h_cw = -1;
    for (int ci = ci_lo; ci < ci_hi; ci += ci_step) {
        int lane = lane_id(); asm volatile("" : "+v"(lane));
        const int m16 = lane & 15, kq = lane >> 4, tid = 64 * w + lane;
        int h, t0, T, row0; const float* cs = nullptr;
        if (ci < NCHUNK_P) { const int sh = ci >> 5; h = sh & 7; t0 = (ci & 31) * 64; T = SEQ; row0 = (sh >> 3) * SEQ; }
        else { const int sb = ci - NCHUNK_P, b = sb >> 3; h = sb & 7; t0 = 0; T = TS; row0 = MP + b * TS; cs = F.state_conv() + (size_t)b * 3 * CONVD; }
        if (h != h_cw) { for (int i = tid; i < 1536; i += NTHREADS) { const int p = i >> 9, j = (i >> 7) & 3, c = i & 127; CW[i] = F.conv_w()[(size_t)j * CONVD + p * 1024 + h * 128 + c]; } h_cw = h; }
        const int r4 = lane >> 4, cg = lane & 15;
        v4u xr[2][3][4];
        if (false) { const int tok = t0 + 8 * w + r4;
#pragma unroll
            for (int p = 0; p < 3; ++p)
#pragma unroll
                for (int j = 0; j < 4; ++j) { const int tt = tok + j - 3;
                    xr[0][p][j] = (tt >= 0) ? *(const GAS v4u*)(F.QKVB() + (size_t)(row0 + tt) * CONVD + p * 1024 + h * 128 + 8 * cg) : (v4u){0u, 0u, 0u, 0u}; } }
        {
            const int tok = t0 + lane; const bool valid = tok < T; float g = 0.f, be = 0.f;
            if (valid) { const float* hr = F.BA() + (size_t)(row0 + tok) * 16; be = sigmoid_f(hr[h]); g = -__expf(F.a_log()[h]) * softplus_f(hr[8 + h] + F.dt_bias()[h]); }
            float G = g;
#pragma unroll
            for (int o = 1; o < 64; o <<= 1) { const float t = __shfl_up(G, o); if (lane >= o) G += t; }
            const float G63 = __shfl(G, 63);
            SM[lane] = G; SM[64 + lane] = be; SM[128 + lane] = __expf(G); SM[192 + lane] = __expf(G63 - G);
            if (w == 0 && lane == 0) F.EGL()[ci] = __expf(G63);
        }
        LDS_BARRIER();
        if (false) { const int tok = t0 + 8 * w + 4 + r4;
#pragma unroll
            for (int p = 0; p < 3; ++p)
#pragma unroll
                for (int j = 0; j < 4; ++j) { const int tt = tok + j - 3;
                    xr[1][p][j] = (tt >= 0) ? *(const GAS v4u*)(F.QKVB() + (size_t)(row0 + tt) * CONVD + p * 1024 + h * 128 + 8 * cg) : (v4u){0u, 0u, 0u, 0u}; } }
#pragma unroll
        for (int g = 0; g < 2; ++g) {
            const int i = 8 * w + 4 * g + r4, tok = t0 + i; const bool valid = tok < T;
            LAS float* cwp = CW + 8 * cg; asm volatile("" : "+v"(cwp));
            float a[3][8];
#pragma unroll
            for (int p = 0; p < 3; ++p) {
                float acc[8];
#pragma unroll
                for (int c = 0; c < 8; ++c) acc[c] = 0.f;
#pragma unroll
                for (int j = 0; j < 4; ++j) {
                    float xv[8];
                    if (false) { const v4u xw = xr[g][p][j];
                        xv[0] = __uint_as_float(xw.x << 16); xv[1] = __uint_as_float(xw.x & 0xffff0000u); xv[2] = __uint_as_float(xw.y << 16); xv[3] = __uint_as_float(xw.y & 0xffff0000u);
                        xv[4] = __uint_as_float(xw.z << 16); xv[5] = __uint_as_float(xw.z & 0xffff0000u); xv[6] = __uint_as_float(xw.w << 16); xv[7] = __uint_as_float(xw.w & 0xffff0000u); }
                    else {
                        const int tt = tok + j - 3;
#pragma unroll
                        for (int c = 0; c < 8; ++c) xv[c] = 0.f;
                        if (valid) {
                            if (tt >= 0) { const v4u xw = *(const GAS v4u*)(F.QKVB() + (size_t)(row0 + tt) * CONVD + p * 1024 + h * 128 + 8 * cg);
                                xv[0] = __uint_as_float(xw.x << 16); xv[1] = __uint_as_float(xw.x & 0xffff0000u); xv[2] = __uint_as_float(xw.y << 16); xv[3] = __uint_as_float(xw.y & 0xffff0000u);
                                xv[4] = __uint_as_float(xw.z << 16); xv[5] = __uint_as_float(xw.z & 0xffff0000u); xv[6] = __uint_as_float(xw.w << 16); xv[7] = __uint_as_float(xw.w & 0xffff0000u); }
                            else { const f32x4 c0 = *(const GAS f32x4*)(cs + (size_t)(tt + 3) * CONVD + p * 1024 + h * 128 + 8 * cg), c1 = *(const GAS f32x4*)(cs + (size_t)(tt + 3) * CONVD + p * 1024 + h * 128 + 8 * cg + 4);
                                xv[0] = c0.x; xv[1] = c0.y; xv[2] = c0.z; xv[3] = c0.w; xv[4] = c1.x; xv[5] = c1.y; xv[6] = c1.z; xv[7] = c1.w; }
                        }
                    }
                    const f32x4 w0 = *(const LAS f32x4*)(cwp + (p * 4 + j) * 128), w1 = *(const LAS f32x4*)(cwp + (p * 4 + j) * 128 + 4);
                    acc[0] += xv[0] * w0.x; acc[1] += xv[1] * w0.y; acc[2] += xv[2] * w0.z; acc[3] += xv[3] * w0.w; acc[4] += xv[4] * w1.x; acc[5] += xv[5] * w1.y; acc[6] += xv[6] * w1.z; acc[7] += xv[7] * w1.w;
                }
#pragma unroll
                for (int c = 0; c < 8; ++c) a[p][c] = valid ? silu_f(acc[c]) : 0.f;
            }
            float sq = 0.f, sk = 0.f;
#pragma unroll
            for (int c = 0; c < 8; ++c) { sq += a[0][c] * a[0][c]; sk += a[1][c] * a[1][c]; }
            sq = sum16(sq); sk = sum16(sk);
            const float rq = rsqrtf(sq + 1e-6f) * 0.08838834764831845f, rk = rsqrtf(sk + 1e-6f);
            const float be = SM[64 + i], eg = SM[128 + i], ed = SM[192 + i];
            float qn[8], kn[8];
#pragma unroll
            for (int c = 0; c < 8; ++c) { qn[c] = a[0][c] * rq; kn[c] = a[1][c] * rk; }
            *(LAS v4u*)(QI + i * QS + 8 * cg) = (v4u){pk2(qn[0], qn[1]), pk2(qn[2], qn[3]), pk2(qn[4], qn[5]), pk2(qn[6], qn[7])};
            *(LAS v4u*)(KI + i * QS + 8 * cg) = (v4u){pk2(kn[0], kn[1]), pk2(kn[2], kn[3]), pk2(kn[4], kn[5]), pk2(kn[6], kn[7])};
            *(GAS v4u*)(F.QGc() + ((size_t)ci * 64 + i) * 128 + 8 * cg) = (v4u){pk2(qn[0] * eg, qn[1] * eg), pk2(qn[2] * eg, qn[3] * eg), pk2(qn[4] * eg, qn[5] * eg), pk2(qn[6] * eg, qn[7] * eg)};
#pragma unroll
            for (int c = 0; c < 8; ++c) KD[(8 * cg + c) * TS72 + i] = (bf16)f2bf(kn[c] * ed);
            const float bg = be * eg;
            *(LAS f32x4*)(R + i * 256 + 8 * cg) = (f32x4){a[2][0] * be, a[2][1] * be, a[2][2] * be, a[2][3] * be}; *(LAS f32x4*)(R + i * 256 + 8 * cg + 4) = (f32x4){a[2][4] * be, a[2][5] * be, a[2][6] * be, a[2][7] * be};
            *(LAS f32x4*)(R + i * 256 + 128 + 8 * cg) = (f32x4){kn[0] * bg, kn[1] * bg, kn[2] * bg, kn[3] * bg}; *(LAS f32x4*)(R + i * 256 + 128 + 8 * cg + 4) = (f32x4){kn[4] * bg, kn[5] * bg, kn[6] * bg, kn[7] * bg};
        }
        LDS_BARRIER();
        {
            const int tm = w & 3, tnb = (w >> 2) * 2;
            f32x4 kk[2], kqv[2];
#pragma unroll
            for (int t2 = 0; t2 < 2; ++t2) { kk[t2] = (f32x4){0.f, 0.f, 0.f, 0.f}; kqv[t2] = (f32x4){0.f, 0.f, 0.f, 0.f}; }
#pragma unroll
            for (int ks = 0; ks < 4; ++ks) {
                const bf16x8 ak = *(const LAS bf16x8*)(KI + (16 * tm + m16) * QS + 32 * ks + 8 * kq);
#pragma unroll
                for (int t2 = 0; t2 < 2; ++t2) {
                    const bf16x8 bk = *(const LAS bf16x8*)(KI + (16 * (tnb + t2) + m16) * QS + 32 * ks + 8 * kq);
                    const bf16x8 bq = *(const LAS bf16x8*)(QI + (16 * (tnb + t2) + m16) * QS + 32 * ks + 8 * kq);
                    kk[t2] = __builtin_amdgcn_mfma_f32_16x16x32_bf16(ak, bk, kk[t2], 0, 0, 0);
                    kqv[t2] = __builtin_amdgcn_mfma_f32_16x16x32_bf16(ak, bq, kqv[t2], 0, 0, 0);
                }
            }
#pragma unroll
            for (int t2 = 0; t2 < 2; ++t2) {
                const int i = 16 * (tnb + t2) + m16, j0 = 16 * tm + 4 * kq; const float Gi = SM[i]; float o4[4];
#pragma unroll
                for (int r = 0; r < 4; ++r) { const int j = j0 + r; o4[r] = (i >= j) ? kqv[t2][r] * __expf(Gi - SM[j]) : 0.f; }
                *(GAS unsigned long long*)(F.QKc() + ((size_t)ci * 64 + i) * 64 + j0) = (unsigned long long)pk2(o4[0], o4[1]) | ((unsigned long long)pk2(o4[2], o4[3]) << 32);
            }
            LDS_BARRIER();
#pragma unroll
            for (int t2 = 0; t2 < 2; ++t2) {
                const int j = 16 * (tnb + t2) + m16; const float Gj = SM[j];
#pragma unroll
                for (int r = 0; r < 4; ++r) { const int i = 16 * tm + 4 * kq + r; Lm[i * 64 + j] = (i > j) ? SM[64 + i] * kk[t2][r] * __expf(SM[i] - Gj) : 0.f; }
            }
        }
        LDS_BARRIER();
        if (w < 2) {
            typedef float f32x2 __attribute__((ext_vector_type(2)));
            const int c2 = 64 * w + lane;
            LAS float* Lb = Lm; asm volatile("" : "+v"(Lb));
            f32x2 x[64];
#pragma unroll
            for (int i = 0; i < 64; ++i) x[i] = *(const LAS f32x2*)(R + i * 256 + 2 * c2);
#define G1_SOLVE_ROW(i) do { f32x2 a0 = {0.f, 0.f}, a1 = {0.f, 0.f}; \
                _Pragma("unroll") for (int j4 = 0; j4 < ((i) + 3) / 4; ++j4) { const f32x4 l = *(const LAS f32x4*)(Lb + (i) * 64 + 4 * j4); \
                    a0 = a0 + x[4 * j4] * l.x; a1 = a1 + x[4 * j4 + 1] * l.y; a0 = a0 + x[4 * j4 + 2] * l.z; a1 = a1 + x[4 * j4 + 3] * l.w; } \
                x[i] = x[i] - (a0 + a1); asm volatile("" ::: "memory"); } while (0)
#pragma unroll
            for (int i = 1; i < TS; ++i) G1_SOLVE_ROW(i);
            if (false) {
#pragma unroll
                for (int i = TS; i < 64; ++i) G1_SOLVE_ROW(i);
            }
#ifdef REP_SOLVE
            asm volatile("" : "+v"(Lb));
#pragma unroll
            for (int i = 0; i < 64; ++i) x[i] = *(const LAS f32x2*)(R + i * 256 + 2 * c2);
#pragma unroll
            for (int i = 1; i < 64; ++i) G1_SOLVE_ROW(i);
            asm volatile("" : "+v"(Lb));
#pragma unroll
            for (int i = 0; i < 64; ++i) x[i] = *(const LAS f32x2*)(R + i * 256 + 2 * c2);
#pragma unroll
            for (int i = 1; i < 64; ++i) G1_SOLVE_ROW(i);
#endif
#undef G1_SOLVE_ROW
            if (w == 0) { float* up = F.UT() + (size_t)ci * 8192 + 2 * lane;
#pragma unroll
                for (int i = 0; i < 64; ++i) *(GAS f32x2*)(up + i * 128) = x[i];
            } else { bf16* wp = F.WC() + (size_t)ci * 8192 + 2 * lane;
#pragma unroll
                for (int i = 0; i < 64; ++i) *(GAS unsigned*)(wp + i * 128) = pk2(x[i].x, x[i].y); }
        } else if (w >= 4) {
            const int t = tid - 256;
#pragma unroll
            for (int q = 0; q < 4; ++q) { const int p = t + 256 * q, row = p >> 3, pc = p & 7;
                *(GAS v4u*)(F.KDTc() + (size_t)ci * 8192 + row * 64 + pc * 8) = *(const LAS v4u*)(KD + row * TS72 + pc * 8); }
        }
        LDS_BARRIER();
    }
}
constexpr int P2_HALF = 69632, P2_R = 0, P2_Q = 32768, P2_K = 50176, P2_SM = 67584, P2_CW = 2 * P2_HALF;
static_assert(P2_SM + 1024 <= P2_HALF && P2_CW + 6144 <= MISC_OFF, "prep2 LDS");
__device__ __forceinline__ void gdn_chunk_prep2(Frame& F, int ci_lo, int ci_hi) {
    typedef float f32x2 __attribute__((ext_vector_type(2)));
    const int w = F.wave, hb = w >> 2, wl = w & 3;
    LAS unsigned char* HB = F.lds + hb * P2_HALF;
    LAS bf16* R16 = (LAS bf16*)(HB + P2_R); LAS bf16* QI = (LAS bf16*)(HB + P2_Q); LAS float* Lm = (LAS float*)(HB + P2_Q); LAS bf16* KI = (LAS bf16*)(HB + P2_K); LAS float* SM = (LAS float*)(HB + P2_SM);
    LAS float* CW = (LAS float*)(F.lds + P2_CW);
    int h_cw = -1;
    for (int cp = ci_lo; cp < ci_hi; cp += 2) {
        int lane = lane_id(); asm volatile("" : "+v"(lane));
        const int m16 = lane & 15, kq = lane >> 4, tid = 64 * w + lane, r4 = lane >> 4, cg = lane & 15;
        const int ci = cp + hb, sh = ci >> 5, h = sh & 7, t0 = (ci & 31) * 64, row0 = (sh >> 3) * SEQ;
        if (h != h_cw) { for (int i = tid; i < 1536; i += NTHREADS) { const int p = i >> 9, j = (i >> 7) & 3, c = i & 127; CW[i] = F.conv_w()[(size_t)j * CONVD + p * 1024 + h * 128 + c]; } h_cw = h; }
        v4u xr[2][3][4];
#define P2_LOADG(buf, g_) do { const int tok_ = t0 + 16 * wl + 4 * (g_) + r4; \
            _Pragma("unroll") for (int p = 0; p < 3; ++p) _Pragma("unroll") for (int j = 0; j < 4; ++j) { const int tt = tok_ + j - 3; \
                xr[buf][p][j] = (tt >= 0) ? *(const GAS v4u*)(F.QKVB() + (size_t)(row0 + tt) * CONVD + p * 1024 + h * 128 + 8 * cg) : (v4u){0u, 0u, 0u, 0u}; } } while (0)
        P2_LOADG(0, 0);
        {
            const float* hr = F.BA() + (size_t)(row0 + t0 + lane) * 16; const float be = sigmoid_f(hr[h]), g = -__expf(F.a_log()[h]) * softplus_f(hr[8 + h] + F.dt_bias()[h]);
            float G = g;
#pragma unroll
            for (int o = 1; o < 64; o <<= 1) { const float t = __shfl_up(G, o); if (lane >= o) G += t; }
            const float G63 = __shfl(G, 63);
            SM[lane] = G; SM[64 + lane] = be; SM[128 + lane] = __expf(G); SM[192 + lane] = __expf(G63 - G);
            if (wl == 0 && lane == 0) F.EGL()[ci] = __expf(G63);
        }
        LDS_BARRIER();
#pragma unroll
        for (int g = 0; g < 4; ++g) {
            if (g + 1 < 4) P2_LOADG((g + 1) & 1, g + 1);
            const int i = 16 * wl + 4 * g + r4;
            LAS float* cwp = CW + 8 * cg; asm volatile("" : "+v"(cwp));
            float a[3][8];
#pragma unroll
            for (int p = 0; p < 3; ++p) {
                float acc[8];
#pragma unroll
                for (int c = 0; c < 8; ++c) acc[c] = 0.f;
#pragma unroll
                for (int j = 0; j < 4; ++j) {
                    const v4u xw = xr[g & 1][p][j]; float xv[8];
                    xv[0] = __uint_as_float(xw.x << 16); xv[1] = __uint_as_float(xw.x & 0xffff0000u); xv[2] = __uint_as_float(xw.y << 16); xv[3] = __uint_as_float(xw.y & 0xffff0000u);
                    xv[4] = __uint_as_float(xw.z << 16); xv[5] = __uint_as_float(xw.z & 0xffff0000u); xv[6] = __uint_as_float(xw.w << 16); xv[7] = __uint_as_float(xw.w & 0xffff0000u);
                    const f32x4 w0 = *(const LAS f32x4*)(cwp + (p * 4 + j) * 128), w1 = *(const LAS f32x4*)(cwp + (p * 4 + j) * 128 + 4);
                    acc[0] += xv[0] * w0.x; acc[1] += xv[1] * w0.y; acc[2] += xv[2] * w0.z; acc[3] += xv[3] * w0.w; acc[4] += xv[4] * w1.x; acc[5] += xv[5] * w1.y; acc[6] += xv[6] * w1.z; acc[7] += xv[7] * w1.w;
                }
#pragma unroll
                for (int c = 0; c < 8; ++c) a[p][c] = silu_f(acc[c]);
            }
            float sq = 0.f, sk = 0.f;
#pragma unroll
            for (int c = 0; c < 8; ++c) { sq += a[0][c] * a[0][c]; sk += a[1][c] * a[1][c]; }
            sq = sum16(sq); sk = sum16(sk);
            const float rq = rsqrtf(sq + 1e-6f) * 0.08838834764831845f, rk = rsqrtf(sk + 1e-6f);
            const float be = SM[64 + i], eg = SM[128 + i], ed = SM[192 + i], bg = be * eg;
            float qn[8], kn[8];
#pragma unroll
            for (int c = 0; c < 8; ++c) { qn[c] = a[0][c] * rq; kn[c] = a[1][c] * rk; }
            *(LAS v4u*)(QI + i * QS + 8 * cg) = (v4u){pk2(qn[0], qn[1]), pk2(qn[2], qn[3]), pk2(qn[4], qn[5]), pk2(qn[6], qn[7])};
            *(LAS v4u*)(KI + i * QS + 8 * cg) = (v4u){pk2(kn[0], kn[1]), pk2(kn[2], kn[3]), pk2(kn[4], kn[5]), pk2(kn[6], kn[7])};
            *(GAS v4u*)(F.QGc() + ((size_t)ci * 64 + i) * 128 + 8 * cg) = (v4u){pk2(qn[0] * eg, qn[1] * eg), pk2(qn[2] * eg, qn[3] * eg), pk2(qn[4] * eg, qn[5] * eg), pk2(qn[6] * eg, qn[7] * eg)};
#pragma unroll
            for (int c = 0; c < 8; ++c) F.KDTc()[(size_t)ci * 8192 + (8 * cg + c) * 64 + i] = (bf16)f2bf(kn[c] * ed);
            *(LAS v4u*)(R16 + i * 256 + 8 * cg) = (v4u){pk2(a[2][0] * be, a[2][1] * be), pk2(a[2][2] * be, a[2][3] * be), pk2(a[2][4] * be, a[2][5] * be), pk2(a[2][6] * be, a[2][7] * be)};
            *(LAS v4u*)(R16 + i * 256 + 128 + 8 * cg) = (v4u){pk2(kn[0] * bg, kn[1] * bg), pk2(kn[2] * bg, kn[3] * bg), pk2(kn[4] * bg, kn[5] * bg), pk2(kn[6] * bg, kn[7] * bg)};
        }
#undef P2_LOADG
        LDS_BARRIER();
        {
            const int tm = wl;
            f32x4 kk[4], kqv[4];
#pragma unroll
            for (int t4 = 0; t4 < 4; ++t4) { kk[t4] = (f32x4){0.f, 0.f, 0.f, 0.f}; kqv[t4] = (f32x4){0.f, 0.f, 0.f, 0.f}; }
#pragma unroll
            for (int ks = 0; ks < 4; ++ks) {
                const bf16x8 ak = *(const LAS bf16x8*)(KI + (16 * tm + m16) * QS + 32 * ks + 8 * kq);
#pragma unroll
                for (int t4 = 0; t4 < 4; ++t4) {
                    const bf16x8 bk = *(const LAS bf16x8*)(KI + (16 * t4 + m16) * QS + 32 * ks + 8 * kq);
                    const bf16x8 bq = *(const LAS bf16x8*)(QI + (16 * t4 + m16) * QS + 32 * ks + 8 * kq);
                    kk[t4] = __builtin_amdgcn_mfma_f32_16x16x32_bf16(ak, bk, kk[t4], 0, 0, 0);
                    kqv[t4] = __builtin_amdgcn_mfma_f32_16x16x32_bf16(ak, bq, kqv[t4], 0, 0, 0);
                }
            }
#pragma unroll
            for (int t4 = 0; t4 < 4; ++t4) {
                const int i = 16 * t4 + m16, j0 = 16 * tm + 4 * kq; const float Gi = SM[i]; float o4[4];
#pragma unroll
                for (int r = 0; r < 4; ++r) { const int j = j0 + r; o4[r] = (i >= j) ? kqv[t4][r] * __expf(Gi - SM[j]) : 0.f; }
                *(GAS unsigned long long*)(F.QKc() + ((size_t)ci * 64 + i) * 64 + j0) = (unsigned long long)pk2(o4[0], o4[1]) | ((unsigned long long)pk2(o4[2], o4[3]) << 32);
            }
            LDS_BARRIER();
#pragma unroll
            for (int t4 = 0; t4 < 4; ++t4) {
                const int j = 16 * t4 + m16; const float Gj = SM[j];
#pragma unroll
                for (int r = 0; r < 4; ++r) { const int i = 16 * tm + 4 * kq + r; Lm[i * 64 + j] = (i > j) ? SM[64 + i] * kk[t4][r] * __expf(SM[i] - Gj) : 0.f; }
            }
        }
        LDS_BARRIER();
        if (wl < 2) {
            const int c2 = 64 * wl + lane;
            LAS float* Lb = Lm; asm volatile("" : "+v"(Lb));
            f32x2 x[64];
#pragma unroll
            for (int i = 0; i < 64; ++i) { const unsigned rw = *(const LAS unsigned*)(R16 + i * 256 + 2 * c2); x[i] = (f32x2){__uint_as_float(rw << 16), __uint_as_float(rw & 0xffff0000u)}; }
#pragma unroll
            for (int i = 1; i < 64; ++i) { f32x2 a0 = {0.f, 0.f}, a1 = {0.f, 0.f};
#pragma unroll
                for (int j4 = 0; j4 < (i + 3) / 4; ++j4) { const f32x4 l = *(const LAS f32x4*)(Lb + i * 64 + 4 * j4);
                    a0 = a0 + x[4 * j4] * l.x; a1 = a1 + x[4 * j4 + 1] * l.y; a0 = a0 + x[4 * j4 + 2] * l.z; a1 = a1 + x[4 * j4 + 3] * l.w; }
                x[i] = x[i] - (a0 + a1); asm volatile("" ::: "memory"); }
            if (wl == 0) { float* up = F.UT() + (size_t)ci * 8192 + 2 * lane;
#pragma unroll
                for (int i = 0; i < 64; ++i) *(GAS f32x2*)(up + i * 128) = x[i];
            } else { bf16* wp = F.WC() + (size_t)ci * 8192 + 2 * lane;
#pragma unroll
                for (int i = 0; i < 64; ++i) *(GAS unsigned*)(wp + i * 128) = pk2(x[i].x, x[i].y); }
        }
        LDS_BARRIER();
    }
}
constexpr int G2_W = 0, G2_QG = 17408, G2_QK = 34816, G2_KDT = 44032, G2_WAVE = 62464, G2_WAVE_BYTES = 6656, G2_END = G2_WAVE + 8 * G2_WAVE_BYTES;
static_assert(G2_END <= RING_BYTES, "G2 LDS");
constexpr int N_SCAN_ITEMS = NBP * NH + NBS * NH;
__device__ __forceinline__ void gdn_scan_item(Frame& F, int item) {
    int NC, ci0, T, row0, h; const float* s0 = nullptr; float* sout;
    if (item < NBP * NH) { NC = SEQ / 64; ci0 = item * 32; T = SEQ; row0 = (item >> 3) * SEQ; h = item & 7; sout = F.out() + OUT_SSMP + (size_t)item * 16384; }
    else { const int sb = item - NBP * NH; NC = 1; ci0 = NCHUNK_P + sb; T = TS; row0 = MP + (sb >> 3) * TS; h = sb & 7; s0 = F.state_ssm() + (size_t)sb * 16384; sout = F.out() + OUT_SSMS + (size_t)sb * 16384; }
    const int s = F.wave; int lane = lane_id(); asm volatile("" : "+v"(lane));
    const int n = lane & 15, kq = lane >> 4, tid = 64 * s + lane;
    LAS unsigned char* L = F.lds;
    LAS unsigned char* Vb = L + G2_WAVE + s * G2_WAVE_BYTES; LAS unsigned char* Sb = Vb + 2304;
    f32x4 S[8];
#pragma unroll
    for (int dt = 0; dt < 8; ++dt)
#pragma unroll
        for (int r = 0; r < 4; ++r) S[dt][r] = s0 ? s0[(size_t)(16 * dt + 4 * kq + r) * 128 + 16 * s + n] : 0.f;
    v4u st[7]; f32x4 ut[4];
#define G2_LOAD(ci_) do { const size_t cb = (size_t)(ci_); \
        _Pragma("unroll") for (int q = 0; q < 2; ++q) { const int p = tid + 512 * q; st[q] = *(const GAS v4u*)(F.WC() + cb * 8192 + (p >> 4) * 128 + (p & 15) * 8); st[2 + q] = *(const GAS v4u*)(F.QGc() + cb * 8192 + (p >> 4) * 128 + (p & 15) * 8); \
            st[5 + q] = *(const GAS v4u*)(F.KDTc() + cb * 8192 + (p >> 3) * 64 + (p & 7) * 8); } \
        st[4] = *(const GAS v4u*)(F.QKc() + cb * 4096 + (tid >> 3) * 64 + (tid & 7) * 8); \
        _Pragma("unroll") for (int rt = 0; rt < 4; ++rt) _Pragma("unroll") for (int r = 0; r < 4; ++r) ut[rt][r] = F.UT()[(cb * 64 + 16 * rt + 4 * kq + r) * 128 + 16 * s + n]; } while (0)
#define G2_STORE() do { \
        _Pragma("unroll") for (int q = 0; q < 2; ++q) { const int p = tid + 512 * q; *(LAS v4u*)(L + G2_W + (p >> 4) * 272 + (p & 15) * 16) = st[q]; *(LAS v4u*)(L + G2_QG + (p >> 4) * 272 + (p & 15) * 16) = st[2 + q]; \
            *(LAS v4u*)(L + G2_KDT + (p >> 3) * 144 + (p & 7) * 16) = st[5 + q]; } \
        *(LAS v4u*)(L + G2_QK + (tid >> 3) * 144 + (tid & 7) * 16) = st[4]; } while (0)
    G2_LOAD(ci0);
    G2_STORE();
    f32x4 uc[4];
#pragma unroll
    for (int rt = 0; rt < 4; ++rt) uc[rt] = ut[rt];
#pragma unroll
    for (int dt = 0; dt < 8; ++dt) *(LAS unsigned long long*)(Sb + n * 272 + (16 * dt + 4 * kq) * 2) = (unsigned long long)pk2(S[dt][0], S[dt][1]) | ((unsigned long long)pk2(S[dt][2], S[dt][3]) << 32);
    LDS_BARRIER();
    for (int c = 0; c < NC; ++c) {
        const float egl = F.EGL()[ci0 + c];
        if (c + 1 < NC) G2_LOAD(ci0 + c + 1);
        LDS_WAIT(); asm volatile("" ::: "memory");
        bf16x8 sbf[4];
#pragma unroll
        for (int ks = 0; ks < 4; ++ks) sbf[ks] = *(const LAS bf16x8*)(Sb + n * 272 + (32 * ks + 8 * kq) * 2);
        f32x4 vn[4], oo[4];
#pragma unroll
        for (int rt = 0; rt < 4; ++rt) {
            f32x4 acc = {0.f, 0.f, 0.f, 0.f}, ao = {0.f, 0.f, 0.f, 0.f};
#pragma unroll
            for (int ks = 0; ks < 4; ++ks) {
                const bf16x8 aw = *(const LAS bf16x8*)(L + G2_W + (16 * rt + n) * 272 + (32 * ks + 8 * kq) * 2);
                const bf16x8 aq = *(const LAS bf16x8*)(L + G2_QG + (16 * rt + n) * 272 + (32 * ks + 8 * kq) * 2);
                acc = __builtin_amdgcn_mfma_f32_16x16x32_bf16(aw, sbf[ks], acc, 0, 0, 0);
                ao = __builtin_amdgcn_mfma_f32_16x16x32_bf16(aq, sbf[ks], ao, 0, 0, 0);
            }
            vn[rt] = uc[rt] - acc; oo[rt] = ao;
            *(LAS unsigned long long*)(Vb + n * 144 + (16 * rt + 4 * kq) * 2) = (unsigned long long)pk2(vn[rt][0], vn[rt][1]) | ((unsigned long long)pk2(vn[rt][2], vn[rt][3]) << 32);
        }
        LDS_WAIT(); asm volatile("" ::: "memory");
        bf16x8 vbf[2];
#pragma unroll
        for (int k2 = 0; k2 < 2; ++k2) vbf[k2] = *(const LAS bf16x8*)(Vb + n * 144 + (32 * k2 + 8 * kq) * 2);
#pragma unroll
        for (int rt = 0; rt < 4; ++rt) {
#pragma unroll
            for (int k2 = 0; k2 < 2; ++k2) { const bf16x8 a = *(const LAS bf16x8*)(L + G2_QK + (16 * rt + n) * 144 + (32 * k2 + 8 * kq) * 2); oo[rt] = __builtin_amdgcn_mfma_f32_16x16x32_bf16(a, vbf[k2], oo[rt], 0, 0, 0); }
#pragma unroll
            for (int r = 0; r < 4; ++r) { const int t = 64 * c + 16 * rt + 4 * kq + r; if (t < T) F.OG()[(size_t)(row0 + t) * 1024 + h * 128 + 16 * s + n] = (bf16)f2bf(oo[rt][r]); }
        }
#pragma unroll
        for (int dt = 0; dt < 8; ++dt) {
            f32x4 acc = S[dt] * egl;
#pragma unroll
            for (int k2 = 0; k2 < 2; ++k2) { const bf16x8 a = *(const LAS bf16x8*)(L + G2_KDT + (16 * dt + n) * 144 + (32 * k2 + 8 * kq) * 2); acc = __builtin_amdgcn_mfma_f32_16x16x32_bf16(a, vbf[k2], acc, 0, 0, 0); }
            S[dt] = acc;
            *(LAS unsigned long long*)(Sb + n * 272 + (16 * dt + 4 * kq) * 2) = (unsigned long long)pk2(acc[0], acc[1]) | ((unsigned long long)pk2(acc[2], acc[3]) << 32);
        }
        LDS_BARRIER();
        if (c + 1 < NC) { G2_STORE();
#pragma unroll
            for (int rt = 0; rt < 4; ++rt) uc[rt] = ut[rt]; }
        LDS_BARRIER();
    }
#pragma unroll
    for (int dt = 0; dt < 8; ++dt)
#pragma unroll
        for (int r = 0; r < 4; ++r) sout[(size_t)(16 * dt + 4 * kq + r) * 128 + 16 * s + n] = S[dt][r];
#undef G2_LOAD
#undef G2_STORE
}
template <bool SAMPLE> __device__ __forceinline__ void attn_row_item(Frame& F, int item, LAS float* wl) {
    typedef float f32x2 __attribute__((ext_vector_type(2)));
    const int h = item & 7, mi = item >> 3;
    int b, tq, nkeys, qrow, krow0;
    if (SAMPLE) { b = mi / TS; tq = mi % TS; nkeys = PAST + tq + 1; qrow = MP + mi; krow0 = MP + b * TS; }
    else { b = mi / SEQ; tq = mi % SEQ; nkeys = tq + 1; qrow = mi; krow0 = b * SEQ; }
    LAS float* ql = wl + 128;
    { const unsigned w = *(const GAS unsigned*)(F.QB() + (size_t)qrow * 1024 + h * 128 + 2 * F.lane);
      ql[2 * F.lane] = __uint_as_float(w << 16); ql[2 * F.lane + 1] = __uint_as_float(w & 0xffff0000u); }
    LDS_WAIT(); asm volatile("" ::: "memory");
    const float slope2 = exp2f(-(float)(h + 1)) * LOG2E;
    const int qpos = SAMPLE ? PAST + tq : tq;
    float M1 = -1e30f, M2 = -1e30f, l1 = 0.f, l2 = 0.f; f32x2 o1 = {0.f, 0.f}, o2 = {0.f, 0.f};
    for (int c0 = 0; c0 < nkeys; c0 += 64) {
        const int j = c0 + F.lane; const bool valid = j < nkeys;
        float s1 = -1e30f, s2 = -1e30f;
        if (valid) {
            float a1 = 0.f, a2 = 0.f;
            if (SAMPLE && j < PAST) {
                const int page = F.page_table()[b * NPAGES + (j >> 7)];
                const GAS f32x4* kp = (const GAS f32x4*)(F.cache_k() + ((size_t)(page * PAGE + (j & 127)) * NH + h) * 128);
#pragma unroll 4
                for (int i = 0; i < 16; ++i) { const f32x4 kv = kp[i]; const f32x4 qv = *(const LAS f32x4*)(ql + 4 * i); a1 += qv.x * kv.x + qv.y * kv.y + qv.z * kv.z + qv.w * kv.w; }
#pragma unroll 4
                for (int i = 16; i < 32; ++i) { const f32x4 kv = kp[i]; const f32x4 qv = *(const LAS f32x4*)(ql + 4 * i); a2 += qv.x * kv.x + qv.y * kv.y + qv.z * kv.z + qv.w * kv.w; }
            } else {
                const int kr = SAMPLE ? krow0 + (j - PAST) : krow0 + j;
                const GAS v4u* kp = (const GAS v4u*)(F.KB() + (size_t)kr * 1024 + h * 128);
#pragma unroll 4
                for (int i = 0; i < 16; ++i) { const v4u w = kp[i]; const f32x4 qa = *(const LAS f32x4*)(ql + 8 * i), qb = *(const LAS f32x4*)(ql + 8 * i + 4);
                    const float d = qa.x * __uint_as_float(w.x << 16) + qa.y * __uint_as_float(w.x & 0xffff0000u) + qa.z * __uint_as_float(w.y << 16) + qa.w * __uint_as_float(w.y & 0xffff0000u)
                                  + qb.x * __uint_as_float(w.z << 16) + qb.y * __uint_as_float(w.z & 0xffff0000u) + qb.z * __uint_as_float(w.w << 16) + qb.w * __uint_as_float(w.w & 0xffff0000u);
                    if (i < 8) a1 += d; else a2 += d; }
            }
            const float bias = slope2 * (float)(qpos - j);
            s1 = a1 - bias; s2 = a2 - bias;
        }
        const float n1 = fmaxf(M1, wave_max(s1)), n2 = fmaxf(M2, wave_max(s2));
        const float al1 = exp2f(M1 - n1), al2 = exp2f(M2 - n2);
        const float p1 = valid ? exp2f(s1 - n1) : 0.f, p2 = valid ? exp2f(s2 - n2) : 0.f;
        l1 = l1 * al1 + p1; l2 = l2 * al2 + p2; o1 = o1 * al1; o2 = o2 * al2; M1 = n1; M2 = n2;
        wl[F.lane] = p1; wl[64 + F.lane] = p2;
        LDS_WAIT(); asm volatile("" ::: "memory");
        const int nk = (nkeys - c0) < 64 ? (nkeys - c0) : 64;
        for (int jj = 0; jj < nk; ++jj) {
            const float pp1 = wl[jj], pp2 = wl[64 + jj]; const int jk = c0 + jj; f32x2 vv;
            if (SAMPLE && jk < PAST) { const int page = F.page_table()[b * NPAGES + (jk >> 7)];
                vv = *(const GAS f32x2*)(F.cache_v() + ((size_t)(page * PAGE + (jk & 127)) * NH + h) * 128 + 2 * F.lane); }
            else { const int kr = SAMPLE ? krow0 + (jk - PAST) : krow0 + jk; const unsigned w = *(const GAS unsigned*)(F.VB() + (size_t)kr * 1024 + h * 128 + 2 * F.lane);
                vv.x = __uint_as_float(w << 16); vv.y = __uint_as_float(w & 0xffff0000u); }
            o1 = o1 + vv * pp1; o2 = o2 + vv * pp2;
        }
        LDS_WAIT(); asm volatile("" ::: "memory");
    }
    const float L1 = 1.f / wave_sum(l1), L2 = 1.f / wave_sum(l2);
    const size_t oo = (size_t)qrow * 1024 + h * 128 + 2 * F.lane;
    *(GAS unsigned*)(F.O1b() + oo) = pk2(o1.x * L1, o1.y * L1); *(GAS unsigned*)(F.O2b() + oo) = pk2(o2.x * L2, o2.y * L2);
}
constexpr int SA_WAVE_BYTES = 16384, SA_ROW = 132, SA_PIMG = 8192, SA_PROW = 136;
__device__ __forceinline__ unsigned sa_offb(unsigned row, unsigned ch) { return 256u * row + 16u * (ch ^ (((row & 3u) << 2) | ((row >> 2) & 3u))); }
typedef short sa_v4i16 __attribute__((ext_vector_type(4)));
__device__ __forceinline__ sa_v4i16 sa_tr(const LAS unsigned char* p) { return __builtin_amdgcn_ds_read_tr16_b64_v4i16((LAS sa_v4i16*)p); }
__device__ __forceinline__ void sattn_unit(Frame& F, int unit) {
    typedef float f32x2 __attribute__((ext_vector_type(2)));
    int lane = F.lane; asm volatile("" : "+v"(lane));
    const int h = F.wave, n = lane & 15, kq = lane >> 4;
    const bool newtok = unit >= NBS * NSPLIT;
    const int b = newtok ? unit - NBS * NSPLIT : unit / NSPLIT, split = newtok ? NSPLIT : unit % NSPLIT;
    LAS unsigned char* WL = F.lds + RING_OFF + h * SA_WAVE_BYTES;
    LAS float* Ssc = (LAS float*)WL; LAS float* ALP = Ssc + 16 * SA_ROW;
    const float sl2 = exp2f(-(float)(h + 1)) * LOG2E;
    const size_t pi = (size_t)(b * NH + h) * NSP + split;
    if (!newtok) {
        bf16x8 aq[4];
#pragma unroll
        for (int ks = 0; ks < 4; ++ks) {
            const bool nz = (n < 8) == (ks < 2);
            const bf16* qp = F.QB() + (size_t)(MP + b * TS + (n & 7)) * 1024 + h * 128 + (n >> 3) * 64 + 32 * (ks & 1) + 8 * kq;
            aq[ks] = nz ? *(const GAS bf16x8*)qp : (bf16x8){0, 0, 0, 0, 0, 0, 0, 0};
        }
        f32x4 acc[8];
#pragma unroll
        for (int c = 0; c < 8; ++c) acc[c] = (f32x4){0.f, 0.f, 0.f, 0.f};
        float m_run[4], l_run[4];
#pragma unroll
        for (int r = 0; r < 4; ++r) { m_run[r] = -1e30f; l_run[r] = 0.f; }
        const int rp2 = lane >> 5, c4 = lane & 31, kr = rp2, ch = c4 >> 1, hf = c4 & 1;
        const unsigned tq_ = (lane & 15) >> 2, tp_ = lane & 3;
#pragma unroll 1
        for (int pgi = 0; pgi < PGU; ++pgi) {
            const int pg = split * PGU + pgi, phys = F.page_table()[b * NPAGES + pg];
            const float* kbase = F.cache_k() + ((size_t)phys * PAGE * NH + h) * 128;
            const float* vbase = F.cache_v() + ((size_t)phys * PAGE * NH + h) * 128;
            f32x4 sc[8];
            const unsigned roff = (unsigned)(rp2 * 1024 + 4 * c4) * 4u;
            {
                f32x4 kv[2][8];
#pragma unroll
                for (int i = 0; i < 8; ++i) kv[0][i] = __builtin_nontemporal_load((const GAS f32x4*)((const GAS char*)(kbase + (size_t)(2 * i) * 1024) + roff));
#pragma unroll
                for (int kt = 0; kt < 8; ++kt) {
                    if (kt + 1 < 8) {
#pragma unroll
                        for (int i = 0; i < 8; ++i) kv[(kt + 1) & 1][i] = __builtin_nontemporal_load((const GAS f32x4*)((const GAS char*)(kbase + (size_t)(16 * (kt + 1) + 2 * i) * 1024) + roff));
                    }
#pragma unroll
                    for (int i = 0; i < 8; ++i) { const f32x4 v = kv[kt & 1][i]; *(LAS unsigned long long*)(WL + (2 * i + rp2) * 272 + c4 * 8) = (unsigned long long)pk2(v.x, v.y) | ((unsigned long long)pk2(v.z, v.w) << 32); }
                    LDS_WAIT(); asm volatile("" ::: "memory");
                    f32x4 a4 = {0.f, 0.f, 0.f, 0.f};
#pragma unroll
                    for (int ks = 0; ks < 4; ++ks) a4 = __builtin_amdgcn_mfma_f32_16x16x32_bf16(aq[ks], *(const LAS bf16x8*)(WL + n * 272 + (32 * ks + 8 * kq) * 2), a4, 0, 0, 0);
                    LDS_WAIT(); asm volatile("" ::: "memory");
                    const int kpos = pg * PAGE + 16 * kt + n;
#pragma unroll
                    for (int r = 0; r < 4; ++r) sc[kt][r] = a4[r] - sl2 * (float)(PAST + ((4 * kq + r) & 7) - kpos);
                }
            }
            f32x4 vl[16];
#pragma unroll
            for (int i = 0; i < 16; ++i) vl[i] = __builtin_nontemporal_load((const GAS f32x4*)((const GAS char*)(vbase + (size_t)(2 * i) * 1024) + roff));
#pragma unroll
            for (int r = 0; r < 4; ++r) {
                float mx = sc[0][r];
#pragma unroll
                for (int kt = 1; kt < 8; ++kt) mx = fmaxf(mx, sc[kt][r]);
                mx = max16(mx);
                const float mn = fmaxf(m_run[r], mx), al = __builtin_amdgcn_exp2f(m_run[r] - mn); float ls = 0.f;
#pragma unroll
                for (int kt = 0; kt < 8; ++kt) { const float p = __builtin_amdgcn_exp2f(sc[kt][r] - mn); sc[kt][r] = p; ls += p; }
                ls = sum16(ls);
                l_run[r] = l_run[r] * al + ls; m_run[r] = mn;
#pragma unroll
                for (int c = 0; c < 8; ++c) acc[c][r] *= al;
            }
#pragma unroll
            for (int kt = 0; kt < 8; ++kt)
#pragma unroll
                for (int r = 0; r < 4; ++r) *(LAS bf16*)(WL + SA_PIMG + ((4 * kq + r) * SA_PROW + 16 * kt + n) * 2) = (bf16)f2bf(sc[kt][r]);
#pragma unroll 1
            for (int t32 = 0; t32 < 4; ++t32) {
                unsigned tq2 = tq_, kr2 = (unsigned)kr; asm volatile("" : "+v"(tq2), "+v"(kr2));
#pragma unroll
                for (int i = 0; i < 16; ++i) { const f32x4 v = vl[i];
                    *(LAS unsigned long long*)(WL + sa_offb(2 * i + kr2, ch) + 8 * hf) = (unsigned long long)pk2(v.x, v.y) | ((unsigned long long)pk2(v.z, v.w) << 32); }
                if (t32 + 1 < 4) {
#pragma unroll
                    for (int i = 0; i < 16; ++i) vl[i] = __builtin_nontemporal_load((const GAS f32x4*)((const GAS char*)(vbase + (size_t)(32 * (t32 + 1) + 2 * i) * 1024) + roff));
                }
                LDS_WAIT(); asm volatile("" ::: "memory");
                const bf16x8 pa = *(const LAS bf16x8*)(WL + SA_PIMG + (n * SA_PROW + 32 * t32 + 8 * kq) * 2);
#pragma unroll
                for (int c = 0; c < 8; ++c) {
                    const sa_v4i16 lo = sa_tr(WL + sa_offb(8 * kq + tq2, 2 * c + (tp_ >> 1)) + 8 * (tp_ & 1));
                    const sa_v4i16 hi = sa_tr(WL + sa_offb(8 * kq + 4 + tq2, 2 * c + (tp_ >> 1)) + 8 * (tp_ & 1));
                    const bf16x8 vb = {lo[0], lo[1], lo[2], lo[3], hi[0], hi[1], hi[2], hi[3]};
                    acc[c] = __builtin_amdgcn_mfma_f32_16x16x32_bf16(pa, vb, acc[c], 0, 0, 0);
                }
                LDS_WAIT(); asm volatile("" ::: "memory");
            }
        }
        if (n == 0) {
#pragma unroll
            for (int r = 0; r < 4; ++r) { F.PM()[pi * 16 + 4 * kq + r] = m_run[r]; F.PL()[pi * 16 + 4 * kq + r] = l_run[r]; }
        }
#pragma unroll
        for (int c = 0; c < 8; ++c)
#pragma unroll
            for (int r = 0; r < 4; ++r) F.PO()[(pi * 16 + 4 * kq + r) * 128 + 16 * c + n] = acc[c][r];
    } else {
        f32x2 o[16];
#pragma unroll
        for (int m = 0; m < 16; ++m) o[m] = (f32x2){0.f, 0.f};
        float m_run = -1e30f, l_run = 0.f;
        const size_t krow0 = (size_t)(MP + b * TS);
        const bf16* qp = F.QB() + (krow0 + (n & 7)) * 1024 + h * 128 + (n >> 3) * 64;
#pragma unroll
        for (int kk = 0; kk < 2; ++kk) {
            const int t = kq + 4 * kk; const bf16* kp = F.KB() + (krow0 + t) * 1024 + h * 128 + (n >> 3) * 64; float acc = 0.f;
            for (int d = 0; d < 64; d += 2) { const unsigned qw = *(const GAS unsigned*)(qp + d), kw = *(const GAS unsigned*)(kp + d);
                acc += __uint_as_float(qw << 16) * __uint_as_float(kw << 16) + __uint_as_float(qw & 0xffff0000u) * __uint_as_float(kw & 0xffff0000u); }
            const int tq = n & 7;
            Ssc[n * SA_ROW + t] = (t <= tq) ? acc - sl2 * (float)(tq - t) : -1e30f;
        }
        LDS_WAIT(); asm volatile("" ::: "memory");
        {
            const f32x4 s0 = *(const LAS f32x4*)(Ssc + n * SA_ROW), s1 = *(const LAS f32x4*)(Ssc + n * SA_ROW + 4);
            const float mx = fmaxf(fmaxf(fmaxf(s0.x, s0.y), fmaxf(s0.z, s0.w)), fmaxf(fmaxf(s1.x, s1.y), fmaxf(s1.z, s1.w)));
            f32x4 p0, p1; p0.x = __builtin_amdgcn_exp2f(s0.x - mx); p0.y = __builtin_amdgcn_exp2f(s0.y - mx); p0.z = __builtin_amdgcn_exp2f(s0.z - mx); p0.w = __builtin_amdgcn_exp2f(s0.w - mx); p1.x = __builtin_amdgcn_exp2f(s1.x - mx); p1.y = __builtin_amdgcn_exp2f(s1.y - mx); p1.z = __builtin_amdgcn_exp2f(s1.z - mx); p1.w = __builtin_amdgcn_exp2f(s1.w - mx);
            m_run = mx; l_run = (p0.x + p0.y) + (p0.z + p0.w) + (p1.x + p1.y) + (p1.z + p1.w);
            LDS_WAIT(); asm volatile("" ::: "memory");
            if (kq == 0) { *(LAS f32x4*)(Ssc + n * SA_ROW) = p0; *(LAS f32x4*)(Ssc + n * SA_ROW + 4) = p1; }
        }
        LDS_WAIT(); asm volatile("" ::: "memory");
#pragma unroll
        for (int t = 0; t < TS; ++t) {
            const unsigned w = *(const GAS unsigned*)(F.VB() + (krow0 + t) * 1024 + h * 128 + 2 * lane); const f32x2 v2 = {__uint_as_float(w << 16), __uint_as_float(w & 0xffff0000u)};
#pragma unroll
            for (int m = 0; m < 16; ++m) o[m] = o[m] + v2 * Ssc[m * SA_ROW + t];
        }
        LDS_WAIT(); asm volatile("" ::: "memory");
        if (kq == 0) { F.PM()[pi * 16 + n] = m_run; F.PL()[pi * 16 + n] = l_run; }
#pragma unroll
        for (int m = 0; m < 16; ++m) *(GAS f32x2*)(F.PO() + (pi * 16 + m) * 128 + 2 * lane) = o[m];
    }
}
constexpr int N_SATT_UNITS = NBS * NSPLIT + NBS;
constexpr int N_ATT_S = MS * NH, N_ATT_UNITS = NBP * NH * 2 * 2 * (SEQ / 256);
constexpr int CW_QCTR2 = 128;
__device__ __forceinline__ void flash_loop(Frame& F, int ctr) {
    for (;;) {
        __syncthreads();
        if (F.wave == 0 && lane_id() == 0) F.MISC[16] = __hip_atomic_fetch_add(F.ctl + ctr, 1u, RLX_AGENT);
        __syncthreads();
        const int uu = (int)F.MISC[16];
        if (uu >= N_ATT_UNITS * REP_FLASH) break;
        const int u = uu & (N_ATT_UNITS - 1);
        const int qb = 7 - (u >> 7), vh = u & 127, b = vh >> 5, h = (vh >> 2) & 7, map = (vh >> 1) & 1, vhalf = vh & 1;
        const attn_body::bf16* Qp = (const attn_body::bf16*)(F.QB() + h * 128 + map * 64);
        const attn_body::bf16* Kp = (const attn_body::bf16*)(F.KB() + h * 128 + map * 64);
        const attn_body::bf16* Vp = (const attn_body::bf16*)(F.VB() + h * 128 + vhalf * 64);
        attn_body::bf16* Op = (attn_body::bf16*)((map ? F.O2b() : F.O1b()) + h * 128 + vhalf * 64);
        attn_body::attn_unit<8>(b, 0, qb, Qp, Kp, Vp, Op, exp2f(-(float)(h + 1)) * LOG2E, F.lds_g + RING_OFF, F.tid);
    }
}
__device__ __forceinline__ void sattn_loop(Frame& F) {
    for (;;) {
        __syncthreads();
        if (F.wave == 0 && lane_id() == 0) F.MISC[16] = __hip_atomic_fetch_add(F.ctl + CW_QCTR, 1u, RLX_AGENT);
        __syncthreads();
        const int uq = (int)F.MISC[16];
        if (uq >= N_SATT_UNITS * REP_SATT) break;
        sattn_unit(F, REP_SATT > 1 ? uq % N_SATT_UNITS : uq);
    }
}
constexpr int N_MEM_WG = 56;
__device__ __forceinline__ void mixer_phase(Frame& F) {
#define MIX_TID() do { int t_ = F.wave * 64 + lane_id(); asm volatile("" : "+v"(t_)); F.tid = t_; F.lane = t_ & 63; } while (0)
    if ((int)blockIdx.x >= F.G - N_MEM_WG) { MIX_TID(); sattn_loop(F); }
    MIX_TID();
    for (int rp = 0; rp < REP_SCAN; ++rp) {
        const int it = (int)blockIdx.x + (F.G < N_SCAN_ITEMS ? 1 << 20 : 0);
        if (it < N_SCAN_ITEMS) {
            if (it >= NBP * NH) { gdn_chunk_prep(F, NCHUNK_P + (it - NBP * NH), NCHUNK_P + (it - NBP * NH) + 1, 1); asm volatile("s_waitcnt vmcnt(0)" ::: "memory"); __syncthreads(); }
            gdn_scan_item(F, it);
        }
    }
    MIX_TID();
    flash_loop(F, CW_QCTR2);
    MIX_TID();
    sattn_loop(F);
#undef MIX_TID
}
__device__ __forceinline__ void combine_phase(Frame& F) {
    typedef float f32x2 __attribute__((ext_vector_type(2)));
    static_assert(NSP <= 64, "one partial per lane in the sample rows' merge");
    const int lane = F.lane;
    const float lam = __expf(wave_sum(F.lq1()[lane] * F.lk1()[lane])) - __expf(wave_sum(F.lq2()[lane] * F.lk2()[lane])) + 0.2f;
    {
        const f32x2 sw = *(const GAS f32x2*)(F.subln_w() + 2 * lane), dw = *(const GAS f32x2*)(F.dnorm_w() + 2 * lane);
        for (int item = F.gw; item < MS * NH; item += F.NGW) {
            const int ms = item >> 3, h = item & 7, m = MP + ms, b = ms / TS, tq = ms % TS; const size_t p0 = (size_t)(b * NH + h) * NSP; f32x2 om[2];
#pragma unroll
            for (int mp = 0; mp < 2; ++mp) { const int r = mp * 8 + tq;
                const float pm = lane < NSP ? F.PM()[(p0 + lane) * 16 + r] : -1e30f, pl = lane < NSP ? F.PL()[(p0 + lane) * 16 + r] : 0.f;
                const float M = wave_max(pm), wgt = lane < NSP ? exp2f(pm - M) : 0.f, L = wave_sum(wgt * pl);
                f32x2 acc = {0.f, 0.f};
#pragma unroll
                for (int i = 0; i < NSP; ++i) { const float wi = __builtin_bit_cast(float, __builtin_amdgcn_readlane(__builtin_bit_cast(int, wgt), i)); acc = acc + *(const GAS f32x2*)(F.PO() + ((p0 + i) * 16 + r) * 128 + 2 * lane) * wi; }
                om[mp] = acc * (1.f / L); }
            const f32x2 d = om[0] - om[1] * lam;
            const size_t o = (size_t)m * 1024 + h * 128 + 2 * lane;
            const float rs = rsqrtf(wave_sum(d.x * d.x + d.y * d.y) * (1.f / 128.f) + EPS) * 0.8f;
            *(GAS unsigned*)(F.MIX() + (size_t)m * DM + h * 128 + 2 * lane) = pk2(d.x * rs * sw.x, d.y * rs * sw.y);
            const unsigned gw = *(const GAS unsigned*)(F.OG() + o); const f32x2 g = {__uint_as_float(gw << 16), __uint_as_float(gw & 0xffff0000u)};
            const float rg = rsqrtf(wave_sum(g.x * g.x + g.y * g.y) * (1.f / 128.f) + EPS);
            const unsigned zw = *(const GAS unsigned*)(F.Zb() + o); const f32x2 z = {__uint_as_float(zw << 16), __uint_as_float(zw & 0xffff0000u)};
            *(GAS unsigned*)(F.MIX() + (size_t)m * DM + 1024 + h * 128 + 2 * lane) = pk2(g.x * rg * dw.x * silu_f(z.x), g.y * rg * dw.y * silu_f(z.y));
        }
    }
    {
        const int hq = lane >> 4, c8 = lane & 15;
        float sw[8], dw[8];
#pragma unroll
        for (int e = 0; e < 8; ++e) { sw[e] = F.subln_w()[8 * c8 + e] * 0.8f; dw[e] = F.dnorm_w()[8 * c8 + e]; }
#define CB_LOAD(S, item_) do { const int m_ = (item_) >> 1, col_ = (((item_) & 1) * 4 + hq) * 128 + 8 * c8; \
            S##a = *(const GAS v4u*)(F.O1b() + (size_t)m_ * 1024 + col_); S##b = *(const GAS v4u*)(F.O2b() + (size_t)m_ * 1024 + col_); \
            S##z = *(const GAS v4u*)(F.Zb() + (size_t)m_ * 1024 + col_); S##g = *(const GAS v4u*)(F.OG() + (size_t)m_ * 1024 + col_); } while (0)
#define CB_PROC(S, item_) do { const int m = (item_) >> 1, col = (((item_) & 1) * 4 + hq) * 128 + 8 * c8; \
            float d[8], g[8], z[8]; \
            const unsigned w1[4] = {S##a.x, S##a.y, S##a.z, S##a.w}, w2[4] = {S##b.x, S##b.y, S##b.z, S##b.w}, wz[4] = {S##z.x, S##z.y, S##z.z, S##z.w}, wg[4] = {S##g.x, S##g.y, S##g.z, S##g.w}; \
            _Pragma("unroll") for (int e = 0; e < 4; ++e) { d[2 * e] = __uint_as_float(w1[e] << 16) - lam * __uint_as_float(w2[e] << 16); d[2 * e + 1] = __uint_as_float(w1[e] & 0xffff0000u) - lam * __uint_as_float(w2[e] & 0xffff0000u); \
                z[2 * e] = __uint_as_float(wz[e] << 16); z[2 * e + 1] = __uint_as_float(wz[e] & 0xffff0000u); g[2 * e] = __uint_as_float(wg[e] << 16); g[2 * e + 1] = __uint_as_float(wg[e] & 0xffff0000u); } \
            float sd = 0.f, sg = 0.f; \
            _Pragma("unroll") for (int e = 0; e < 8; ++e) { sd += d[e] * d[e]; sg += g[e] * g[e]; } \
            const float rs = rsqrtf(sum16(sd) * (1.f / 128.f) + EPS), rg = rsqrtf(sum16(sg) * (1.f / 128.f) + EPS); \
            *(GAS v4u*)(F.MIX() + (size_t)m * DM + col) = (v4u){pk2(d[0] * rs * sw[0], d[1] * rs * sw[1]), pk2(d[2] * rs * sw[2], d[3] * rs * sw[3]), pk2(d[4] * rs * sw[4], d[5] * rs * sw[5]), pk2(d[6] * rs * sw[6], d[7] * rs * sw[7])}; \
            _Pragma("unroll") for (int e = 0; e < 8; ++e) g[e] = g[e] * rg * dw[e] * silu_f(z[e]); \
            *(GAS v4u*)(F.MIX() + (size_t)m * DM + 1024 + col) = (v4u){pk2(g[0], g[1]), pk2(g[2], g[3]), pk2(g[4], g[5]), pk2(g[6], g[7])}; } while (0)
        {
            constexpr int TOT = 2 * MP; const int st = F.NGW;
            v4u Aa, Ab, Az, Ag, Ba, Bb, Bz, Bg, Ca, Cb, Cz, Cg;
            if (F.gw < TOT) CB_LOAD(A, F.gw);
            if (F.gw + st < TOT) CB_LOAD(B, F.gw + st);
            for (int item = F.gw; item < TOT; item += 3 * st) {
                if (item + 2 * st < TOT) CB_LOAD(C, item + 2 * st);
                CB_PROC(A, item);
                if (item + 3 * st < TOT) CB_LOAD(A, item + 3 * st);
                if (item + st < TOT) CB_PROC(B, item + st);
                if (item + 4 * st < TOT) CB_LOAD(B, item + 4 * st);
                if (item + 2 * st < TOT) CB_PROC(C, item + 2 * st);
            }
        }
#undef CB_LOAD
#undef CB_PROC
    }
}
__global__ void __launch_bounds__(NTHREADS, 2) fwd_kernel(Args args) {
    extern __shared__ __attribute__((aligned(16))) unsigned char lds[];
    Frame F(args);
    F.lds = (LAS unsigned char*)lds; F.MISC = (volatile LAS unsigned*)(F.lds + MISC_OFF); F.lds_g = (char*)lds;
    F.tid = threadIdx.x; F.lane = F.tid & 63; F.wave = __builtin_amdgcn_readfirstlane(F.tid >> 6);
    F.G = gridDim.x; F.gw = (int)blockIdx.x * NWAVES + F.wave; F.NGW = F.G * NWAVES;
    F.ctl = (gu32*)(args.ws + WS_CTL); F.z = 0; F.ws = args.ws;
    for (int u = F.tid; u < (LDS_BYTES - LDSCTL_OFF) / 4; u += NTHREADS) ((LAS unsigned*)(F.lds + LDSCTL_OFF))[u] = 0u;
    __syncthreads();
    XcdBarrier bar; bar.bar = (unsigned*)(F.ctl + CW_BAR); bar.x = 0; bar.st = nullptr;
    if (MK_N_LAUNCHES == 1) bar = xcd_barrier_post((unsigned*)(F.ctl + CW_BAR), F.MISC + 8, F.tid == 0);
    const int lo = args.ph_lo, hi = args.ph_hi;
#define IN(k) (lo <= (k) && (k) < hi)
#define PB() do { int t_ = F.wave * 64 + lane_id(); asm volatile("" : "+v"(t_)); F.tid = t_; F.lane = t_ & 63; int z_ = 0; asm volatile("" : "+s"(z_)); F.z = z_; F.ws = args.ws + z_; } while (0)
#define SEAM(k) do { if (IN(k) && IN((k) + 1)) { if (MK_N_LAUNCHES == 1) xcd_barrier(bar, F.wave == 0 && lane_id() == 0); } } while (0)
#ifndef ROT_ALL
#define ROT_ALL 0
#endif
#define GEMM_PH(EpiT, Eobj, Aptr, Bptr, N_, K_) GEMM_PHX(EpiT, Eobj, Aptr, Bptr, N_, K_, ROT_ALL)
#define GEMM_PHR(EpiT, Eobj, Aptr, Bptr, N_, K_) GEMM_PHX(EpiT, Eobj, Aptr, Bptr, N_, K_, 1)
#define GEMM_PHX(EpiT, Eobj, Aptr, Bptr, N_, K_, ROT_) do { pg8::Gemm g{Aptr, Bptr, MP, N_, K_, (ROT_) ? (((int)blockIdx.x & 7) * ((K_) / 64) / 8) & ~1 : 0}; pg8::StaticOrder S; S.init(MP, N_, F.G, (int)blockIdx.x); \
        pg8::gemm_phase<EpiT, pg8::StaticOrder, PG8_ALIGN, PG8_SP2>(F.lds + RING_OFF, g, S, Eobj, F.tid); } while (0)
    if (IN(0)) { PB(); for (int rp = 0; rp < REP_PRO; ++rp) p0_prologue(F); } SEAM(0);
#ifdef REP_BAR
    for (int rp = 0; rp < REP_BAR; ++rp) xcd_barrier(bar, F.wave == 0 && lane_id() == 0);
#endif
    if (IN(1)) { PB(); EpiAct E{F.ACT(), F.RS()}; for (int rp = 0; rp < REP_G1; ++rp) GEMM_PH(EpiAct, E, F.X0h(), F.W1GU(), GU, DM);
                 SkEpiAct SE{F.ACT() + (size_t)MP * FF, F.RS() + MP}; skinny_phase<2, 1>(F, F.X0h() + (size_t)MP * DM, F.W1GU(), DM, FF / 16, SE, 128);
#if CONV_TAILS
                 convert_matrix(F, F.down1(), FF, DM, DM, F.W1D(), 0, 128);
#endif
    } SEAM(1);
    if (IN(2)) { PB(); EpiBf E{F.F16()}; GEMM_PHR(EpiBf, E, F.ACT(), F.W1D(), DM, FF);
#ifdef REP_G2
        GEMM_PHR(EpiBf, E, F.ACT(), F.W1D(), DM, FF);
#endif
 SkEpiAddF32 SE{F.Fb() + (size_t)MP * DM}; skinny_phase<1, 2>(F, F.ACT() + (size_t)MP * FF, F.W1D(), FF, DM / 16, SE, 0); } SEAM(2);
    if (IN(3)) { PB(); for (int rp = 0; rp < REP_THIN; ++rp) thin_rows(F, F.X0h(), F.F16(), F.Fb(), 0.5f, F.ffn1_post(), F.X1h(), nullptr, F.RS()); } SEAM(3);
    if (IN(4)) { PB(); EpiIn E{F.QB(), F.KB(), F.VB(), F.QKVB(), F.Zb(), F.BA(), F.out(), F.RS()}; GEMM_PH(EpiIn, E, F.X1h(), F.WIN(), INW_PAD, DM);
#ifdef REP_WIN
        GEMM_PH(EpiIn, E, F.X1h(), F.WIN(), INW_PAD, DM);
#endif

                 SkEpiIn SE{F.QB() + (size_t)MP * 1024, F.KB() + (size_t)MP * 1024, F.VB() + (size_t)MP * 1024, F.QKVB() + (size_t)MP * CONVD, F.Zb() + (size_t)MP * 1024, F.BA() + (size_t)MP * 16, F.out(), F.RS() + MP};
                 skinny_phase<2, 1, SkEpiIn, 16, false>(F, F.X1h() + (size_t)MP * DM, F.WIN(), DM, (INW + 31) / 32, SE, 160); } SEAM(4);
    if (IN(5)) { PB(); for (int rp = 0; rp < REP_PREP; ++rp) { const int per = 2 * ((NCHUNK_P / 2 + F.G - 1) / F.G), c0 = per * (int)blockIdx.x; gdn_chunk_prep2(F, c0 < NCHUNK_P ? c0 : NCHUNK_P, c0 + per < NCHUNK_P ? c0 + per : NCHUNK_P); } } SEAM(5);
    if (IN(6)) { PB(); mixer_phase(F); } SEAM(6);
    if (IN(7)) { PB(); combine_phase(F);
#ifdef REP_COMB
        combine_phase(F); combine_phase(F);
#endif
    } SEAM(7);
    if (IN(8)) { PB(); EpiBf E{F.F16()}; GEMM_PH(EpiBf, E, F.MIX(), F.WOUT(), DM, DM); SkEpiAddF32 SE{F.Fb() + (size_t)MP * DM}; skinny_phase<1, 2>(F, F.MIX() + (size_t)MP * DM, F.WOUT(), DM, DM / 16, SE, 0); } SEAM(8);
    if (IN(9)) { PB(); thin_rows(F, F.X1h(), F.F16(), F.Fb(), 1.0f, F.mix_post(), F.X2h(), nullptr, F.RS()); } SEAM(9);
    if (IN(10)) { PB(); EpiAct E{F.ACT(), F.RS()}; GEMM_PH(EpiAct, E, F.X2h(), F.W2GU(), GU, DM);
                  SkEpiAct SE{F.ACT() + (size_t)MP * FF, F.RS() + MP}; skinny_phase<2, 1>(F, F.X2h() + (size_t)MP * DM, F.W2GU(), DM, FF / 16, SE, 128);
#if CONV_TAILS
                  convert_matrix(F, F.down2(), FF, DM, DM, F.W2D(), 0, 128);
#endif
    } SEAM(10);
    if (IN(11)) { PB(); EpiBf E{F.F16()}; GEMM_PHR(EpiBf, E, F.ACT(), F.W2D(), DM, FF); SkEpiAddF32 SE{F.Fb() + (size_t)MP * DM}; skinny_phase<1, 2>(F, F.ACT() + (size_t)MP * FF, F.W2D(), FF, DM / 16, SE, 0); } SEAM(11);
    if (IN(12)) { PB(); thin_rows(F, F.X2h(), F.F16(), F.Fb(), 0.5f, F.ffn2_post(), nullptr, F.out() + OUT_Y, nullptr); }
#undef IN
#undef SEAM
#undef GEMM_PH
#undef GEMM_PHR
#undef GEMM_PHX
}

extern "C" void kernel_launch(void* const* d_in, const int* in_sizes, int n_in, void* d_out, int out_size, void* d_ws, size_t ws_size, hipStream_t stream) {
    static int grid = 0;
    if (grid == 0) {
        if (n_in != 30 || ws_size < WS_END) { fprintf(stderr, "kernel_launch: unexpected shapes (n_in %d, out %d, ws %zu)\n", n_in, out_size, ws_size); grid = -1; return; }
        int dev = 0, cus = 0, per_cu = 0;
        if (hipGetDevice(&dev) != hipSuccess || hipDeviceGetAttribute(&cus, hipDeviceAttributeMultiprocessorCount, dev) != hipSuccess) { grid = -1; return; }
        if (hipFuncSetAttribute((const void*)fwd_kernel, hipFuncAttributeMaxDynamicSharedMemorySize, LDS_BYTES) != hipSuccess) { fprintf(stderr, "kernel_launch: hipFuncSetAttribute failed\n"); grid = -1; return; }
        if (hipOccupancyMaxActiveBlocksPerMultiprocessor(&per_cu, (const void*)fwd_kernel, NTHREADS, LDS_BYTES) != hipSuccess || per_cu < 1) { fprintf(stderr, "kernel_launch: occupancy query says %d\n", per_cu); }
        (void)hipGetLastError();
        grid = cus;
    }
    if (grid < 0) return;
    (void)hipMemsetAsync((char*)d_ws + WS_CTL, 0, CTL_ZERO_BYTES, stream);
    Args a{};
    for (int i = 0; i < 30; ++i) a.in[i] = d_in[i];
    a.out = (float*)d_out; a.ws = (unsigned char*)d_ws;
    if (MK_N_LAUNCHES == 1) { a.ph_lo = 0; a.ph_hi = NPHASE; hipLaunchKernelGGL(fwd_kernel, dim3(grid), dim3(NTHREADS), LDS_BYTES, stream, a); }
    else for (int p = 0; p < NPHASE; ++p) { a.ph_lo = p; a.ph_hi = p + 1; hipLaunchKernelGGL(fwd_kernel, dim3(grid), dim3(NTHREADS), LDS_BYTES, stream, a); }
}
```

```cpp
#include <hip/hip_runtime.h>
#include <cstdio>
#include <cstdint>
namespace pg8 {
#define PG8_LAS __attribute__((address_space(3)))
typedef unsigned short bf16_t;
typedef short bf16x8 __attribute__((ext_vector_type(8)));
typedef float f32x4 __attribute__((ext_vector_type(4)));
typedef unsigned u32x4 __attribute__((ext_vector_type(4)));
constexpr int BM = 256, BK = 64, HALF = 128, HTB = HALF * BK * 2  , STAGE_BYTES = 8 * HTB, NXCD = 8, WGM = 8;

__host__ __device__ __forceinline__ int lds_byte(int r, int c) { const int st = (r >> 4) * 2 + (c >> 5), rr = r & 15, cc = c & 31, ob = rr * 64 + cc * 2; return st * 1024 + (ob ^ (((ob >> 9) & 1) << 5)); }
__host__ __device__ __forceinline__ void stage_rc(int b, int& R, int& C) { const int st = b / 1024, sb = b % 1024, swz = sb ^ (((sb >> 9) & 1) << 5); R = (st >> 1) * 16 + swz / 64; C = (st & 1) * 32 + (swz % 64) / 2; }
__host__ __device__ __forceinline__ int perm32(int rho) { const int n = rho >> 4, i = rho & 15; return 8 * (i >> 2) + 4 * n + (i & 3); }

struct Unit { int pm, pn; };
struct Gemm { const bf16_t* A; const bf16_t* Bt; int M, N, K; int rot; };

struct StaticOrder {
    int nM, nN, nwg, G, c;
    __host__ __device__ void init(int M, int N, int G_, int c_) { nM = M / BM; nN = N / BM; nwg = nM * nN; G = G_; c = c_; }
    __host__ __device__ bool next(int i, Unit& u) const {
        const long L = (long)i * G + c; if (L >= nwg) return false;
        int wgid = (int)L; { const int q = nwg / NXCD, r = nwg % NXCD, xcd = wgid % NXCD, off = wgid / NXCD; wgid = (xcd < r ? xcd * (q + 1) : r * (q + 1) + (xcd - r) * q) + off; }
        const int nig = WGM * nN, gid = wgid / nig, fm = gid * WGM, gsz = (nM - fm) < WGM ? (nM - fm) : WGM;
        u.pm = fm + ((wgid % nig) % gsz); u.pn = (wgid % nig) / gsz; return true;
    }
    __device__ __forceinline__ void a_ready(const Unit&) const {}
    __device__ __forceinline__ void done(const Unit&) const {}
};

__device__ __forceinline__ unsigned cvt_pk_bf16(float lo, float hi) { unsigned r; asm volatile("v_cvt_pk_bf16_f32 %0, %1, %2" : "=v"(r) : "v"(lo), "v"(hi)); return r; }
typedef float f32x2 __attribute__((ext_vector_type(2)));
__device__ __forceinline__ f32x2 gelu_pk(f32x2 v) {
    const f32x2 av = __builtin_elementwise_abs(v), d = av * 0.2316418882f + 1.0f;
    f32x2 t; t.x = __builtin_amdgcn_rcpf(d.x); t.y = __builtin_amdgcn_rcpf(d.y);
    f32x2 q = t * 0.5307027145f + (-0.7265760135f); q = q * t + 0.7107068705f; q = q * t + (-0.142248368f); q = q * t + 0.127414796f; q = q * t;
    const f32x2 s = (v * v) * (-0.72134752044f);
    f32x2 e; e.x = __builtin_amdgcn_exp2f(s.x); e.y = __builtin_amdgcn_exp2f(s.y);
    const f32x2 m = v * (q * e), r = v - m;
    f32x2 o; o.x = v.x < 0.f ? m.x : r.x; o.y = v.y < 0.f ? m.y : r.y; return o;
}

template <int ACT  > struct EpiBf16 {
    static constexpr bool PERM = true, AFTER_DRAIN = false; static_assert(ACT == 0 || ACT == 1, "EpiBf16: ACT is 0 (none) or 1 (gelu_pk)");
    bf16_t* O; int ldc; const float* bias; int split_cols; size_t split_stride; float scale0;
    __device__ __forceinline__ void operator()(const f32x4 (&acc)[2][2][4][2], const Unit& u, int wr, int wc, int fr, int fq) const {
        const int row0 = u.pm * BM + wr * 64 + fr; int colt = u.pn * BM; bf16_t* base = O;
        float sc = 1.f; if (split_cols) { const int t = colt / split_cols; base += (size_t)t * split_stride; colt -= t * split_cols; if (t == 0) sc = scale0; }
        const int col0 = colt + wc * 32 + 8 * fq, bcol0 = u.pn * BM + wc * 32 + 8 * fq;
        f32x4 bv[2][2];
#pragma unroll
        for (int bj = 0; bj < 2; ++bj)
#pragma unroll
            for (int n = 0; n < 2; ++n) bv[bj][n] = bias ? *(const f32x4*)(bias + bcol0 + bj * HALF + 4 * n) : (f32x4){0.f, 0.f, 0.f, 0.f};
#pragma unroll
        for (int ai = 0; ai < 2; ++ai)
#pragma unroll
            for (int m = 0; m < 4; ++m) { bf16_t* rowp = base + (size_t)(row0 + ai * HALF + m * 16) * ldc + col0;
#pragma unroll
                for (int bj = 0; bj < 2; ++bj) { f32x4 v0 = acc[ai][bj][m][0] + bv[bj][0], v1 = acc[ai][bj][m][1] + bv[bj][1];
                    if (ACT == 1) { f32x2 a = gelu_pk((f32x2){v0[0], v0[1]}), b = gelu_pk((f32x2){v0[2], v0[3]}), c = gelu_pk((f32x2){v1[0], v1[1]}), d = gelu_pk((f32x2){v1[2], v1[3]});
                        v0 = (f32x4){a.x, a.y, b.x, b.y}; v1 = (f32x4){c.x, c.y, d.x, d.y}; }
                    v0 = v0 * sc; v1 = v1 * sc; u32x4 w; w.x = cvt_pk_bf16(v0[0], v0[1]); w.y = cvt_pk_bf16(v0[2], v0[3]); w.z = cvt_pk_bf16(v1[0], v1[1]); w.w = cvt_pk_bf16(v1[2], v1[3]);
                    *(u32x4*)(rowp + bj * HALF) = w; } }
    }
};

struct PanelStats {
    unsigned* xbuf;
    unsigned* cnt;
    unsigned* tmo;
    int ntn; float eps;
    unsigned code;
    __device__ __forceinline__ bool run(const f32x4 (&v)[2][2][4][2], const Unit& u, int wr, int wc, int fr, int fq, PG8_LAS unsigned char* lds, int wid, int lane) const {
        typedef float f32x2v __attribute__((ext_vector_type(2)));
        PG8_LAS f32x2v* P = (PG8_LAS f32x2v*)lds;
        PG8_LAS f32x2v* S = (PG8_LAS f32x2v*)(lds + 8192);
        PG8_LAS unsigned* flag = (PG8_LAS unsigned*)(lds + 8192 + 2048);
#pragma unroll
        for (int ai = 0; ai < 2; ++ai)
#pragma unroll
            for (int m = 0; m < 4; ++m) {
                float s = 0.f;
#pragma unroll
                for (int bj = 0; bj < 2; ++bj)
#pragma unroll
                    for (int n = 0; n < 2; ++n) { const f32x4 x = v[ai][bj][m][n]; s += (x[0] + x[1]) + (x[2] + x[3]); }
                s += __shfl_xor(s, 16); s += __shfl_xor(s, 32);
                const float mw = s * (1.0f / 64.0f); float q = 0.f;
#pragma unroll
                for (int bj = 0; bj < 2; ++bj)
#pragma unroll
                    for (int n = 0; n < 2; ++n) { const f32x4 d = v[ai][bj][m][n] - mw; q += (d[0] * d[0] + d[1] * d[1]) + (d[2] * d[2] + d[3] * d[3]); }
                q += __shfl_xor(q, 16); q += __shfl_xor(q, 32);
                if (fq == 0) P[(ai * HALF + wr * 64 + m * 16 + fr) * 4 + wc] = (f32x2v){mw, q};
            }
        asm volatile("s_waitcnt lgkmcnt(0)" ::: "memory"); __builtin_amdgcn_s_barrier(); asm volatile("" ::: "memory");
#if defined(BROKEN_EXCHANGE_NO_WAIT)
#warning BROKEN CONTROL BUILD: the row-statistics exchange does not wait; results are wrong by design
        if (blockIdx.x >= 64) { const long long t0_ = clock64(); while (clock64() - t0_ < 60000) __builtin_amdgcn_s_sleep(8); }
#endif
        const int row = wid * 32 + (lane & 31);
        if (lane < 32) {
            const f32x2v a = P[row * 4 + 0], b = P[row * 4 + 1], c = P[row * 4 + 2], d = P[row * 4 + 3];
            const float mt = (a.x + b.x + c.x + d.x) * 0.25f;
            const float da = a.x - mt, db = b.x - mt, dc = c.x - mt, dd = d.x - mt;
            const float m2 = (a.y + b.y) + (c.y + d.y) + 64.0f * ((da * da + db * db) + (dc * dc + dd * dd));
            unsigned long long* slot = (unsigned long long*)xbuf + ((size_t)(u.pm * BM + row) * 4 + u.pn);
            __hip_atomic_store(slot, ((unsigned long long)__float_as_uint(m2) << 32) | __float_as_uint(mt), __ATOMIC_RELAXED, __HIP_MEMORY_SCOPE_AGENT);
        }
        asm volatile("s_waitcnt vmcnt(0)" ::: "memory");
        if (lane == 0) __hip_atomic_fetch_add(cnt + 64 * u.pm, 1u, __ATOMIC_RELAXED, __HIP_MEMORY_SCOPE_AGENT);
        if (wid == 0) {
            bool dead = false; const unsigned long long t0 = __builtin_amdgcn_s_memrealtime(); const unsigned want = 8u * (unsigned)ntn;
            for (;;) {
#if defined(BROKEN_EXCHANGE_NO_WAIT)
                break;
#endif
                if ((unsigned)__builtin_amdgcn_readfirstlane(__hip_atomic_load(cnt + 64 * u.pm, __ATOMIC_RELAXED, __HIP_MEMORY_SCOPE_AGENT)) >= want) break;
                if (__builtin_amdgcn_s_memrealtime() - t0 > 2000000ull) {
                    if (lane == 0) { unsigned expect = 0u; __hip_atomic_compare_exchange_strong(tmo + 1, &expect, code | (unsigned)(u.pm & 0xff), __ATOMIC_RELAXED, __ATOMIC_RELAXED, __HIP_MEMORY_SCOPE_AGENT);
                                     __hip_atomic_store(tmo, 1u, __ATOMIC_RELAXED, __HIP_MEMORY_SCOPE_AGENT); }
                    dead = true; break; }
                __builtin_amdgcn_s_sleep(2);
            }
            __builtin_amdgcn_fence(__ATOMIC_ACQUIRE, "agent");
            if (lane == 0) flag[0] = dead ? 1u : 0u;
        }
        asm volatile("s_waitcnt vmcnt(0) lgkmcnt(0)" ::: "memory"); __builtin_amdgcn_s_barrier(); asm volatile("" ::: "memory");
        const bool bad = flag[0] != 0u;
        if (lane < 32) {
            const unsigned long long* slot = (const unsigned long long*)xbuf + (size_t)(u.pm * BM + row) * 4; float mt[4], m2[4]; float ms = 0.f;
#pragma unroll
            for (int t = 0; t < 4; ++t) { if (t < ntn) { const unsigned long long w = __hip_atomic_load(slot + t, __ATOMIC_RELAXED, __HIP_MEMORY_SCOPE_AGENT); mt[t] = __uint_as_float((unsigned)w); m2[t] = __uint_as_float((unsigned)(w >> 32)); } else { mt[t] = 0.f; m2[t] = 0.f; } ms += mt[t]; }
            const float mean = ms / (float)ntn; float q = 0.f;
#pragma unroll
            for (int t = 0; t < 4; ++t) if (t < ntn) { const float dm = mt[t] - mean; q += m2[t] + 256.0f * dm * dm; }
            S[row] = (f32x2v){mean, 1.0f / sqrtf(q / (256.0f * (float)ntn) + eps)};
        }
        asm volatile("s_waitcnt lgkmcnt(0)" ::: "memory"); __builtin_amdgcn_s_barrier(); asm volatile("" ::: "memory");
        return bad;
    }
};
struct EpiLnRes {
    static constexpr bool PERM = false, AFTER_DRAIN = true;
    const float* base; float* out; int ldc; const float* bias; PanelStats st; unsigned poison;
    __device__ __forceinline__ void fused(f32x4 (&acc)[2][2][4][2], const Unit& u, int wr, int wc, int fr, int fq, PG8_LAS unsigned char* lds, int wid, int lane) const {
        typedef float f32x2v __attribute__((ext_vector_type(2)));
        const PG8_LAS f32x2v* S = (const PG8_LAS f32x2v*)(lds + 8192);
        const int col0 = u.pn * BM + wc * 32 + 4 * fq;
#pragma unroll
        for (int bj = 0; bj < 2; ++bj)
#pragma unroll
            for (int n = 0; n < 2; ++n) { const f32x4 bv = bias ? *(const f32x4*)(bias + col0 + bj * HALF + n * 16) : (f32x4){0.f, 0.f, 0.f, 0.f};
#pragma unroll
                for (int ai = 0; ai < 2; ++ai)
#pragma unroll
                    for (int m = 0; m < 4; ++m) acc[ai][bj][m][n] += bv; }
        f32x4 pre[4][2][2];
#pragma unroll
        for (int m = 0; m < 4; ++m) { const size_t off = (size_t)(u.pm * BM + wr * 64 + m * 16 + fr) * ldc + col0;
#pragma unroll
            for (int bj = 0; bj < 2; ++bj)
#pragma unroll
                for (int n = 0; n < 2; ++n) pre[m][bj][n] = *(const f32x4*)(base + off + bj * HALF + n * 16); }
        const bool bad = st.run(acc, u, wr, wc, fr, fq, lds, wid, lane) || poison != 0u;
        const float qnan = __builtin_nanf("");
#pragma unroll
        for (int ai = 0; ai < 2; ++ai)
#pragma unroll
            for (int m = 0; m < 4; ++m) { const int r = ai * HALF + wr * 64 + m * 16 + fr; const f32x2v sr = S[r]; const size_t off = (size_t)(u.pm * BM + r) * ldc + col0;
#pragma unroll
                for (int bj = 0; bj < 2; ++bj)
#pragma unroll
                    for (int n = 0; n < 2; ++n) { const f32x4 bs = ai == 0 ? pre[m][bj][n] : *(const f32x4*)(base + off + bj * HALF + n * 16); f32x4 o = bs + (acc[ai][bj][m][n] - sr.x) * sr.y;
                        if (bad) o = (f32x4){qnan, qnan, qnan, qnan}; *(f32x4*)(out + off + bj * HALF + n * 16) = o; }
                if (m & 1) asm volatile("" ::: "memory"); }
    }
};
struct EpiLnResLn {
    static constexpr bool PERM = false, AFTER_DRAIN = true;
    const float* base; float* out; bf16_t* xn; int ldc; const float* bias; PanelStats st1, st2; unsigned poison;
    __device__ __forceinline__ void fused(f32x4 (&acc)[2][2][4][2], const Unit& u, int wr, int wc, int fr, int fq, PG8_LAS unsigned char* lds, int wid, int lane) const {
        typedef float f32x2v __attribute__((ext_vector_type(2))); typedef unsigned u32x2v __attribute__((ext_vector_type(2)));
        const PG8_LAS f32x2v* S = (const PG8_LAS f32x2v*)(lds + 8192);
        const int col0 = u.pn * BM + wc * 32 + 4 * fq;
#pragma unroll
        for (int bj = 0; bj < 2; ++bj)
#pragma unroll
            for (int n = 0; n < 2; ++n) { const f32x4 bv = bias ? *(const f32x4*)(bias + col0 + bj * HALF + n * 16) : (f32x4){0.f, 0.f, 0.f, 0.f};
#pragma unroll
                for (int ai = 0; ai < 2; ++ai)
#pragma unroll
                    for (int m = 0; m < 4; ++m) acc[ai][bj][m][n] += bv; }
        bool bad = st1.run(acc, u, wr, wc, fr, fq, lds, wid, lane) || poison != 0u;
        const float qnan = __builtin_nanf("");
#pragma unroll
        for (int ai = 0; ai < 2; ++ai)
#pragma unroll
            for (int m = 0; m < 4; ++m) { const int r = ai * HALF + wr * 64 + m * 16 + fr; const f32x2v sr = S[r]; const size_t off = (size_t)(u.pm * BM + r) * ldc + col0;
#pragma unroll
                for (int bj = 0; bj < 2; ++bj)
#pragma unroll
                    for (int n = 0; n < 2; ++n) { const f32x4 bs = *(const f32x4*)(base + off + bj * HALF + n * 16); acc[ai][bj][m][n] = bs + (acc[ai][bj][m][n] - sr.x) * sr.y; }
                asm volatile("" : "+v"(acc[ai][0][m][0]), "+v"(acc[ai][0][m][1]), "+v"(acc[ai][1][m][0]), "+v"(acc[ai][1][m][1]));
                if (m & 1) asm volatile("" ::: "memory"); }
        const bool bad1 = bad;
        bad = st2.run(acc, u, wr, wc, fr, fq, lds, wid, lane) || bad;
#pragma unroll
        for (int ai = 0; ai < 2; ++ai)
#pragma unroll
            for (int m = 0; m < 4; ++m) { const int r = ai * HALF + wr * 64 + m * 16 + fr; const f32x2v sr = S[r]; const size_t off = (size_t)(u.pm * BM + r) * ldc + col0;
#pragma unroll
                for (int bj = 0; bj < 2; ++bj)
#pragma unroll
                    for (int n = 0; n < 2; ++n) { const f32x4 x1 = acc[ai][bj][m][n]; *(f32x4*)(out + off + bj * HALF + n * 16) = bad1 ? (f32x4){qnan, qnan, qnan, qnan} : x1;
                        const f32x4 o = (x1 - sr.x) * sr.y; u32x2v w; w.x = cvt_pk_bf16(o[0], o[1]); w.y = cvt_pk_bf16(o[2], o[3]);
                        if (bad) { w.x = 0x7fc07fc0u; w.y = 0x7fc07fc0u; } *(u32x2v*)(xn + off + bj * HALF + n * 16) = w; }
                asm volatile("" ::: "memory"); }
    }
};

template <class Epi, class Sched, bool ALIGN_EPI = false, bool SP2 = false>
__device__ __forceinline__ void gemm_phase(PG8_LAS unsigned char* lds, const Gemm g, const Sched& S, const Epi& E, const int tid_in) {
    const int tid = tid_in, wid = __builtin_amdgcn_readfirstlane(tid >> 6), lane = tid & 63, wr = wid >> 2, wc = wid & 3, fr = lane & 15, fq = lane >> 4;
    const int K = g.K, nt = K / BK;
    unsigned voffA[2], voffB[2];
#pragma unroll
    for (int i = 0; i < 2; ++i) { int R, C; stage_rc(tid * 16 + i * 8192, R, C); const int Rb = Epi::PERM ? ((R & ~31) + perm32(R & 31)) : R;
        voffA[i] = (unsigned)(R * K + C) * 2u; voffB[i] = (unsigned)(Rb * K + C) * 2u; }
    const size_t kstep = (size_t)(BK * 2);
    const size_t hstep = (size_t)HALF * K * 2;
    const size_t tstep = 2 * hstep;
    const unsigned ldsw = (unsigned)wid * 1024u;
    const int aoff = lds_byte(wr * 64 + fr, fq * 8), boff = lds_byte(wc * 32 + fr, fq * 8);
#define PG8_SA(b, h) (((b) * 2 + (h)) * HTB)
#define PG8_SB(b, h) ((4 + (b) * 2 + (h)) * HTB)
#define PG8_STAGE(bufoff, gbase, voff) do { _Pragma("unroll") for (int _i = 0; _i < 2; ++_i) \
        __builtin_amdgcn_global_load_lds((const unsigned*)((const char*)(gbase) + (voff)[_i]), (PG8_LAS unsigned*)(lds + (bufoff) + ldsw + _i * 8192), 16, 0, 0); } while (0)
#define PG8_LDA(dst, b, h) do { _Pragma("unroll") for (int m = 0; m < 4; ++m) _Pragma("unroll") for (int k = 0; k < 2; ++k) dst[m][k] = *(const PG8_LAS bf16x8*)(lds + PG8_SA(b, h) + aoff + m * 2048 + k * 1024); } while (0)
#define PG8_LDB(dst, b, h) do { _Pragma("unroll") for (int n = 0; n < 2; ++n) _Pragma("unroll") for (int k = 0; k < 2; ++k) dst[n][k] = *(const PG8_LAS bf16x8*)(lds + PG8_SB(b, h) + boff + n * 2048 + k * 1024); } while (0)
#define PG8_MMA(ai, bj, At, Bt) do { __builtin_amdgcn_s_setprio(1); _Pragma("unroll") for (int m = 0; m < 4; ++m) _Pragma("unroll") for (int n = 0; n < 2; ++n) _Pragma("unroll") for (int k = 0; k < 2; ++k) \
        acc[ai][bj][m][n] = __builtin_amdgcn_mfma_f32_16x16x32_bf16(Bt[n][k], At[m][k], acc[ai][bj][m][n], 0, 0, 0); __builtin_amdgcn_s_setprio(0); } while (0)
#define PG8_WAIT_V(n) asm volatile("s_waitcnt vmcnt(" #n ")" ::: "memory")
#define PG8_WAIT_L(n) asm volatile("s_waitcnt lgkmcnt(" #n ")" ::: "memory")
#define PG8_BAR __builtin_amdgcn_s_barrier()
#define PG8_SCHED __builtin_amdgcn_sched_barrier(0)
    Unit cur, nxt; int ui = 0;
    if (!S.next(0, cur)) return;
    f32x4 acc[2][2][4][2];
#pragma unroll
    for (int a = 0; a < 2; ++a)
#pragma unroll
        for (int b = 0; b < 2; ++b)
#pragma unroll
            for (int m = 0; m < 4; ++m)
#pragma unroll
                for (int n = 0; n < 2; ++n) acc[a][b][m][n] = (f32x4){0.f, 0.f, 0.f, 0.f};
    bf16x8 At[4][2], B0[2][2], B1[2][2];
    const char* cA = (const char*)g.A + (size_t)cur.pm * tstep; const char* cB = (const char*)g.Bt + (size_t)cur.pn * tstep;
    const size_t rotb = (size_t)g.rot * kstep;
    S.a_ready(cur);
    { const char* cA0 = cA; const char* cB0 = cB; cA += rotb; cB += rotb;
    if constexpr (SP2) {
        PG8_STAGE(PG8_SB(0, 0), cB, voffB); PG8_STAGE(PG8_SB(0, 1), cB + hstep, voffB); PG8_STAGE(PG8_SA(0, 0), cA, voffA); PG8_STAGE(PG8_SA(0, 1), cA + hstep, voffA);
        if (wr == 1) PG8_BAR;
        PG8_WAIT_V(2); PG8_BAR;
        PG8_STAGE(PG8_SB(1, 0), cB + kstep, voffB); PG8_STAGE(PG8_SA(1, 0), cA + kstep, voffA); PG8_STAGE(PG8_SB(1, 1), cB + hstep + kstep, voffB);
        PG8_WAIT_V(6); PG8_BAR;
    } else {
        PG8_STAGE(PG8_SB(0, 0), cB, voffB); PG8_STAGE(PG8_SA(0, 0), cA, voffA); PG8_STAGE(PG8_SB(0, 1), cB + hstep, voffB); PG8_STAGE(PG8_SA(0, 1), cA + hstep, voffA);
        if (wr == 1) PG8_BAR;
        PG8_WAIT_V(4); PG8_BAR;
        PG8_STAGE(PG8_SB(1, 0), cB + kstep, voffB); PG8_STAGE(PG8_SA(1, 0), cA + kstep, voffA); PG8_STAGE(PG8_SB(1, 1), cB + hstep + kstep, voffB);
        PG8_WAIT_V(6); PG8_BAR;
    }
    cA = cA0; cB = cB0; }
    for (;;) {
        const bool has_next = S.next(ui + 1, nxt);
        const char* nA = has_next ? (const char*)g.A + (size_t)nxt.pm * tstep : cA; const char* nB = has_next ? (const char*)g.Bt + (size_t)nxt.pn * tstep : cB;
        for (int t = 0; t < nt; t += 2) {
            const bool last = (t == nt - 2);
            int kc = t + g.rot; kc = kc >= nt ? kc - nt : kc; int kn = kc + 2; kn = kn >= nt ? kn - nt : kn;
            const char* a1 = cA + (size_t)(kc + 1) * kstep;
            const char* a2 = last ? nA + rotb : cA + (size_t)kn * kstep; const char* b2 = last ? nB + rotb : cB + (size_t)kn * kstep;
            const char* a3 = a2 + kstep; const char* b3 = b2 + kstep;
            if (last && has_next) S.a_ready(nxt);
            if constexpr (SP2) {
            PG8_LDB(B0, 0, 0); PG8_LDB(B1, 0, 1); PG8_SCHED; PG8_LDA(At, 0, 0); PG8_STAGE(PG8_SA(1, 1), a1 + hstep, voffA);
            PG8_WAIT_V(8); PG8_WAIT_L(0); PG8_BAR; PG8_MMA(0, 0, At, B0); PG8_MMA(0, 1, At, B1); PG8_BAR; PG8_SCHED;
            PG8_LDA(At, 0, 1); PG8_STAGE(PG8_SB(0, 0), b2, voffB); PG8_STAGE(PG8_SB(0, 1), b2 + hstep, voffB); PG8_STAGE(PG8_SA(0, 0), a2, voffA);
            PG8_WAIT_V(8); PG8_WAIT_L(0); PG8_BAR; PG8_MMA(1, 0, At, B0); PG8_MMA(1, 1, At, B1); PG8_BAR; PG8_SCHED;
            PG8_LDB(B0, 1, 0); PG8_LDB(B1, 1, 1); PG8_SCHED; PG8_LDA(At, 1, 0); PG8_STAGE(PG8_SA(0, 1), a2 + hstep, voffA);
            PG8_WAIT_V(8); PG8_WAIT_L(0); PG8_BAR; PG8_MMA(0, 0, At, B0); PG8_MMA(0, 1, At, B1); PG8_BAR; PG8_SCHED;
            PG8_LDA(At, 1, 1); PG8_STAGE(PG8_SB(1, 0), b3, voffB); PG8_STAGE(PG8_SB(1, 1), b3 + hstep, voffB); PG8_STAGE(PG8_SA(1, 0), a3, voffA);
            PG8_WAIT_V(8); PG8_WAIT_L(0); PG8_BAR; PG8_MMA(1, 0, At, B0); PG8_MMA(1, 1, At, B1); PG8_BAR; PG8_SCHED;
            } else {
            PG8_LDB(B0, 0, 0); PG8_SCHED; PG8_LDA(At, 0, 0); PG8_STAGE(PG8_SA(1, 1), a1 + hstep, voffA);
            PG8_WAIT_L(8); PG8_BAR; PG8_WAIT_L(0); PG8_MMA(0, 0, At, B0); PG8_BAR; PG8_SCHED;
            PG8_LDB(B1, 0, 1); PG8_STAGE(PG8_SB(0, 0), b2, voffB);
            PG8_BAR; PG8_WAIT_L(0); PG8_MMA(0, 1, At, B1); PG8_BAR;
            PG8_LDA(At, 0, 1); PG8_STAGE(PG8_SA(0, 0), a2, voffA);
            PG8_BAR; PG8_WAIT_L(0); PG8_MMA(1, 0, At, B0); PG8_BAR; PG8_SCHED;
            PG8_STAGE(PG8_SB(0, 1), b2 + hstep, voffB);
            PG8_WAIT_V(6); PG8_BAR; PG8_MMA(1, 1, At, B1); PG8_BAR;
            PG8_LDB(B0, 1, 0); PG8_SCHED; PG8_LDA(At, 1, 0); PG8_STAGE(PG8_SA(0, 1), a2 + hstep, voffA);
            PG8_WAIT_L(8); PG8_BAR; PG8_WAIT_L(0); PG8_MMA(0, 0, At, B0); PG8_BAR; PG8_SCHED;
            PG8_LDB(B1, 1, 1); PG8_STAGE(PG8_SB(1, 0), b3, voffB);
            PG8_BAR; PG8_WAIT_L(0); PG8_MMA(0, 1, At, B1); PG8_BAR;
            PG8_LDA(At, 1, 1); PG8_STAGE(PG8_SA(1, 0), a3, voffA);
            PG8_BAR; PG8_WAIT_L(0); PG8_MMA(1, 0, At, B0); PG8_BAR; PG8_SCHED;
            PG8_STAGE(PG8_SB(1, 1), b3 + hstep, voffB);
            PG8_WAIT_V(6); PG8_BAR; PG8_MMA(1, 1, At, B1); PG8_BAR;
            }
        }
        if constexpr (ALIGN_EPI) { if (wr == 0) PG8_BAR; }
        if constexpr (!Epi::AFTER_DRAIN) { E(acc, cur, wr, wc, fr, fq); S.done(cur); }
        if (!has_next) break;
#pragma unroll
        for (int a = 0; a < 2; ++a)
#pragma unroll
            for (int b = 0; b < 2; ++b)
#pragma unroll
                for (int m = 0; m < 4; ++m)
#pragma unroll
                    for (int n = 0; n < 2; ++n) acc[a][b][m][n] = (f32x4){0.f, 0.f, 0.f, 0.f};
        cur = nxt; cA = nA; cB = nB; ++ui;
        if constexpr (ALIGN_EPI) { if (wr == 1) PG8_BAR; }
    }
    PG8_WAIT_V(0);
    if constexpr (!ALIGN_EPI) { if (wr == 0) PG8_BAR; }
    PG8_BAR;
    if constexpr (Epi::AFTER_DRAIN) { E.fused(acc, cur, wr, wc, fr, fq, lds, wid, lane); S.done(cur); }
#undef PG8_SA
#undef PG8_SB
#undef PG8_STAGE
#undef PG8_LDA
#undef PG8_LDB
#undef PG8_MMA
#undef PG8_WAIT_V
#undef PG8_WAIT_L
#undef PG8_BAR
#undef PG8_SCHED
}
}

#ifndef PG8_SP2
#define PG8_SP2 true
#endif
#ifndef PG8_ALIGN
#define PG8_ALIGN true
#endif
#include <hip/hip_bf16.h>
#include <cmath>
namespace attn_body {
using bf16=__hip_bfloat16;
using bf16x8=__attribute__((ext_vector_type(8)))short;
using s16x4=__attribute__((ext_vector_type(4)))short;
using f32x16=__attribute__((ext_vector_type(16)))float;
using u32x4=__attribute__((ext_vector_type(4)))unsigned;
constexpr int SEQ=2048,D=64,DM=1024;
constexpr int NW=8,QBLK=32,QB=QBLK*NW,KVBLK=64,NQB=SEQ/QB;
constexpr int ATTN_PITCH=DM, ATTN_UNIT_ROWS=QB;
__device__ __forceinline__ int crow(int r,int hi){return (r&3)+8*(r>>2)+4*hi;}
#define SBAR() __builtin_amdgcn_sched_barrier(0)
__device__ __forceinline__ void cmask(f32x16&p0,f32x16&p1,int jb,int qrel,int hi){
  const float NEG=-INFINITY; int kb=64*jb+4*hi;
  #pragma unroll
  for(int r=0;r<16;++r){int kv=kb+(r&3)+8*(r>>2); if(kv>qrel)p0[r]=NEG; if(kv+32>qrel)p1[r]=NEG;}
}

constexpr int NSLOT=3, SLOTB=8192;
constexpr int LDS_K=0, LDS_V=NSLOT*SLOTB, LDS_WS=2*NSLOT*SLOTB, LDS_OST=LDS_WS+NW*64*4, LDS_BYTES=LDS_OST+NW*4096;
constexpr float C2=0.125f*1.4426950408889634f;
__device__ __forceinline__ void glds16(const void*gsrc,unsigned lds_dst){unsigned keep;
  asm volatile("s_mov_b32 %0, m0\n\ts_mov_b32 m0, %2\n\ts_nop 0\n\tglobal_load_lds_dwordx4 %1, off\n\ts_mov_b32 m0, %0":"=&s"(keep):"v"(gsrc),"s"(lds_dst):"memory");}
__device__ __forceinline__ float max3f(float a,float b,float c){float r;asm("v_max3_f32 %0, %1, %2, %3":"=v"(r):"v"(a),"v"(b),"v"(c));return r;}
__device__ __forceinline__ float max2f(float a,float b){float r;asm("v_max_f32_e32 %0, %1, %2":"=v"(r):"v"(a),"v"(b));return r;}
__device__ __forceinline__ float fadd_s(float a,float b){float r;asm("v_add_f32_e32 %0, %1, %2":"=v"(r):"v"(a),"v"(b));return r;}
__device__ __forceinline__ float fsub_s(float a,float b){float r;asm("v_sub_f32_e32 %0, %1, %2":"=v"(r):"v"(a),"v"(b));return r;}
typedef float f32x2_t __attribute__((ext_vector_type(2))); typedef __bf16 bf16x2_t __attribute__((ext_vector_type(2)));
__device__ __forceinline__ unsigned cvtpk_s(float lo,float hi){f32x2_t v={lo,hi};bf16x2_t b=__builtin_convertvector(v,bf16x2_t);return __builtin_bit_cast(unsigned,b);}
#define WAIT_BAR(N) asm volatile("s_waitcnt vmcnt(" #N ") lgkmcnt(0)\n\ts_barrier":::"memory")

__device__ __forceinline__ void qkt(f32x16&p0,f32x16&p1,const char*Kslot,const bf16x8*qr,const f32x16&negm,int r32,int hi){
  const char*kb=Kslot+hi*1024+r32*16;
  #pragma unroll
  for(int d0=0;d0<4;++d0){
    const bf16x8 b0=*reinterpret_cast<const bf16x8*>(kb+d0*2048);
    const bf16x8 b1=*reinterpret_cast<const bf16x8*>(kb+d0*2048+512);
    if(d0==0){p0=__builtin_amdgcn_mfma_f32_32x32x16_bf16(b0,qr[0],negm,0,0,0);p1=__builtin_amdgcn_mfma_f32_32x32x16_bf16(b1,qr[0],negm,0,0,0);}
    else{p0=__builtin_amdgcn_mfma_f32_32x32x16_bf16(b0,qr[d0],p0,0,0,0);p1=__builtin_amdgcn_mfma_f32_32x32x16_bf16(b1,qr[d0],p1,0,0,0);}}
}
typedef __attribute__((address_space(3))) const char* lds_cptr;
typedef short v4i16_t __attribute__((ext_vector_type(4)));
__device__ __forceinline__ void kload8(bf16x8*kf,lds_cptr kp){
  kf[0]=*(const __attribute__((address_space(3))) bf16x8*)(kp);      kf[1]=*(const __attribute__((address_space(3))) bf16x8*)(kp+512);
  kf[2]=*(const __attribute__((address_space(3))) bf16x8*)(kp+2048); kf[3]=*(const __attribute__((address_space(3))) bf16x8*)(kp+2560);
  kf[4]=*(const __attribute__((address_space(3))) bf16x8*)(kp+4096); kf[5]=*(const __attribute__((address_space(3))) bf16x8*)(kp+4608);
  kf[6]=*(const __attribute__((address_space(3))) bf16x8*)(kp+6144); kf[7]=*(const __attribute__((address_space(3))) bf16x8*)(kp+6656);
}
__device__ __forceinline__ void kload2(bf16x8*kf,lds_cptr kp,int j){ kf[2*j]=*(const __attribute__((address_space(3))) bf16x8*)(kp+j*2048); kf[2*j+1]=*(const __attribute__((address_space(3))) bf16x8*)(kp+j*2048+512); }
__device__ __forceinline__ s16x4 vtr(lds_cptr p){ return __builtin_bit_cast(s16x4,__builtin_amdgcn_ds_read_tr16_b64_v4i16((__attribute__((address_space(3))) v4i16_t*)p)); }
__device__ __forceinline__ float rowmax2(const f32x16&p0,const f32x16&p1,float k32){
  float a=max3f(p0[0],p0[1],p0[2]),b=max3f(p1[0],p1[1],p1[2]);
  #pragma unroll
  for(int r=3;r<15;r+=2){a=max3f(a,p0[r],p0[r+1]);b=max3f(b,p1[r],p1[r+1]);}
  a=max2f(a,p0[15]);b=max2f(b,p1[15]);
  const float m=max2f(a,fadd_s(b,k32));
  auto rr=__builtin_amdgcn_permlane32_swap(__float_as_uint(m),__float_as_uint(m),false,false);
  return max2f(__uint_as_float(rr[0]),__uint_as_float(rr[1]));
}
__device__ __forceinline__ float rowmax(const f32x16&p0,const f32x16&p1){
  float a=max3f(p0[0],p0[1],p1[0]),b=max3f(p0[2],p0[3],p1[1]);a=max3f(a,p1[2],p1[3]);
  #pragma unroll
  for(int r=4;r<16;r+=4){a=max3f(a,p0[r],p0[r+1]);b=max3f(b,p0[r+2],p0[r+3]);a=max3f(a,p1[r],p1[r+1]);b=max3f(b,p1[r+2],p1[r+3]);}
  const float m=max2f(a,b);
  auto rr=__builtin_amdgcn_permlane32_swap(__float_as_uint(m),__float_as_uint(m),false,false);
  return max2f(__uint_as_float(rr[0]),__uint_as_float(rr[1]));
}
__device__ __forceinline__ void pv(f32x16*o,int vb,bf16x8 pa0,bf16x8 pa1,bf16x8 pa2,bf16x8 pa3){
  #pragma unroll
  for(int d0=0;d0<2;++d0){s16x4 lo[4],hi[4];
    #pragma unroll
    for(int ks=0;ks<4;++ks){
      asm volatile("ds_read_b64_tr_b16 %0,%1 offset:%c2":"=&v"(lo[ks]):"v"(vb),"i"(d0*4096+ks*1024):"memory");
      asm volatile("ds_read_b64_tr_b16 %0,%1 offset:%c2":"=&v"(hi[ks]):"v"(vb),"i"(d0*4096+ks*1024+512):"memory");}
    asm volatile("s_waitcnt lgkmcnt(0)":::"memory");SBAR();
    #define PK(k) (bf16x8){lo[k][0],lo[k][1],lo[k][2],lo[k][3],hi[k][0],hi[k][1],hi[k][2],hi[k][3]}
    o[d0]=__builtin_amdgcn_mfma_f32_32x32x16_bf16(pa0,PK(0),o[d0],0,0,0);
    o[d0]=__builtin_amdgcn_mfma_f32_32x32x16_bf16(pa1,PK(1),o[d0],0,0,0);
    o[d0]=__builtin_amdgcn_mfma_f32_32x32x16_bf16(pa2,PK(2),o[d0],0,0,0);
    o[d0]=__builtin_amdgcn_mfma_f32_32x32x16_bf16(pa3,PK(3),o[d0],0,0,0);
    #undef PK
  }
}

#ifndef ATTN_STORE16
#define ATTN_STORE16(p,v) (*(u32x4*)(p)=(v))
#endif
template<int THRL> __device__ __forceinline__ void attn_unit(int b,int h,int qb,const bf16*Q,const bf16*__restrict__ K,const bf16*__restrict__ V,bf16*O,float sl2,char*shm,int tid_in){
  const int tid=tid_in,lane=tid&63,r32=lane&31,hi=lane>>5; const int wid=__builtin_amdgcn_readfirstlane(tid>>6);
  const long rowbase=(long)b*SEQ; const int q0=qb*QB;
  const bf16*Qw=Q+(rowbase+q0+wid*QBLK)*DM+h*D;
  const bf16*Kh=K+rowbase*DM+h*D,*Vh=V+rowbase*DM+h*D;
  const unsigned lds0=(unsigned)(uintptr_t)shm;
  float*wsf=(float*)(shm+LDS_WS)+wid*64;
  const bf16*ksrc=Kh+(long)lane*DM+wid*8;
  const bf16*vsrc=Vh+(long)(16*(wid&3)+(lane>>2))*DM+(wid>>2)*32+(lane&3)*8;
  const unsigned kdst=lds0+LDS_K+wid*1024, vdst=lds0+LDS_V+wid*1024;
  #define DMA_K(t,slot) glds16(ksrc+(long)(t)*KVBLK*DM,(unsigned)__builtin_amdgcn_readfirstlane(kdst+(slot)))
  #define DMA_V(t,slot) glds16(vsrc+(long)(t)*KVBLK*DM,(unsigned)__builtin_amdgcn_readfirstlane(vdst+(slot)))
  const int vb0=(int)(lds0+LDS_V)+((lane>>4)&1)*32+(lane&3)*8+(4*hi+((lane&15)>>2))*64;
  const char*Kbase=shm+LDS_K; bf16x8 kf[8];
  const lds_cptr shm3=(lds_cptr)shm; const lds_cptr kp0=shm3+LDS_K+hi*1024+r32*16; const lds_cptr vp0=shm3+LDS_V+((lane>>4)&1)*32+(lane&3)*8+(4*hi+((lane&15)>>2))*64;
  const int NT=(q0+QB)/KVBLK;
  DMA_K(0,0);DMA_V(0,0);DMA_K(1,SLOTB);
  bf16x8 qr[4];
  #pragma unroll
  for(int d0=0;d0<4;++d0)qr[d0]=*reinterpret_cast<const bf16x8*>(&Qw[(long)r32*DM+d0*16+hi*8]);
  float mhat=0.f,l_reg=0.f;f32x16 o[2];o[0]=f32x16{};o[1]=f32x16{};const float k32=32.f*sl2,k64=64.f*sl2; f32x16 negm; { const float lb=sl2*(float)(4*hi-(q0+wid*QBLK+r32)); _Pragma("unroll") for(int r=0;r<16;++r)negm[r]=sl2*(float)((r&3)+8*(r>>2))+lb; } asm volatile("":"+v"(negm));
  const int qrel=wid*QBLK+r32;
  #define CMASK(P0,P1,t) do{int jb_=(t)-(NT-4); if(jb_>=0)cmask(P0,P1,jb_,qrel,hi);}while(0)
  bool resc=false;
  #define START(P0,P1) do{ const float rm=rowmax2(P0,P1,k32); resc=false; \
    { const float dl=max2f(rm,0.f),dl1=fsub_s(dl,k32); mhat=fadd_s(mhat,dl); \
      _Pragma("unroll") for(int r=0;r<16;++r){P0[r]=fsub_s(P0[r],dl);P1[r]=fsub_s(P1[r],dl1);} \
      _Pragma("unroll") for(int r=0;r<16;++r)negm[r]=fadd_s(negm[r],fsub_s(k64,dl)); asm volatile("":"+v"(negm)); } \
    _Pragma("unroll") for(int r=0;r<16;++r)P0[r]=__builtin_amdgcn_exp2f(P0[r]); }while(0)
  #define RESC() do{ if(resc){ asm volatile("s_waitcnt lgkmcnt(0)":::"memory"); \
      _Pragma("unroll") for(int d_=0;d_<2;++d_) _Pragma("unroll") for(int r=0;r<16;++r)o[d_][r]*=wsf[crow(r,hi)]; } }while(0)
  f32x16 pA0,pA1,pB0,pB1;
  int sl_prev=0,sl_cur=0,sl_next=SLOTB;
  #define ROT() do{sl_prev=sl_cur;sl_cur=sl_next;sl_next=(sl_next==(NSLOT-1)*SLOTB)?0:sl_next+SLOTB;}while(0)
  DMA_K(2,2*SLOTB);
  WAIT_BAR(3);
  qkt(pA0,pA1,Kbase,qr,negm,r32,hi);asm volatile("s_nop 15\n\ts_nop 7":"+v"(pA0),"+v"(pA1));CMASK(pA0,pA1,0);
  START(pA0,pA1);
  _Pragma("unroll") for(int r=0;r<16;++r)pA1[r]=__builtin_amdgcn_exp2f(pA1[r]);
  WAIT_BAR(0);
  DMA_K(3,0);DMA_V(1,SLOTB);
  ROT();
  kload8(kf,kp0+sl_cur);
  WAIT_BAR(2);
  s16x4 vlo[8],vhi[8]; u32x4 pw0,pw1,pw2,pw3;
  #define PKW(P,B) cvtpk_s(P[B],P[B+1])
  #define PAF(k) __builtin_bit_cast(bf16x8,pw##k)
  #define VFR(i) (bf16x8){vlo[i][0],vlo[i][1],vlo[i][2],vlo[i][3],vhi[i][0],vhi[i][1],vhi[i][2],vhi[i][3]}
  #define PIN(x) asm volatile("":"+v"(x))
  #define MX3(a,b,c) __builtin_fmaxf(__builtin_fmaxf((a),(b)),(c))
  #define GAPA(MF,A0,A1,A2,A3,W0,W1,PW) do{ MF; sacc+=A0; sacc+=A1; sacc+=A2; sacc+=A3; PIN(sacc); W0; W1; PIN(PW); SBAR(); }while(0)
  #define EX(v) __builtin_amdgcn_exp2f(v)
  #define GAPB(MF,X,B) do{ MF; X[B]=EX(X[B]); X[B+1]=EX(X[B+1]); X[B+2]=EX(X[B+2]); X[B+3]=EX(X[B+3]); PIN(X); SBAR(); }while(0)
  #define GAPB1(MF,X,B) do{ MF; X[B]=EX(X[B]+k32); X[B+1]=EX(X[B+1]+k32); X[B+2]=EX(X[B+2]+k32); X[B+3]=EX(X[B+3]+k32); PIN(X); SBAR(); }while(0)
  #define VRD(i) do{ vlo[i]=vtr(vp_+(((i)>>2)*4096+((i)&3)*1024)); vhi[i]=vtr(vp_+(((i)>>2)*4096+((i)&3)*1024+512)); }while(0)
  #define KRD(G,j) do{ if(G){ kload2(kf,kp0+sl_next,j); SBAR(); } }while(0)
  #define STEP(C0,C1,P0,P1,t,GK,GV,GL) do{ SBAR(); \
    const lds_cptr vp_=vp0+sl_prev; \
    VRD(0); SBAR(); float sacc=(P0[0]+P0[1]); \
    GAPA(C0=__builtin_amdgcn_mfma_f32_32x32x16_bf16(kf[0],qr[0],negm,0,0,0), P0[2],P0[3],P0[4],P0[5],     pw0[0]=PKW(P0,0), pw0[1]=PKW(P0,2), pw0); \
    VRD(4); SBAR(); GAPA(C1=__builtin_amdgcn_mfma_f32_32x32x16_bf16(kf[1],qr[0],negm,0,0,0), P0[6],P0[7],P0[8],P0[9],     pw0[2]=PKW(P0,4), pw0[3]=PKW(P0,6), pw0); \
    VRD(1); SBAR(); GAPA(C0=__builtin_amdgcn_mfma_f32_32x32x16_bf16(kf[2],qr[1],C0,0,0,0),   P0[10],P0[11],P0[12],P0[13], pw1[0]=PKW(P0,8), pw1[1]=PKW(P0,10), pw1); \
    VRD(5); SBAR(); GAPA(C1=__builtin_amdgcn_mfma_f32_32x32x16_bf16(kf[3],qr[1],C1,0,0,0),   P0[14],P0[15],P1[0],P1[1],   pw1[2]=PKW(P0,12),pw1[3]=PKW(P0,14), pw1); \
    VRD(2); SBAR(); GAPA(C0=__builtin_amdgcn_mfma_f32_32x32x16_bf16(kf[4],qr[2],C0,0,0,0),   P1[2],P1[3],P1[4],P1[5],     pw2[0]=PKW(P1,0), pw2[1]=PKW(P1,2), pw2); \
    VRD(6); SBAR(); GAPA(C1=__builtin_amdgcn_mfma_f32_32x32x16_bf16(kf[5],qr[2],C1,0,0,0),   P1[6],P1[7],P1[8],P1[9],     pw2[2]=PKW(P1,4), pw2[3]=PKW(P1,6), pw2); \
    VRD(3); SBAR(); GAPA(C0=__builtin_amdgcn_mfma_f32_32x32x16_bf16(kf[6],qr[3],C0,0,0,0),   P1[10],P1[11],P1[12],P1[13], pw3[0]=PKW(P1,8), pw3[1]=PKW(P1,10), pw3); \
    VRD(7); SBAR(); GAPA(C1=__builtin_amdgcn_mfma_f32_32x32x16_bf16(kf[7],qr[3],C1,0,0,0),   P1[14],P1[15],0.f,0.f,       pw3[2]=PKW(P1,12),pw3[3]=PKW(P1,14), pw3); \
    l_reg+=sacc; \
    if(GK){DMA_K((t)+3,sl_cur);} if(GV){DMA_V((t)+1,sl_next);} \
    CMASK(C0,C1,t); \
    { float a=MX3(C0[0],C0[1],C0[2]),b=MX3(C1[0],C1[1],C1[2]); \
      _Pragma("unroll") for(int r=3;r<15;r+=2){a=MX3(a,C0[r],C0[r+1]);b=MX3(b,C1[r],C1[r+1]);} \
      a=__builtin_fmaxf(a,C0[15]); b=__builtin_fmaxf(b,C1[15]); \
      float rm=__builtin_fmaxf(a,b+k32); { auto rr=__builtin_amdgcn_permlane32_swap(__float_as_uint(rm),__float_as_uint(rm),false,false); rm=__builtin_fmaxf(__uint_as_float(rr[0]),__uint_as_float(rr[1])); } \
      resc=false; float tadv=k64; \
      if(__builtin_expect(__any(rm>(float)THRL),0)){ const float dl=__builtin_fmaxf(rm,0.f); mhat+=dl; tadv=k64-dl; \
        _Pragma("unroll") for(int r=0;r<16;++r){C0[r]-=dl;C1[r]-=dl;} \
        const float f=__builtin_amdgcn_exp2f(-dl); l_reg*=f; if(hi==0)wsf[r32]=f; resc=true; } \
      _Pragma("unroll") for(int r=0;r<16;++r)negm[r]+=tadv; asm volatile("":"+v"(negm)); } \
    SBAR(); \
    GAPB(o[0]=__builtin_amdgcn_mfma_f32_32x32x16_bf16(PAF(0),VFR(0),o[0],0,0,0), C0,0); \
    GAPB(o[1]=__builtin_amdgcn_mfma_f32_32x32x16_bf16(PAF(0),VFR(4),o[1],0,0,0), C0,4); \
    KRD(GL,0); GAPB(o[0]=__builtin_amdgcn_mfma_f32_32x32x16_bf16(PAF(1),VFR(1),o[0],0,0,0), C0,8); \
    KRD(GL,1); GAPB(o[1]=__builtin_amdgcn_mfma_f32_32x32x16_bf16(PAF(1),VFR(5),o[1],0,0,0), C0,12); \
    KRD(GL,2); GAPB1(o[0]=__builtin_amdgcn_mfma_f32_32x32x16_bf16(PAF(2),VFR(2),o[0],0,0,0), C1,0); \
    KRD(GL,3); GAPB1(o[1]=__builtin_amdgcn_mfma_f32_32x32x16_bf16(PAF(2),VFR(6),o[1],0,0,0), C1,4); \
    GAPB1(o[0]=__builtin_amdgcn_mfma_f32_32x32x16_bf16(PAF(3),VFR(3),o[0],0,0,0), C1,8); \
    GAPB1(o[1]=__builtin_amdgcn_mfma_f32_32x32x16_bf16(PAF(3),VFR(7),o[1],0,0,0), C1,12); \
    }while(0)
  int t=1;
  #undef CMASK
  #define CMASK(P0,P1,t) do{}while(0)
  for(;t+5<NT;t+=2){
    STEP(pB0,pB1,pA0,pA1,t,true,true,true);     WAIT_BAR(2); RESC(); ROT();
    STEP(pA0,pA1,pB0,pB1,t+1,true,true,true);   WAIT_BAR(2); RESC(); ROT();
  }
  #undef CMASK
  #define CMASK(P0,P1,t) do{int jb_=(t)-(NT-4); if(jb_>=0)cmask(P0,P1,jb_,qrel,hi);}while(0)
  #define ENDW(tt) do{ if((tt)+3<NT){WAIT_BAR(2);} else if((tt)+2<NT){WAIT_BAR(1);} else {WAIT_BAR(0);} }while(0)
  for(;t+1<NT;t+=2){
    STEP(pB0,pB1,pA0,pA1,t,(t+3<NT),(t+1<NT),(t+1<NT));       ENDW(t);   RESC(); ROT();
    STEP(pA0,pA1,pB0,pB1,t+1,(t+4<NT),(t+2<NT),(t+2<NT));     ENDW(t+1); RESC(); ROT();
  }
  STEP(pB0,pB1,pA0,pA1,NT-1,false,false,false); RESC();
  { float sacc=pB0[0]+pB0[1]; _Pragma("unroll") for(int r=2;r<16;++r)sacc+=pB0[r]; _Pragma("unroll") for(int r=0;r<16;++r)sacc+=pB1[r]; l_reg+=sacc;
    pw0=(u32x4){PKW(pB0,0),PKW(pB0,2),PKW(pB0,4),PKW(pB0,6)};pw1=(u32x4){PKW(pB0,8),PKW(pB0,10),PKW(pB0,12),PKW(pB0,14)};pw2=(u32x4){PKW(pB1,0),PKW(pB1,2),PKW(pB1,4),PKW(pB1,6)};pw3=(u32x4){PKW(pB1,8),PKW(pB1,10),PKW(pB1,12),PKW(pB1,14)};
    SBAR(); pv(o,vb0+sl_cur,PAF(0),PAF(1),PAF(2),PAF(3)); }
  #undef PKW
  #undef PAF
  #undef VFR
  #undef PIN
  #undef MX3
  #undef GAPA
  #undef GAPB
  #undef GAPB1
  #undef EX
  #undef VRD
  #undef KRD
  #undef STEP
  #undef ENDW
  {auto rr=__builtin_amdgcn_permlane32_swap(__float_as_uint(l_reg),__float_as_uint(l_reg),false,false);l_reg=__uint_as_float(rr[0])+__uint_as_float(rr[1]);}
  if(hi==0)wsf[32+r32]=l_reg;asm volatile("s_waitcnt lgkmcnt(0)":::"memory");
  float rli[16];
  #pragma unroll
  for(int r=0;r<16;++r)rli[r]=__builtin_amdgcn_rcpf(wsf[32+crow(r,hi)]);
  bf16*Ow=O+(rowbase+q0+wid*QBLK)*DM+h*D;
  { bf16*stg=(bf16*)(shm+LDS_OST)+wid*2048;
    #pragma unroll
    for(int r=0;r<16;++r){const int orow=crow(r,hi);
      #pragma unroll
      for(int d0=0;d0<2;++d0)stg[orow*64+d0*32+r32]=__float2bfloat16(o[d0][r]*rli[r]);}
    asm volatile("s_waitcnt lgkmcnt(0)":::"memory");
    #pragma unroll
    for(int i=0;i<4;++i){const int row=i*8+(lane>>3),ch=lane&7; const u32x4 v=*(const u32x4*)(stg+row*64+ch*8); ATTN_STORE16(Ow+(long)row*DM+ch*8,v);} }
  asm volatile("s_waitcnt lgkmcnt(0)\n\ts_barrier":::"memory");
  #undef DMA_K
  #undef DMA_V
  #undef CMASK
  #undef START
  #undef RESC
  #undef ROT
}
constexpr int ATTN_LDS_BYTES=LDS_BYTES;
#undef SBAR
#undef WAIT_BAR
}
#define GAS __attribute__((address_space(1)))
#define LAS __attribute__((address_space(3)))
typedef unsigned short bf16;
typedef unsigned v4u __attribute__((ext_vector_type(4)));
typedef float f32x4 __attribute__((ext_vector_type(4)));
typedef short bf16x8 __attribute__((ext_vector_type(8)));
typedef GAS unsigned gu32;
typedef GAS unsigned long long gu64;
#define RLX_AGENT __ATOMIC_RELAXED, __HIP_MEMORY_SCOPE_AGENT
#define LDS_WAIT() asm volatile("s_waitcnt lgkmcnt(0)" ::: "memory")
#define VM_WAIT() asm volatile("s_waitcnt vmcnt(0)" ::: "memory")
__device__ __forceinline__ unsigned long long rt() { return __builtin_amdgcn_s_memrealtime(); }
typedef float hw_f32x2 __attribute__((ext_vector_type(2))); typedef __bf16 hw_bf16x2 __attribute__((ext_vector_type(2)));
__device__ __forceinline__ unsigned pk2(float lo, float hi) { const hw_f32x2 v = {lo, hi}; return __builtin_bit_cast(unsigned, __builtin_convertvector(v, hw_bf16x2)); }
__device__ __forceinline__ unsigned f2bf(float f) { return pk2(f, 0.f) & 0xffffu; }

#define XB_TMO      128
#define XB_XCNT(j)  (256  + 64 * (j))
#define XB_XSUB(j)  (1280 + 64 * (j))
#define XB_XGEN(j)  (2304 + 64 * (j))
#define XB_TOP      3328
#define XB_TOPGEN   3392
#define XCD_BAR_WORDS 3456
#define XB_SPIN_CAP (1u << 18)

__device__ __forceinline__ unsigned xb_ld(unsigned* p)              { return __hip_atomic_load(p, __ATOMIC_RELAXED, __HIP_MEMORY_SCOPE_AGENT); }
__device__ __forceinline__ unsigned xb_add(unsigned* p, unsigned v) { return __hip_atomic_fetch_add(p, v, __ATOMIC_RELAXED, __HIP_MEMORY_SCOPE_AGENT); }
__device__ __forceinline__ unsigned xb_xcc_id() { return (unsigned)__builtin_amdgcn_s_getreg((3 << 11) | 20) & 0xFu; }
#define XB_SPIN(cond, bar) do { unsigned _sp = 0; while (cond) { __builtin_amdgcn_s_sleep(1); \
    if ((++_sp & 255u) == 0u) { if (xb_ld(&(bar)[XB_TMO])) break; if (_sp > XB_SPIN_CAP) { atomicAdd(&(bar)[XB_TMO], 1u); break; } } } } while (0)

struct XcdBarrier {
    unsigned* bar; unsigned x;
    volatile LAS unsigned* st;
};

__device__ __forceinline__ XcdBarrier xcd_barrier_post(unsigned* bar, volatile LAS unsigned* st, bool leader) {
    XcdBarrier b; b.bar = bar; b.x = xb_xcc_id(); b.st = st;
    if (leader) (void)xb_add(&bar[XB_XCNT(b.x)], 1u);
    return b;
}
__device__ __forceinline__ void xcd_barrier_complete(unsigned* bar, unsigned x, unsigned& nloc, unsigned& nx) {
    const unsigned G = gridDim.x * gridDim.y * gridDim.z;
    unsigned sum, cnt, mine, sp = 0u;
    for (;;) {
        sum = 0u; cnt = 0u; mine = 0u;
#pragma unroll
        for (unsigned j = 0; j < 16; ++j) { const unsigned c = xb_ld(&bar[XB_XCNT(j)]); sum += c; cnt += (c > 0u) ? 1u : 0u; mine = (j == x) ? c : mine; }
        if (sum == G) break;
        __builtin_amdgcn_s_sleep(1);
        if ((++sp & 255u) == 0u) { if (xb_ld(&bar[XB_TMO])) break; if (sp > XB_SPIN_CAP) { atomicAdd(&bar[XB_TMO], 1u); break; } }
    }
    nloc = mine > 0u ? mine : 1u; nx = cnt > 0u ? cnt : 1u;
}

__device__ __forceinline__ void xcd_barrier(const XcdBarrier& b, bool leader) {
    asm volatile("s_waitcnt vmcnt(0)" ::: "memory");
    __syncthreads();
    if (leader) {
        unsigned* bar = b.bar;
        __builtin_amdgcn_s_waitcnt(0);
        unsigned nloc = b.st[0], nx = b.st[1];
        if (nloc == 0u) { xcd_barrier_complete(bar, b.x, nloc, nx); b.st[0] = nloc; b.st[1] = nx; }
        const unsigned old = xb_add(&bar[XB_XSUB(b.x)], 1u);
        const unsigned gen = old / nloc;
        if (old + 1u == (gen + 1u) * nloc) {
            __builtin_amdgcn_fence(__ATOMIC_RELEASE, "agent");
            asm volatile("s_waitcnt vmcnt(0)" ::: "memory");
            const unsigned og = xb_add(&bar[XB_TOP], 1u);
            const unsigned tg = og / nx;
            if (og + 1u == (tg + 1u) * nx) xb_add(&bar[XB_TOPGEN], 1u);
            else XB_SPIN(xb_ld(&bar[XB_TOPGEN]) == tg, bar);
            __builtin_amdgcn_fence(__ATOMIC_ACQUIRE, "agent");
            xb_add(&bar[XB_XGEN(b.x)], 1u);
            asm volatile("s_waitcnt vmcnt(0)" ::: "memory");
        } else {
            XB_SPIN(xb_ld(&bar[XB_XGEN(b.x)]) == gen, bar);
            __builtin_amdgcn_fence(__ATOMIC_ACQUIRE, "agent");
            asm volatile("s_waitcnt vmcnt(0)" ::: "memory");
        }
    }
    __syncthreads();
}
constexpr int DM = 2048, SEQ = 2048, NBP = 4, MP = NBP * SEQ, NBS = 8, TS = 8, MS = NBS * TS, M_ALL = MP + MS, M_PAD = 8448;
constexpr int PAST = 16384, PAGE = 128, NPAGES = PAST / PAGE;
constexpr int NH = 8, HD = 128;
constexpr int CONVD = 3072, INW = 7184, INW_PAD = 7424, FF = 5632, GU = 2 * FF;
constexpr int C_K = 1024, C_V = 2048, C_QKVB = 3072, C_Z = 6144, C_B = 7168, C_A = 7176;
constexpr float EPS = 1e-6f, LOG2E = 1.4426950408889634f, C2 = 0.125f * LOG2E;
constexpr int NWAVES = 8, NTHREADS = NWAVES * 64;
constexpr int PGU = 4, NSPLIT = NPAGES / PGU, NSP = NSPLIT + 1;
constexpr int NCHUNK_P = NBP * NH * (SEQ / 64), NCHUNK = NCHUNK_P + NBS * NH;
constexpr size_t OUT_Y = 0, OUT_KP = (size_t)M_ALL * DM, OUT_VP = OUT_KP + (size_t)MP * 1024, OUT_SSMP = OUT_VP + (size_t)MP * 1024,
                 OUT_CONVP = OUT_SSMP + (size_t)NBP * NH * 16384, OUT_KS = OUT_CONVP + (size_t)NBP * 3 * CONVD, OUT_VS = OUT_KS + (size_t)MS * 1024,
                 OUT_SSMS = OUT_VS + (size_t)MS * 1024, OUT_CONVS = OUT_SSMS + (size_t)NBS * NH * 16384, OUT_END = OUT_CONVS + (size_t)NBS * 3 * CONVD;
constexpr size_t MiB = 1u << 20;
constexpr size_t WS_CTL = 0, CTL_ZERO_BYTES = 1 * MiB;
constexpr size_t WS_W1GU = 16 * MiB, WS_W1D = 60 * MiB, WS_WIN = 82 * MiB, WS_WOUT = 111 * MiB, WS_W2GU = 119 * MiB, WS_W2D = 163 * MiB;
constexpr size_t WS_XN = 192 * MiB, WS_ACT = 226 * MiB, WS_F = 320 * MiB, WS_X1 = 388 * MiB, WS_X2 = 456 * MiB, WS_C1 = 528 * MiB, WS_H = 896 * MiB;
constexpr size_t WS_QKVB = 896 * MiB, WS_Z = 946 * MiB, WS_BA = 963 * MiB, WS_HS = 964 * MiB;
constexpr size_t WS_QB = 1136 * MiB, WS_KB = 1153 * MiB, WS_VB = 1170 * MiB;
constexpr size_t WS_UT = 1322 * MiB, WS_WC = 1356 * MiB, WS_QG = 1373 * MiB, WS_KDT = 1390 * MiB, WS_QKC = 1407 * MiB, WS_EGL = 1416 * MiB, WS_OG = 1424 * MiB, WS_O1 = 1458 * MiB, WS_O2 = 1491 * MiB, WS_MIX = 1526 * MiB, WS_PM = 1560 * MiB, WS_PL = 1561 * MiB, WS_PO = 1562 * MiB, WS_END = 1600 * MiB;
static_assert(WS_QKVB + (size_t)M_ALL * CONVD * 2 <= WS_Z && WS_Z + (size_t)M_ALL * 1024 * 2 <= WS_BA && WS_BA + (size_t)M_ALL * 16 * 4 <= WS_HS && WS_HS + (size_t)MS * INW_PAD * 4 <= WS_QB, "d_ws map 2");
static_assert(WS_W1GU + (size_t)GU * DM * 2 <= WS_W1D && WS_W1D + (size_t)DM * FF * 2 <= WS_WIN && WS_WIN + (size_t)INW_PAD * DM * 2 <= WS_WOUT && WS_WOUT + (size_t)DM * DM * 2 <= WS_W2GU &&
              WS_W2GU + (size_t)GU * DM * 2 <= WS_W2D && WS_W2D + (size_t)DM * FF * 2 <= WS_XN && WS_XN + (size_t)M_PAD * DM * 2 <= WS_ACT && WS_ACT + (size_t)M_PAD * FF * 2 <= WS_F &&
              WS_F + (size_t)M_PAD * DM * 4 <= WS_X1 && WS_X1 + (size_t)M_ALL * DM * 4 <= WS_X2 && WS_X2 + (size_t)M_ALL * DM * 4 <= WS_C1 && WS_C1 + (size_t)M_PAD * GU * 4 <= WS_H &&
              WS_H + (size_t)M_PAD * INW_PAD * 4 <= WS_QB && WS_QB + (size_t)M_PAD * 1024 * 2 <= WS_KB && WS_VB + (size_t)M_PAD * 1024 * 2 <= WS_UT && WS_UT + (size_t)NCHUNK * 8192 * 4 <= WS_WC && WS_WC + (size_t)NCHUNK * 8192 * 2 <= WS_QG && WS_QG + (size_t)NCHUNK * 8192 * 2 <= WS_KDT &&
              WS_KDT + (size_t)NCHUNK * 8192 * 2 <= WS_QKC && WS_QKC + (size_t)NCHUNK * 4096 * 2 <= WS_EGL && WS_EGL + (size_t)NCHUNK * 4 <= WS_OG && WS_OG + (size_t)M_ALL * 1024 * 4 <= WS_O1 && WS_O1 + (size_t)M_ALL * 1024 * 4 <= WS_O2 && WS_O2 + (size_t)M_ALL * 1024 * 4 <= WS_MIX &&
              WS_MIX + (size_t)M_PAD * DM * 2 <= WS_PM && WS_PO + (size_t)NBS * NH * NSP * 16 * 128 * 4 <= WS_END, "d_ws map");
constexpr int CW_QCTR = 64;
constexpr int CW_BAR = 4096;
constexpr int RING_OFF = 0, RING_BYTES = 131072, LDSCTL_OFF = RING_BYTES, LDS_BYTES = 147456, MISC_OFF = LDS_BYTES - 256;

#ifndef NT_WSTORE
#define NT_WSTORE 0
#endif
#ifndef CONV_NFAST
#define CONV_NFAST 1
#endif
#ifndef THIN_PIPE
#define THIN_PIPE 0
#endif
#ifndef CONV_PIPE
#define CONV_PIPE 1
#endif
#ifndef NT_OUT
#define NT_OUT 0
#endif
#ifndef CONV_TAILS
#define CONV_TAILS 0
#endif
#ifndef REP_PRO
#define REP_PRO 1
#endif
#ifndef REP_PREP
#define REP_PREP 1
#endif
#ifndef REP_SCAN
#define REP_SCAN 1
#endif
#ifndef REP_SATT
#define REP_SATT 1
#endif
#ifndef REP_FLASH
#define REP_FLASH 1
#endif
#ifndef REP_THIN
#define REP_THIN 1
#endif
#ifndef REP_G1
#define REP_G1 1
#endif
#ifndef MK_N_LAUNCHES
#define MK_N_LAUNCHES 1
#endif
constexpr int NPHASE = 13;

struct Args { const void* in[30]; float* out; unsigned char* ws; int ph_lo, ph_hi; };
struct Frame {
    const Args& A;
    LAS unsigned char* lds; volatile LAS unsigned* MISC; gu32* ctl; char* lds_g;
    int tid, lane, wave, G, gw, NGW, z; unsigned char* ws;
    __device__ __forceinline__ Frame(const Args& a) : A(a) {}
    __device__ __forceinline__ const float* xp() const { return (const float*)A.in[0 + z]; }
    __device__ __forceinline__ const float* xs() const { return (const float*)A.in[1 + z]; }
    __device__ __forceinline__ const float* cache_k() const { return (const float*)A.in[2 + z]; }
    __device__ __forceinline__ const float* cache_v() const { return (const float*)A.in[3 + z]; }
    __device__ __forceinline__ const float* state_ssm() const { return (const float*)A.in[4 + z]; }
    __device__ __forceinline__ const float* state_conv() const { return (const float*)A.in[5 + z]; }
    __device__ __forceinline__ const int* page_table() const { return (const int*)A.in[6 + z]; }
    __device__ __forceinline__ const float* ffn1_pre() const { return (const float*)A.in[7 + z]; }
    __device__ __forceinline__ const float* ffn1_post() const { return (const float*)A.in[8 + z]; }
    __device__ __forceinline__ const float* gate1() const { return (const float*)A.in[9 + z]; }
    __device__ __forceinline__ const float* up1() const { return (const float*)A.in[10 + z]; }
    __device__ __forceinline__ const float* down1() const { return (const float*)A.in[11 + z]; }
    __device__ __forceinline__ const float* mix_pre() const { return (const float*)A.in[12 + z]; }
    __device__ __forceinline__ const float* mix_post() const { return (const float*)A.in[13 + z]; }
    __device__ __forceinline__ const float* w_in() const { return (const float*)A.in[14 + z]; }
    __device__ __forceinline__ const float* conv_w() const { return (const float*)A.in[15 + z]; }
    __device__ __forceinline__ const float* a_log() const { return (const float*)A.in[16 + z]; }
    __device__ __forceinline__ const float* dt_bias() const { return (const float*)A.in[17 + z]; }
    __device__ __forceinline__ const float* dnorm_w() const { return (const float*)A.in[18 + z]; }
    __device__ __forceinline__ const float* lq1() const { return (const float*)A.in[19 + z]; }
    __device__ __forceinline__ const float* lk1() const { return (const float*)A.in[20 + z]; }
    __device__ __forceinline__ const float* lq2() const { return (const float*)A.in[21 + z]; }
    __device__ __forceinline__ const float* lk2() const { return (const float*)A.in[22 + z]; }
    __device__ __forceinline__ const float* subln_w() const { return (const float*)A.in[23 + z]; }
    __device__ __forceinline__ const float* w_out() const { return (const float*)A.in[24 + z]; }
    __device__ __forceinline__ const float* ffn2_pre() const { return (const float*)A.in[25 + z]; }
    __device__ __forceinline__ const float* ffn2_post() const { return (const float*)A.in[26 + z]; }
    __device__ __forceinline__ const float* gate2() const { return (const float*)A.in[27 + z]; }
    __device__ __forceinline__ const float* up2() const { return (const float*)A.in[28 + z]; }
    __device__ __forceinline__ const float* down2() const { return (const float*)A.in[29 + z]; }
    __device__ __forceinline__ float* out() const { return A.out; }
    __device__ __forceinline__ bf16* F16() const { return (bf16*)(ws + WS_C1); }
    __device__ __forceinline__ bf16* X1h() const { return (bf16*)(ws + WS_X1); }
    __device__ __forceinline__ bf16* X2h() const { return (bf16*)(ws + WS_X2); }
    __device__ __forceinline__ bf16* QKVB() const { return (bf16*)(ws + WS_QKVB); }
    __device__ __forceinline__ bf16* Zb() const { return (bf16*)(ws + WS_Z); }
    __device__ __forceinline__ float* BA() const { return (float*)(ws + WS_BA); }
    __device__ __forceinline__ float* HS() const { return (float*)(ws + WS_HS); }
    __device__ __forceinline__ float* PM() const { return (float*)(ws + WS_PM); }
    __device__ __forceinline__ float* PL() const { return (float*)(ws + WS_PL); }
    __device__ __forceinline__ float* PO() const { return (float*)(ws + WS_PO); }
    __device__ __forceinline__ bf16* W1GU() const { return (bf16*)(ws + WS_W1GU); }
    __device__ __forceinline__ bf16* W1D() const { return (bf16*)(ws + WS_W1D); }
    __device__ __forceinline__ bf16* WIN() const { return (bf16*)(ws + WS_WIN); }
    __device__ __forceinline__ bf16* WOUT() const { return (bf16*)(ws + WS_WOUT); }
    __device__ __forceinline__ bf16* W2GU() const { return (bf16*)(ws + WS_W2GU); }
    __device__ __forceinline__ bf16* W2D() const { return (bf16*)(ws + WS_W2D); }
    __device__ __forceinline__ bf16* X0h() const { return (bf16*)(ws + WS_XN); }
    __device__ __forceinline__ float* RS() const { return (float*)(ws + WS_CTL + 512 * 1024); }
    __device__ __forceinline__ bf16* ACT() const { return (bf16*)(ws + WS_ACT); }
    __device__ __forceinline__ bf16* QB() const { return (bf16*)(ws + WS_QB); }
    __device__ __forceinline__ bf16* KB() const { return (bf16*)(ws + WS_KB); }
    __device__ __forceinline__ bf16* VB() const { return (bf16*)(ws + WS_VB); }
    __device__ __forceinline__ bf16* MIX() const { return (bf16*)(ws + WS_MIX); }
    __device__ __forceinline__ bf16* O1b() const { return (bf16*)(ws + WS_O1); }
    __device__ __forceinline__ bf16* O2b() const { return (bf16*)(ws + WS_O2); }
    __device__ __forceinline__ bf16* WC() const { return (bf16*)(ws + WS_WC); }
    __device__ __forceinline__ bf16* QGc() const { return (bf16*)(ws + WS_QG); }
    __device__ __forceinline__ bf16* KDTc() const { return (bf16*)(ws + WS_KDT); }
    __device__ __forceinline__ bf16* QKc() const { return (bf16*)(ws + WS_QKC); }
    __device__ __forceinline__ float* Fb() const { return (float*)(ws + WS_F); }
    __device__ __forceinline__ float* X1() const { return (float*)(ws + WS_X1); }
    __device__ __forceinline__ float* X2() const { return (float*)(ws + WS_X2); }
    __device__ __forceinline__ float* C1() const { return (float*)(ws + WS_C1); }
    __device__ __forceinline__ float* H() const { return (float*)(ws + WS_H); }
    __device__ __forceinline__ float* UT() const { return (float*)(ws + WS_UT); }
    __device__ __forceinline__ float* EGL() const { return (float*)(ws + WS_EGL); }
    __device__ __forceinline__ bf16* OG() const { return (bf16*)(ws + WS_OG); }
};

#define LDS_BARRIER() asm volatile("s_waitcnt lgkmcnt(0)\n\ts_barrier" ::: "memory")
__device__ __forceinline__ int lane_id() { int r; asm volatile("v_mbcnt_lo_u32_b32 %0, -1, 0\n\tv_mbcnt_hi_u32_b32 %0, -1, %0" : "=v"(r)); return r; }
template <int X> __device__ __forceinline__ float xor_lane(float v) {
    if (X < 32) return __int_as_float(__builtin_amdgcn_ds_swizzle(__float_as_int(v), (X << 10) | 0x1f));
    else { auto rr = __builtin_amdgcn_permlane32_swap(__float_as_uint(v), __float_as_uint(v), false, false); return __uint_as_float(rr[0]) == v ? __uint_as_float(rr[1]) : __uint_as_float(rr[0]); }
}
__device__ __forceinline__ float xor32_sum(float v) { auto rr = __builtin_amdgcn_permlane32_swap(__float_as_uint(v), __float_as_uint(v), false, false); return __uint_as_float(rr[0]) + __uint_as_float(rr[1]); }
__device__ __forceinline__ float xor32_max(float v) { auto rr = __builtin_amdgcn_permlane32_swap(__float_as_uint(v), __float_as_uint(v), false, false); return fmaxf(__uint_as_float(rr[0]), __uint_as_float(rr[1])); }
__device__ __forceinline__ float sum16(float v) { v += xor_lane<1>(v); v += xor_lane<2>(v); v += xor_lane<4>(v); v += xor_lane<8>(v); return v; }
__device__ __forceinline__ float max16(float v) { v = fmaxf(v, xor_lane<1>(v)); v = fmaxf(v, xor_lane<2>(v)); v = fmaxf(v, xor_lane<4>(v)); v = fmaxf(v, xor_lane<8>(v)); return v; }
__device__ __forceinline__ float wave_sum(float v) { v = sum16(v); v += xor_lane<16>(v); return xor32_sum(v); }
__device__ __forceinline__ float wave_max(float v) { v = max16(v); v = fmaxf(v, xor_lane<16>(v)); return xor32_max(v); }
__device__ __forceinline__ float bf2f(unsigned short b) { return __uint_as_float(((unsigned)b) << 16); }
__device__ __forceinline__ float silu_f(float x) { return x * __builtin_amdgcn_rcpf(1.f + __expf(-x)); }
__device__ __forceinline__ float sigmoid_f(float x) { return __builtin_amdgcn_rcpf(1.f + __expf(-x)); }
__device__ __forceinline__ float softplus_f(float x) { return x > 20.f ? x : __logf(1.f + __expf(x)); }

struct EpiF32 {
    static constexpr bool PERM = false, AFTER_DRAIN = false;
    float* C; int ldc;
    __device__ __forceinline__ void operator()(const pg8::f32x4 (&acc)[2][2][4][2], const pg8::Unit& u, int wr, int wc, int fr, int fq) const {
        const int col0 = u.pn * pg8::BM + wc * 32 + 4 * fq;
#pragma unroll
        for (int ai = 0; ai < 2; ++ai)
#pragma unroll
            for (int m = 0; m < 4; ++m) {
                const int r = u.pm * pg8::BM + ai * pg8::HALF + wr * 64 + m * 16 + fr;
                float* rowp = C + (size_t)r * ldc + col0;
#pragma unroll
                for (int bj = 0; bj < 2; ++bj)
#pragma unroll
                    for (int n = 0; n < 2; ++n) *(pg8::f32x4*)(rowp + bj * pg8::HALF + n * 16) = acc[ai][bj][m][n];
            }
    }
};

struct EpiBf {
    static constexpr bool PERM = true, AFTER_DRAIN = false;
    bf16* O;
    __device__ __forceinline__ void operator()(const pg8::f32x4 (&acc)[2][2][4][2], const pg8::Unit& u, int wr, int wc, int fr, int fq) const {
        const int col0 = u.pn * pg8::BM + wc * 32 + 8 * fq;
#pragma unroll
        for (int ai = 0; ai < 2; ++ai)
#pragma unroll
            for (int m = 0; m < 4; ++m) { bf16* rowp = O + (size_t)(u.pm * pg8::BM + ai * pg8::HALF + wr * 64 + m * 16 + fr) * DM + col0;
#pragma unroll
                for (int bj = 0; bj < 2; ++bj) { const pg8::f32x4 v0 = acc[ai][bj][m][0], v1 = acc[ai][bj][m][1];
                    pg8::u32x4 w; w.x = pg8::cvt_pk_bf16(v0[0], v0[1]); w.y = pg8::cvt_pk_bf16(v0[2], v0[3]); w.z = pg8::cvt_pk_bf16(v1[0], v1[1]); w.w = pg8::cvt_pk_bf16(v1[2], v1[3]);
                    *(pg8::u32x4*)(rowp + bj * pg8::HALF) = w; } }
    }
};
struct EpiAct {
    static constexpr bool PERM = true, AFTER_DRAIN = false;
    bf16* O; const float* RS;
    __device__ __forceinline__ void operator()(const pg8::f32x4 (&acc)[2][2][4][2], const pg8::Unit& u, int wr, int wc, int fr, int fq) const {
        const int col0 = u.pn * 128 + wc * 32 + 8 * fq;
#pragma unroll
        for (int ai = 0; ai < 2; ++ai)
#pragma unroll
            for (int m = 0; m < 4; ++m) {
                const int r = u.pm * pg8::BM + ai * pg8::HALF + wr * 64 + m * 16 + fr;
                const float rs = RS[r];
                const pg8::f32x4 g0 = acc[ai][0][m][0] * rs, g1 = acc[ai][0][m][1] * rs, u0 = acc[ai][1][m][0] * rs, u1 = acc[ai][1][m][1] * rs;
                pg8::u32x4 w;
                w.x = pg8::cvt_pk_bf16(silu_f(g0[0]) * u0[0], silu_f(g0[1]) * u0[1]); w.y = pg8::cvt_pk_bf16(silu_f(g0[2]) * u0[2], silu_f(g0[3]) * u0[3]);
                w.z = pg8::cvt_pk_bf16(silu_f(g1[0]) * u1[0], silu_f(g1[1]) * u1[1]); w.w = pg8::cvt_pk_bf16(silu_f(g1[2]) * u1[2], silu_f(g1[3]) * u1[3]);
                *(pg8::u32x4*)(O + (size_t)r * FF + col0) = w;
            }
    }
};
struct EpiIn {
    static constexpr bool PERM = true, AFTER_DRAIN = false;
    bf16 *QBp, *KBp, *VBp, *QKVBp, *Zp; float *BAp, *out; const float* RS;
    __device__ __forceinline__ void operator()(const pg8::f32x4 (&acc)[2][2][4][2], const pg8::Unit& u, int wr, int wc, int fr, int fq) const {
        const int pn = u.pn;
#pragma unroll
        for (int ai = 0; ai < 2; ++ai)
#pragma unroll
            for (int m = 0; m < 4; ++m) {
                const int r = u.pm * pg8::BM + ai * pg8::HALF + wr * 64 + m * 16 + fr; const float rs = RS[r];
#pragma unroll
                for (int bj = 0; bj < 2; ++bj) {
                    const int c8 = pn * 256 + bj * 128 + wc * 32 + 8 * fq;
                    pg8::f32x4 v0 = acc[ai][bj][m][0] * rs, v1 = acc[ai][bj][m][1] * rs;
                    if (pn == 28) { if (c8 < C_B + 16) { *(pg8::f32x4*)(BAp + (size_t)r * 16 + (c8 - C_B)) = v0; *(pg8::f32x4*)(BAp + (size_t)r * 16 + (c8 - C_B) + 4) = v1; } continue; }
                    bf16* dst;
                    if (pn < 4) { dst = QBp + (size_t)r * 1024 + c8; v0 = v0 * C2; v1 = v1 * C2; }
                    else if (pn < 8) { dst = KBp + (size_t)r * 1024 + (c8 - C_K); float* o = out + OUT_KP + (size_t)r * 1024 + (c8 - C_K); if (NT_OUT) { __builtin_nontemporal_store(v0, (pg8::f32x4*)o); __builtin_nontemporal_store(v1, (pg8::f32x4*)(o + 4)); } else { *(pg8::f32x4*)o = v0; *(pg8::f32x4*)(o + 4) = v1; } }
                    else if (pn < 12) { dst = VBp + (size_t)r * 1024 + (c8 - C_V); float* o = out + OUT_VP + (size_t)r * 1024 + (c8 - C_V); if (NT_OUT) { __builtin_nontemporal_store(v0, (pg8::f32x4*)o); __builtin_nontemporal_store(v1, (pg8::f32x4*)(o + 4)); } else { *(pg8::f32x4*)o = v0; *(pg8::f32x4*)(o + 4) = v1; } }
                    else if (pn < 24) { dst = QKVBp + (size_t)r * CONVD + (c8 - C_QKVB); const int t = r & (SEQ - 1);
                        if (t >= SEQ - 3) { float* o = out + OUT_CONVP + (size_t)((r >> 11) * 3 + (t - (SEQ - 3))) * CONVD + (c8 - C_QKVB); *(pg8::f32x4*)o = v0; *(pg8::f32x4*)(o + 4) = v1; } }
                    else { dst = Zp + (size_t)r * 1024 + (c8 - C_Z); }
                    pg8::u32x4 w; w.x = pg8::cvt_pk_bf16(v0[0], v0[1]); w.y = pg8::cvt_pk_bf16(v0[2], v0[3]); w.z = pg8::cvt_pk_bf16(v1[0], v1[1]); w.w = pg8::cvt_pk_bf16(v1[2], v1[3]);
                    *(pg8::u32x4*)dst = w;
                }
            }
    }
};
struct SkEpiF32 { float* C; __device__ __forceinline__ float rowscale(int) const { return 1.f; } __device__ __forceinline__ void operator()(int row, int c, float v0, float, float) const { C[(size_t)row * DM + c] = v0; } };
struct SkEpiAct { bf16* O; const float* RS; __device__ __forceinline__ float rowscale(int row) const { return RS[row]; } __device__ __forceinline__ void operator()(int row, int c, float g, float u, float rs) const { O[(size_t)row * FF + c] = (bf16)f2bf(silu_f(g * rs) * (u * rs)); } };
struct SkEpiIn {
    bf16 *QBp, *KBp, *VBp, *QKVBp, *Zp; float *BAp, *out; const float* RS;
    __device__ __forceinline__ float rowscale(int row) const { return RS[row]; }
    __device__ __forceinline__ void operator()(int ms, int c, float v, float, float rs) const {
        v *= rs;
        if (c < C_K) QBp[(size_t)ms * 1024 + c] = (bf16)f2bf(v * C2);
        else if (c < C_V) { KBp[(size_t)ms * 1024 + (c - C_K)] = (bf16)f2bf(v); out[OUT_KS + (size_t)ms * 1024 + (c - C_K)] = v; }
        else if (c < C_QKVB) { VBp[(size_t)ms * 1024 + (c - C_V)] = (bf16)f2bf(v); out[OUT_VS + (size_t)ms * 1024 + (c - C_V)] = v; }
        else if (c < C_Z) { QKVBp[(size_t)ms * CONVD + (c - C_QKVB)] = (bf16)f2bf(v); const int t = ms % TS;
            if (t >= TS - 3) out[OUT_CONVS + (size_t)((ms / TS) * 3 + (t - (TS - 3))) * CONVD + (c - C_QKVB)] = v; }
        else if (c < C_B) Zp[(size_t)ms * 1024 + (c - C_Z)] = (bf16)f2bf(v);
        else if (c < INW) BAp[(size_t)ms * 16 + (c - C_B)] = v;
    }
};
struct SkEpiAddF32 { float* C; __device__ __forceinline__ float rowscale(int) const { return 1.f; } __device__ __forceinline__ void operator()(int row, int c, float v0, float, float) const { __hip_atomic_fetch_add(C + (size_t)row * DM + c, v0, __ATOMIC_RELAXED, __HIP_MEMORY_SCOPE_AGENT); } };
template <int NB, int KS, int K, class Epi, int GOFF = 128, bool PAIR = true> __device__ __forceinline__ void skinny_phase(Frame& F, const bf16* A, const bf16* Bt, int  , int ncu, const Epi& E, int wg_lo) {
    if ((int)blockIdx.x < wg_lo) return;
    int lane = lane_id(); asm volatile("" : "+v"(lane));
    constexpr int KW = K / (8 * KS), NS = KW / 32, NG = (NS + 1) / 2;
    static_assert(KW % 32 == 0, "skinny_phase: whole k-steps per wave");
    const int w = F.wave, n = lane & 15, kq = lane >> 4, tid = 64 * w + lane;
    LAS float* red = (LAS float*)(F.lds + RING_OFF);
    const int ust = F.G - wg_lo, nu = ncu * KS;
    const float rs0 = E.rowscale(tid >> 4), rs1 = E.rowscale(32 + (tid >> 4));
#define SK_PTRS(u_, bp_, ap_, c0_) do { const int cu_ = (u_) / KS, kp_ = (u_) % KS; c0_ = (PAIR ? 16 : 16 * NB) * cu_; \
        const int br0_ = (NB == 1 || !PAIR) ? c0_ : 256 * (c0_ >> 7) + (c0_ & 127);       \
        bp_ = Bt + (size_t)(br0_ + n) * K + (kp_ * 8 + w) * KW + 8 * kq; ap_ = A + (size_t)n * K + (kp_ * 8 + w) * KW + 8 * kq; } while (0)
#define SK_LOADB(bp_) do { _Pragma("unroll") for (int s_ = 0; s_ < NS; ++s_) _Pragma("unroll") for (int g = 0; g < NB; ++g) bF[s_][g] = *(const GAS bf16x8*)((bp_) + (size_t)(GOFF * g) * K + 32 * s_); } while (0)
#define SK_LOADA(buf_, ap_, s0_) do { _Pragma("unroll") for (int s2 = 0; s2 < 2; ++s2) if ((s0_) + s2 < NS) { \
        _Pragma("unroll") for (int rt = 0; rt < 4; ++rt) aG[buf_][s2][rt] = *(const GAS bf16x8*)((ap_) + (size_t)(16 * rt) * K + 32 * ((s0_) + s2)); } } while (0)
    bf16x8 bF[NS][NB], aG[2][2][4];
    int u = (int)blockIdx.x - wg_lo, c0 = 0; const bf16* bp = Bt; const bf16* ap = A;
    if (u < nu) { SK_PTRS(u, bp, ap, c0); SK_LOADB(bp); SK_LOADA(0, ap, 0); }
    while (u < nu) {
        f32x4 acc[NB][4];
#pragma unroll
        for (int g = 0; g < NB; ++g)
#pragma unroll
            for (int rt = 0; rt < 4; ++rt) acc[g][rt] = (f32x4){0.f, 0.f, 0.f, 0.f};
#pragma unroll
        for (int gi = 0; gi < NG; ++gi) {
            if (gi + 1 < NG) SK_LOADA((gi + 1) & 1, ap, 2 * (gi + 1));
#pragma unroll
            for (int s2 = 0; s2 < 2; ++s2) if (2 * gi + s2 < NS) {
#pragma unroll
                for (int rt = 0; rt < 4; ++rt)
#pragma unroll
                    for (int g = 0; g < NB; ++g) acc[g][rt] = __builtin_amdgcn_mfma_f32_16x16x32_bf16(aG[gi & 1][s2][rt], bF[2 * gi + s2][g], acc[g][rt], 0, 0, 0);
            }
        }
        const int un = u + ust, c0_cur = c0;
        if (un < nu) { SK_PTRS(un, bp, ap, c0); SK_LOADB(bp); SK_LOADA(0, ap, 0); }
#pragma unroll
        for (int g = 0; g < NB; ++g)
#pragma unroll
            for (int rt = 0; rt < 4; ++rt)
#pragma unroll
                for (int r = 0; r < 4; ++r) red[((g * 8 + w) * 64 + 16 * rt + 4 * kq + r) * 16 + n] = acc[g][rt][r];
        __syncthreads();
#pragma unroll
        for (int q = 0; q < 2; ++q) { const int o = tid + 512 * q; const float rsq = q ? rs1 : rs0; float s0 = 0.f, s1 = 0.f;
#pragma unroll
            for (int ww = 0; ww < 8; ++ww) { s0 += red[ww * 1024 + o]; if (NB == 2) s1 += red[(8 + ww) * 1024 + o]; }
            if (PAIR) E(o >> 4, c0_cur + (o & 15), s0, s1, rsq); else { E(o >> 4, c0_cur + (o & 15), s0, 0.f, rsq); if (NB == 2) E(o >> 4, c0_cur + GOFF + (o & 15), s1, 0.f, rsq); } }
        __syncthreads();
        u = un;
    }
#undef SK_PTRS
#undef SK_LOADB
#undef SK_LOADA
}
__device__ __forceinline__ void transpose_item(const float* W, int N, int k0, int n0, bf16* WT, int K, int drow0, LAS float* scr, int lane, const float* ks = nullptr) {
    const int cc = n0 + (lane & 31);
    float ld[32];
#pragma unroll
    for (int i = 0; i < 32; ++i) ld[i] = (cc < N) ? W[(size_t)(k0 + 2 * i + (lane >> 5)) * N + cc] : 0.f;
    if (ks) {
#pragma unroll
        for (int i = 0; i < 32; ++i) ld[i] *= ks[k0 + 2 * i + (lane >> 5)]; }
#pragma unroll
    for (int i = 0; i < 32; ++i) scr[(2 * i + (lane >> 5)) * 33 + (lane & 31)] = ld[i];
    LDS_WAIT(); asm volatile("" ::: "memory");
    const int c = lane & 7;
#pragma unroll
    for (int j = 0; j < 4; ++j) { const int n = (lane >> 3) + 8 * j; const LAS float* s = scr + (8 * c) * 33 + n;
        v4u o; o.x = pk2(s[0 * 33], s[1 * 33]); o.y = pk2(s[2 * 33], s[3 * 33]); o.z = pk2(s[4 * 33], s[5 * 33]); o.w = pk2(s[6 * 33], s[7 * 33]);
#if NT_WSTORE
        __builtin_nontemporal_store(o, (GAS v4u*)(WT + (size_t)(drow0 + n) * K + k0 + 8 * c)); }
#else
        *(GAS v4u*)(WT + (size_t)(drow0 + n) * K + k0 + 8 * c) = o; }
#endif
    LDS_WAIT(); asm volatile("" ::: "memory");
}
__device__ __forceinline__ void tr_gu(const float* W, bf16* WT, int half, int r, LAS float* scr, int lane) {
    constexpr int nblk = FF / 32; const int kb = r / nblk, nb = r % nblk, n0 = 32 * nb;
    transpose_item(W, FF, 64 * kb, n0, WT, DM, 256 * (n0 >> 7) + 128 * half + (n0 & 127), scr, lane);
}
__device__ __forceinline__ void tr_plain(const float* W, int K, int N, int nblk, bf16* WT, int r, LAS float* scr, int lane) {
    const int kb = r / nblk, nb = r % nblk;
    transpose_item(W, N, 64 * kb, 32 * nb, WT, K, 32 * nb, scr, lane);
}
__device__ __forceinline__ f32x4 ld_bf16x4(const bf16* p) { const unsigned long long w = *(const GAS unsigned long long*)p; const unsigned lo = (unsigned)w, hi = (unsigned)(w >> 32);
    return (f32x4){__uint_as_float(lo << 16), __uint_as_float(lo & 0xffff0000u), __uint_as_float(hi << 16), __uint_as_float(hi & 0xffff0000u)}; }
__device__ __forceinline__ void st_bf16x4(bf16* p, f32x4 v) { *(GAS unsigned long long*)p = (unsigned long long)pk2(v.x, v.y) | ((unsigned long long)pk2(v.z, v.w) << 32); }
__device__ __forceinline__ void thin_finish(Frame& F, f32x4 (&v)[8], const f32x4 (&g)[8], bool has_f, int m, float scale, const float* post_w, bf16* xout16, float* xout32, float* rs_out) {
    const int lane = F.lane;
    if (has_f) {
        float ss = 0.f;
#pragma unroll
        for (int j = 0; j < 8; ++j) ss += (g[j].x * g[j].x + g[j].y * g[j].y) + (g[j].z * g[j].z + g[j].w * g[j].w);
        const float rs = scale * rsqrtf(wave_sum(ss) * (1.f / DM) + EPS);
        const GAS f32x4* w4 = (const GAS f32x4*)post_w + lane;
#pragma unroll
        for (int j = 0; j < 8; ++j) { const f32x4 w = w4[64 * j]; v[j] = v[j] + g[j] * w * rs; }
    }
    if (xout16) {
#pragma unroll
        for (int j = 0; j < 8; ++j) st_bf16x4(xout16 + (size_t)m * DM + 4 * (64 * j + lane), v[j]); }
    if (xout32) { GAS f32x4* o4 = (GAS f32x4*)(xout32 + (size_t)m * DM) + lane;
#pragma unroll
        for (int j = 0; j < 8; ++j) { if (NT_OUT) __builtin_nontemporal_store(v[j], o4 + 64 * j); else o4[64 * j] = v[j]; } }
    if (rs_out) {
        float ss = 0.f;
#pragma unroll
        for (int j = 0; j < 8; ++j) ss += (v[j].x * v[j].x + v[j].y * v[j].y) + (v[j].z * v[j].z + v[j].w * v[j].w);
        const float rs = rsqrtf(wave_sum(ss) * (1.f / DM) + EPS);
        if (lane == 0) rs_out[m] = rs;
    }
}
__device__ __forceinline__ void thin_rows(Frame& F, const bf16* xin16, const bf16* f16, float* fs, float scale, const float* post_w, bf16* xout16, float* xout32, float* rs_out) {
    const int lane = F.lane;
    const bool pipe = THIN_PIPE && xin16 && f16;
    if (pipe) {
        typedef unsigned long long u64t;
        u64t ax[8], aq[8], bx[8], bq[8];
#define TH_LOAD(X, Q, m_) do { _Pragma("unroll") for (int j = 0; j < 8; ++j) { X[j] = *(const GAS u64t*)(xin16 + (size_t)(m_) * DM + 4 * (64 * j + lane)); Q[j] = *(const GAS u64t*)(f16 + (size_t)(m_) * DM + 4 * (64 * j + lane)); } } while (0)
#define TH_UNPK(w_) (f32x4){__uint_as_float((unsigned)(w_) << 16), __uint_as_float((unsigned)(w_) & 0xffff0000u), __uint_as_float((unsigned)((w_) >> 32) << 16), __uint_as_float((unsigned)((w_) >> 32) & 0xffff0000u)}
#define TH_FIN(X, Q, m_) do { f32x4 v[8], g[8]; _Pragma("unroll") for (int j = 0; j < 8; ++j) { v[j] = TH_UNPK(X[j]); g[j] = TH_UNPK(Q[j]); } thin_finish(F, v, g, true, m_, scale, post_w, xout16, xout32, rs_out); } while (0)
        int m = F.gw;
        if (m < MP) TH_LOAD(ax, aq, m);
        while (m < MP) {
            const int m2 = m + F.NGW, m3 = m2 + F.NGW;
            if (m2 < MP) TH_LOAD(bx, bq, m2);
            TH_FIN(ax, aq, m);
            if (m3 < MP) TH_LOAD(ax, aq, m3);
            if (m2 < MP) TH_FIN(bx, bq, m2);
            m = m3;
        }
#undef TH_LOAD
#undef TH_UNPK
#undef TH_FIN
    }
    for (int m = F.gw; m < M_ALL; m += F.NGW) {
        if (pipe && m < MP) continue;
        f32x4 v[8], g[8];
        if (xin16) {
#pragma unroll
            for (int j = 0; j < 8; ++j) v[j] = ld_bf16x4(xin16 + (size_t)m * DM + 4 * (64 * j + lane));
        } else { const GAS f32x4* x4 = (const GAS f32x4*)(m < MP ? F.xp() + (size_t)m * DM : F.xs() + (size_t)(m - MP) * DM) + lane;
#pragma unroll
            for (int j = 0; j < 8; ++j) v[j] = x4[64 * j]; }
        if (f16) {
            if (m < MP) {
#pragma unroll
                for (int j = 0; j < 8; ++j) g[j] = ld_bf16x4(f16 + (size_t)m * DM + 4 * (64 * j + lane));
            } else { GAS f32x4* f4 = (GAS f32x4*)(fs + (size_t)m * DM) + lane;
#pragma unroll
                for (int j = 0; j < 8; ++j) { g[j] = f4[64 * j]; f4[64 * j] = (f32x4){0.f, 0.f, 0.f, 0.f}; } }
        } else {
#pragma unroll
            for (int j = 0; j < 8; ++j) g[j] = (f32x4){0.f, 0.f, 0.f, 0.f}; }
        thin_finish(F, v, g, f16 != nullptr, m, scale, post_w, xout16, xout32, rs_out);
    }
}
__device__ __forceinline__ void transpose_item64(const float* W, int N, int k0, int n0, bf16* WT, int K, int drow0, LAS float* scr, int lane) {
    const int kr = lane >> 4, c = lane & 15, nr = lane >> 2, kc = lane & 3; const bool inb = n0 + 4 * c < N;
#pragma unroll
    for (int half = 0; half < 2; ++half) {
        f32x4 v[8];
#pragma unroll
        for (int i = 0; i < 8; ++i) v[i] = inb ? *(const GAS f32x4*)(W + (size_t)(k0 + 32 * half + 4 * i + kr) * N + n0 + 4 * c) : (f32x4){0.f, 0.f, 0.f, 0.f};
#pragma unroll
        for (int i = 0; i < 8; ++i) *(LAS f32x4*)(scr + (4 * i + kr) * 68 + 4 * c) = v[i];
        LDS_WAIT(); asm volatile("" ::: "memory");
#pragma unroll
        for (int it = 0; it < 4; ++it) { const int n = nr + 16 * it; const LAS float* sp = scr + (8 * kc) * 68 + n;
            v4u o; o.x = pk2(sp[0 * 68], sp[1 * 68]); o.y = pk2(sp[2 * 68], sp[3 * 68]); o.z = pk2(sp[4 * 68], sp[5 * 68]); o.w = pk2(sp[6 * 68], sp[7 * 68]);
            *(GAS v4u*)(WT + (size_t)(drow0 + n) * K + k0 + 32 * half + 8 * kc) = o; }
        LDS_WAIT(); asm volatile("" ::: "memory");
    }
}
__device__ __forceinline__ void convert_matrix(Frame& F, const float* W, int K, int N, int Npad, bf16* WT, int mode, int wg_lo, const float* ks = nullptr) {
    if ((int)blockIdx.x < wg_lo) return;
    LAS float* scr = (LAS float*)(F.lds + RING_OFF + F.wave * 16384);
    const int nkb = K / 64, nit = nkb * (Npad / 32), wv = ((int)blockIdx.x - wg_lo) * NWAVES + F.wave, nwv = (F.G - wg_lo) * NWAVES;
    for (int it = wv; it < nit; it += nwv) {
#if CONV_NFAST
        const int nnb = Npad / 32, n0 = 32 * (it % nnb), kb = it / nnb;
#else
        const int kb = it % nkb, n0 = 32 * (it / nkb);
#endif
        const int drow0 = mode == 0 ? n0 : 256 * (n0 >> 7) + 128 * (mode - 1) + (n0 & 127);
        transpose_item(W, N, 64 * kb, n0, WT, K, drow0, scr, F.lane, ks);
    }
}
struct ConvItem { const float* src; bf16* dst; const float* ks; int N, K, cc, k0; };
constexpr int CV_GU = (DM / 64) * (FF / 32), CV_IN = (DM / 64) * (INW_PAD / 32), CV_OUT = (DM / 64) * (DM / 32), CV_DN = (FF / 64) * (DM / 32);
constexpr int CV_E0 = CV_GU, CV_E1 = CV_E0 + CV_GU, CV_E2 = CV_E1 + CV_GU, CV_E3 = CV_E2 + CV_GU, CV_E4 = CV_E3 + CV_IN, CV_E5 = CV_E4 + CV_OUT, CV_E6 = CV_E5 + CV_DN, CV_TOT = CV_E6 + CV_DN;
__device__ __forceinline__ void conv_decode(const Frame& F, int g, int lane, ConvItem& c) {
    const float* W; bf16* WT; const float* ks; int K, N, Npad, mode, it;
    if (g < CV_E0)      { W = F.gate1(); WT = F.W1GU(); ks = F.ffn1_pre(); K = DM; N = FF; Npad = FF; mode = 1; it = g; }
    else if (g < CV_E1) { W = F.up1();   WT = F.W1GU(); ks = F.ffn1_pre(); K = DM; N = FF; Npad = FF; mode = 2; it = g - CV_E0; }
    else if (g < CV_E2) { W = F.gate2(); WT = F.W2GU(); ks = F.ffn2_pre(); K = DM; N = FF; Npad = FF; mode = 1; it = g - CV_E1; }
    else if (g < CV_E3) { W = F.up2();   WT = F.W2GU(); ks = F.ffn2_pre(); K = DM; N = FF; Npad = FF; mode = 2; it = g - CV_E2; }
    else if (g < CV_E4) { W = F.w_in();  WT = F.WIN();  ks = F.mix_pre();  K = DM; N = INW; Npad = INW_PAD; mode = 0; it = g - CV_E3; }
    else if (g < CV_E5) { W = F.w_out(); WT = F.WOUT(); ks = nullptr;      K = DM; N = DM; Npad = DM; mode = 0; it = g - CV_E4; }
    else if (g < CV_E6) { W = F.down1(); WT = F.W1D();  ks = nullptr;      K = FF; N = DM; Npad = DM; mode = 0; it = g - CV_E5; }
    else                { W = F.down2(); WT = F.W2D();  ks = nullptr;      K = FF; N = DM; Npad = DM; mode = 0; it = g - CV_E6; }
    const int nnb = Npad / 32, n0 = 32 * (it % nnb), kb = it / nnb;
    const int drow0 = mode == 0 ? n0 : 256 * (n0 >> 7) + 128 * (mode - 1) + (n0 & 127);
    c.N = N; c.K = K; c.k0 = 64 * kb; c.cc = n0 + (lane & 31); c.ks = ks;
    c.src = W + (size_t)(64 * kb + (lane >> 5)) * N + c.cc;
    c.dst = WT + (size_t)(drow0 + (lane >> 3)) * K + 64 * kb + 8 * (lane & 7);
}
#define CV_LOAD(ld, kv0, kv1, c) do { \
        _Pragma("unroll") for (int i = 0; i < 32; ++i) ld[i] = ((c).cc < (c).N) ? (c).src[(size_t)(2 * i) * (c).N] : 0.f; \
        if ((c).ks) { kv0 = *(const GAS f32x4*)((c).ks + (c).k0 + 8 * (lane & 7)); kv1 = *(const GAS f32x4*)((c).ks + (c).k0 + 8 * (lane & 7) + 4); } \
        else { kv0 = (f32x4){1.f, 1.f, 1.f, 1.f}; kv1 = kv0; } } while (0)
#define CV_STORE(ld, kv0, kv1, c) do { \
        _Pragma("unroll") for (int i = 0; i < 32; ++i) scr[(2 * i + (lane >> 5)) * 33 + (lane & 31)] = ld[i]; \
        LDS_WAIT(); asm volatile("" ::: "memory"); \
        _Pragma("unroll") for (int j = 0; j < 4; ++j) { const LAS float* s_ = scr + (8 * (lane & 7)) * 33 + (lane >> 3) + 8 * j; \
            v4u o_; o_.x = pk2(s_[0 * 33] * kv0.x, s_[1 * 33] * kv0.y); o_.y = pk2(s_[2 * 33] * kv0.z, s_[3 * 33] * kv0.w); o_.z = pk2(s_[4 * 33] * kv1.x, s_[5 * 33] * kv1.y); o_.w = pk2(s_[6 * 33] * kv1.z, s_[7 * 33] * kv1.w); \
            *(GAS v4u*)((c).dst + (size_t)(8 * j) * (c).K) = o_; } \
        LDS_WAIT(); asm volatile("" ::: "memory"); } while (0)
__device__ __forceinline__ void convert_all(Frame& F) {
    LAS float* scr = (LAS float*)(F.lds + RING_OFF + F.wave * 16384);
    const int lane = F.lane, wv = (int)blockIdx.x * NWAVES + F.wave, nwv = F.G * NWAVES;
    float ldA[32], ldB[32], ldC[32]; f32x4 kA0, kA1, kB0, kB1, kC0, kC1; ConvItem cA, cB, cC;
    const int g0 = wv;
    if (g0 < CV_TOT) { conv_decode(F, g0, lane, cA); CV_LOAD(ldA, kA0, kA1, cA); }
    if (g0 + nwv < CV_TOT) { conv_decode(F, g0 + nwv, lane, cB); CV_LOAD(ldB, kB0, kB1, cB); }
    for (int g = g0; g < CV_TOT; g += 3 * nwv) {
        if (g + 2 * nwv < CV_TOT) { conv_decode(F, g + 2 * nwv, lane, cC); CV_LOAD(ldC, kC0, kC1, cC); }
        CV_STORE(ldA, kA0, kA1, cA);
        if (g + 3 * nwv < CV_TOT) { conv_decode(F, g + 3 * nwv, lane, cA); CV_LOAD(ldA, kA0, kA1, cA); }
        if (g + nwv < CV_TOT) CV_STORE(ldB, kB0, kB1, cB);
        if (g + 4 * nwv < CV_TOT) { conv_decode(F, g + 4 * nwv, lane, cB); CV_LOAD(ldB, kB0, kB1, cB); }
        if (g + 2 * nwv < CV_TOT) CV_STORE(ldC, kC0, kC1, cC);
    }
}
__device__ __forceinline__ void p0_prologue(Frame& F) {
#if CONV_PIPE
    convert_all(F);
#else
    convert_matrix(F, F.gate1(), DM, FF, FF, F.W1GU(), 1, 0, F.ffn1_pre());
    convert_matrix(F, F.up1(), DM, FF, FF, F.W1GU(), 2, 0, F.ffn1_pre());
    convert_matrix(F, F.up2(), DM, FF, FF, F.W2GU(), 2, 0, F.ffn2_pre());
    convert_matrix(F, F.w_in(), DM, INW, INW_PAD, F.WIN(), 0, 0, F.mix_pre()); convert_matrix(F, F.w_out(), DM, DM, DM, F.WOUT(), 0, 0);
    convert_matrix(F, F.gate2(), DM, FF, FF, F.W2GU(), 1, 0, F.ffn2_pre());
#if !CONV_TAILS
    convert_matrix(F, F.down1(), FF, DM, DM, F.W1D(), 0, 0); convert_matrix(F, F.down2(), FF, DM, DM, F.W2D(), 0, 0);
#endif
#endif
    thin_rows(F, nullptr, nullptr, nullptr, 0.f, nullptr, F.X0h(), nullptr, F.RS());
    { const int gt = (int)blockIdx.x * NTHREADS + F.tid, NT = F.G * NTHREADS; GAS f32x4* z = (GAS f32x4*)(F.Fb() + (size_t)MP * DM);
      for (int i = gt; i < MS * DM / 4; i += NT) z[i] = (f32x4){0.f, 0.f, 0.f, 0.f}; }
}
constexpr int G1_R = 0, G1_Q = 65536, G1_K = G1_Q + 17408, G1_KDT = G1_K + 17408, G1_SM = G1_KDT + 18432, G1_CW = G1_SM + 1024, G1_END = G1_CW + 6144, QS = 136, TS72 = 72;
static_assert(G1_END <= RING_BYTES, "G1 LDS");
__device__ __forceinline__ void gdn_chunk_prep(Frame& F, int ci_lo, int ci_hi, int ci_step) {
    typedef float f32x2 __attribute__((ext_vector_type(2)));
    LAS float* R = (LAS float*)(F.lds + G1_R); LAS bf16* QI = (LAS bf16*)(F.lds + G1_Q); LAS float* Lm = (LAS float*)(F.lds + G1_Q);
    LAS bf16* KI = (LAS bf16*)(F.lds + G1_K); LAS bf16* KD = (LAS bf16*)(F.lds + G1_KDT); LAS float* SM = (LAS float*)(F.lds + G1_SM); LAS float* CW = (LAS float*)(F.lds + G1_CW);
    const int w = F.wave; int h_cw = -1;
    for (int ci = ci_lo; ci < ci_hi; ci += ci_step) {
        int lane = lane_id(); asm volatile("" : "+v"(lane));
        const int m16 = lane & 15, kq = lane >> 4, tid = 64 * w + lane;
        int h, t0, T, row0; const float* cs = nullptr;
        if (ci < NCHUNK_P) { const int sh = ci >> 5; h = sh & 7; t0 = (ci & 31) * 64; T = SEQ; row0 = (sh >> 3) * SEQ; }
        else { const int sb = ci - NCHUNK_P, b = sb >> 3; h = sb & 7; t0 = 0; T = TS; row0 = MP + b * TS; cs = F.state_conv() + (size_t)b * 3 * CONVD; }
        if (h != h_cw) { for (int i = tid; i < 1536; i += NTHREADS) { const int p = i >> 9, j = (i >> 7) & 3, c = i & 127; CW[i] = F.conv_w()[(size_t)j * CONVD + p * 1024 + h * 128 + c]; } h_cw = h; }
        const int r4 = lane >> 4, cg = lane & 15;
        v4u xr[2][3][4];
        if (false) { const int tok = t0 + 8 * w + r4;
#pragma unroll
            for (int p = 0; p < 3; ++p)
#pragma unroll
                for (int j = 0; j < 4; ++j) { const int tt = tok + j - 3;
                    xr[0][p][j] = (tt >= 0) ? *(const GAS v4u*)(F.QKVB() + (size_t)(row0 + tt) * CONVD + p * 1024 + h * 128 + 8 * cg) : (v4u){0u, 0u, 0u, 0u}; } }
        {
            const int tok = t0 + lane; const bool valid = tok < T; float g = 0.f, be = 0.f;
            if (valid) { const float* hr = F.BA() + (size_t)(row0 + tok) * 16; be = sigmoid_f(hr[h]); g = -__expf(F.a_log()[h]) * softplus_f(hr[8 + h] + F.dt_bias()[h]); }
            float G = g;
#pragma unroll
            for (int o = 1; o < 64; o <<= 1) { const float t = __shfl_up(G, o); if (lane >= o) G += t; }
            const float G63 = __shfl(G, 63);
            SM[lane] = G; SM[64 + lane] = be; SM[128 + lane] = __expf(G); SM[192 + lane] = __expf(G63 - G);
            if (w == 0 && lane == 0) F.EGL()[ci] = __expf(G63);
        }
        LDS_BARRIER();
        if (false) { const int tok = t0 + 8 * w + 4 + r4;
#pragma unroll
            for (int p = 0; p < 3; ++p)
#pragma unroll
                for (int j = 0; j < 4; ++j) { const int tt = tok + j - 3;
                    xr[1][p][j] = (tt >= 0) ? *(const GAS v4u*)(F.QKVB() + (size_t)(row0 + tt) * CONVD + p * 1024 + h * 128 + 8 * cg) : (v4u){0u, 0u, 0u, 0u}; } }
#pragma unroll
        for (int g = 0; g < 2; ++g) {
            const int i = 8 * w + 4 * g + r4, tok = t0 + i; const bool valid = tok < T;
            LAS float* cwp = CW + 8 * cg; asm volatile("" : "+v"(cwp));
            float a[3][8];
#pragma unroll
            for (int p = 0; p < 3; ++p) {
                float acc[8];
#pragma unroll
                for (int c = 0; c < 8; ++c) acc[c] = 0.f;
#pragma unroll
                for (int j = 0; j < 4; ++j) {
                    float xv[8];
                    if (false) { const v4u xw = xr[g][p][j];
                        xv[0] = __uint_as_float(xw.x << 16); xv[1] = __uint_as_float(xw.x & 0xffff0000u); xv[2] = __uint_as_float(xw.y << 16); xv[3] = __uint_as_float(xw.y & 0xffff0000u);
                        xv[4] = __uint_as_float(xw.z << 16); xv[5] = __uint_as_float(xw.z & 0xffff0000u); xv[6] = __uint_as_float(xw.w << 16); xv[7] = __uint_as_float(xw.w & 0xffff0000u); }
                    else {
                        const int tt = tok + j - 3;
#pragma unroll
                        for (int c = 0; c < 8; ++c) xv[c] = 0.f;
                        if (valid) {
                            if (tt >= 0) { const v4u xw = *(const GAS v4u*)(F.QKVB() + (size_t)(row0 + tt) * CONVD + p * 1024 + h * 128 + 8 * cg);
                                xv[0] = __uint_as_float(xw.x << 16); xv[1] = __uint_as_float(xw.x & 0xffff0000u); xv[2] = __uint_as_float(xw.y << 16); xv[3] = __uint_as_float(xw.y & 0xffff0000u);
                                xv[4] = __uint_as_float(xw.z << 16); xv[5] = __uint_as_float(xw.z & 0xffff0000u); xv[6] = __uint_as_float(xw.w << 16); xv[7] = __uint_as_float(xw.w & 0xffff0000u); }
                            else { const f32x4 c0 = *(const GAS f32x4*)(cs + (size_t)(tt + 3) * CONVD + p * 1024 + h * 128 + 8 * cg), c1 = *(const GAS f32x4*)(cs + (size_t)(tt + 3) * CONVD + p * 1024 + h * 128 + 8 * cg + 4);
                                xv[0] = c0.x; xv[1] = c0.y; xv[2] = c0.z; xv[3] = c0.w; xv[4] = c1.x; xv[5] = c1.y; xv[6] = c1.z; xv[7] = c1.w; }
                        }
                    }
                    const f32x4 w0 = *(const LAS f32x4*)(cwp + (p * 4 + j) * 128), w1 = *(const LAS f32x4*)(cwp + (p * 4 + j) * 128 + 4);
                    acc[0] += xv[0] * w0.x; acc[1] += xv[1] * w0.y; acc[2] += xv[2] * w0.z; acc[3] += xv[3] * w0.w; acc[4] += xv[4] * w1.x; acc[5] += xv[5] * w1.y; acc[6] += xv[6] * w1.z; acc[7] += xv[7] * w1.w;
                }
#pragma unroll
                for (int c = 0; c < 8; ++c) a[p][c] = valid ? silu_f(acc[c]) : 0.f;
            }
            float sq = 0.f, sk = 0.f;
#pragma unroll
            for (int c = 0; c < 8; ++c) { sq += a[0][c] * a[0][c]; sk += a[1][c] * a[1][c]; }
            sq = sum16(sq); sk = sum16(sk);
            const float rq = rsqrtf(sq + 1e-6f) * 0.08838834764831845f, rk = rsqrtf(sk + 1e-6f);
            const float be = SM[64 + i], eg = SM[128 + i], ed = SM[192 + i];
            float qn[8], kn[8];
#pragma unroll
            for (int c = 0; c < 8; ++c) { qn[c] = a[0][c] * rq; kn[c] = a[1][c] * rk; }
            *(LAS v4u*)(QI + i * QS + 8 * cg) = (v4u){pk2(qn[0], qn[1]), pk2(qn[2], qn[3]), pk2(qn[4], qn[5]), pk2(qn[6], qn[7])};
            *(LAS v4u*)(KI + i * QS + 8 * cg) = (v4u){pk2(kn[0], kn[1]), pk2(kn[2], kn[3]), pk2(kn[4], kn[5]), pk2(kn[6], kn[7])};
            *(GAS v4u*)(F.QGc() + ((size_t)ci * 64 + i) * 128 + 8 * cg) = (v4u){pk2(qn[0] * eg, qn[1] * eg), pk2(qn[2] * eg, qn[3] * eg), pk2(qn[4] * eg, qn[5] * eg), pk2(qn[6] * eg, qn[7] * eg)};
#pragma unroll
            for (int c = 0; c < 8; ++c) KD[(8 * cg + c) * TS72 + i] = (bf16)f2bf(kn[c] * ed);
            const float bg = be * eg;
            *(LAS f32x4*)(R + i * 256 + 8 * cg) = (f32x4){a[2][0] * be, a[2][1] * be, a[2][2] * be, a[2][3] * be}; *(LAS f32x4*)(R + i * 256 + 8 * cg + 4) = (f32x4){a[2][4] * be, a[2][5] * be, a[2][6] * be, a[2][7] * be};
            *(LAS f32x4*)(R + i * 256 + 128 + 8 * cg) = (f32x4){kn[0] * bg, kn[1] * bg, kn[2] * bg, kn[3] * bg}; *(LAS f32x4*)(R + i * 256 + 128 + 8 * cg + 4) = (f32x4){kn[4] * bg, kn[5] * bg, kn[6] * bg, kn[7] * bg};
        }
        LDS_BARRIER();
        {
            const int tm = w & 3, tnb = (w >> 2) * 2;
            f32x4 kk[2], kqv[2];
#pragma unroll
            for (int t2 = 0; t2 < 2; ++t2) { kk[t2] = (f32x4){0.f, 0.f, 0.f, 0.f}; kqv[t2] = (f32x4){0.f, 0.f, 0.f, 0.f}; }
#pragma unroll
            for (int ks = 0; ks < 4; ++ks) {
                const bf16x8 ak = *(const LAS bf16x8*)(KI + (16 * tm + m16) * QS + 32 * ks + 8 * kq);
#pragma unroll
                for (int t2 = 0; t2 < 2; ++t2) {
                    const bf16x8 bk = *(const LAS bf16x8*)(KI + (16 * (tnb + t2) + m16) * QS + 32 * ks + 8 * kq);
                    const bf16x8 bq = *(const LAS bf16x8*)(QI + (16 * (tnb + t2) + m16) * QS + 32 * ks + 8 * kq);
                    kk[t2] = __builtin_amdgcn_mfma_f32_16x16x32_bf16(ak, bk, kk[t2], 0, 0, 0);
                    kqv[t2] = __builtin_amdgcn_mfma_f32_16x16x32_bf16(ak, bq, kqv[t2], 0, 0, 0);
                }
            }
#pragma unroll
            for (int t2 = 0; t2 < 2; ++t2) {
                const int i = 16 * (tnb + t2) + m16, j0 = 16 * tm + 4 * kq; const float Gi = SM[i]; float o4[4];
#pragma unroll
                for (int r = 0; r < 4; ++r) { const int j = j0 + r; o4[r] = (i >= j) ? kqv[t2][r] * __expf(Gi - SM[j]) : 0.f; }
                *(GAS unsigned long long*)(F.QKc() + ((size_t)ci * 64 + i) * 64 + j0) = (unsigned long long)pk2(o4[0], o4[1]) | ((unsigned long long)pk2(o4[2], o4[3]) << 32);
            }
            LDS_BARRIER();
#pragma unroll
            for (int t2 = 0; t2 < 2; ++t2) {
                const int j = 16 * (tnb + t2) + m16; const float Gj = SM[j];
#pragma unroll
                for (int r = 0; r < 4; ++r) { const int i = 16 * tm + 4 * kq + r; Lm[i * 64 + j] = (i > j) ? SM[64 + i] * kk[t2][r] * __expf(SM[i] - Gj) : 0.f; }
            }
        }
        LDS_BARRIER();
        if (w < 2) {
            typedef float f32x2 __attribute__((ext_vector_type(2)));
            const int c2 = 64 * w + lane;
            LAS float* Lb = Lm; asm volatile("" : "+v"(Lb));
            f32x2 x[64];
#pragma unroll
            for (int i = 0; i < 64; ++i) x[i] = *(const LAS f32x2*)(R + i * 256 + 2 * c2);
#define G1_SOLVE_ROW(i) do { f32x2 a0 = {0.f, 0.f}, a1 = {0.f, 0.f}; \
                _Pragma("unroll") for (int j4 = 0; j4 < ((i) + 3) / 4; ++j4) { const f32x4 l = *(const LAS f32x4*)(Lb + (i) * 64 + 4 * j4); \
                    a0 = a0 + x[4 * j4] * l.x; a1 = a1 + x[4 * j4 + 1] * l.y; a0 = a0 + x[4 * j4 + 2] * l.z; a1 = a1 + x[4 * j4 + 3] * l.w; } \
                x[i] = x[i] - (a0 + a1); asm volatile("" ::: "memory"); } while (0)
#pragma unroll
            for (int i = 1; i < TS; ++i) G1_SOLVE_ROW(i);
            if (false) {
#pragma unroll
                for (int i = TS; i < 64; ++i) G1_SOLVE_ROW(i);
            }
#ifdef REP_SOLVE
            asm volatile("" : "+v"(Lb));
#pragma unroll
            for (int i = 0; i < 64; ++i) x[i] = *(const LAS f32x2*)(R + i * 256 + 2 * c2);
#pragma unroll
            for (int i = 1; i < 64; ++i) G1_SOLVE_ROW(i);
            asm volatile("" : "+v"(Lb));
#pragma unroll
            for (int i = 0; i < 64; ++i) x[i] = *(const LAS f32x2*)(R + i * 256 + 2 * c2);
#pragma unroll
            for (int i = 1; i < 64; ++i) G1_SOLVE_ROW(i);
#endif
#undef G1_SOLVE_ROW
            if (w == 0) { float* up = F.UT() + (size_t)ci * 8192 + 2 * lane;
#pragma unroll
                for (int i = 0; i < 64; ++i) *(GAS f32x2*)(up + i * 128) = x[i];
            } else { bf16* wp = F.WC() + (size_t)ci * 8192 + 2 * lane;
#pragma unroll
                for (int i = 0; i < 64; ++i) *(GAS unsigned*)(wp + i * 128) = pk2(x[i].x, x[i].y); }
        } else if (w >= 4) {
            const int t = tid - 256;
#pragma unroll
            for (int q = 0; q < 4; ++q) { const int p = t + 256 * q, row = p >> 3, pc = p & 7;
                *(GAS v4u*)(F.KDTc() + (size_t)ci * 8192 + row * 64 + pc * 8) = *(const LAS v4u*)(KD + row * TS72 + pc * 8); }
        }
        LDS_BARRIER();
    }
}
constexpr int P2_HALF = 69632, P2_R = 0, P2_Q = 32768, P2_K = 50176, P2_SM = 67584, P2_CW = 2 * P2_HALF;
static_assert(P2_SM + 1024 <= P2_HALF && P2_CW + 6144 <= MISC_OFF, "prep2 LDS");
__device__ __forceinline__ void gdn_chunk_prep2(Frame& F, int ci_lo, int ci_hi) {
    typedef float f32x2 __attribute__((ext_vector_type(2)));
    const int w = F.wave, hb = w >> 2, wl = w & 3;
    LAS unsigned char* HB = F.lds + hb * P2_HALF;
    LAS bf16* R16 = (LAS bf16*)(HB + P2_R); LAS bf16* QI = (LAS bf16*)(HB + P2_Q); LAS float* Lm = (LAS float*)(HB + P2_Q); LAS bf16* KI = (LAS bf16*)(HB + P2_K); LAS float* SM = (LAS float*)(HB + P2_SM);
    LAS float* CW = (LAS float*)(F.lds + P2_CW);
    int h_cw = -1;
    for (int cp = ci_lo; cp < ci_hi; cp += 2) {
        int lane = lane_id(); asm volatile("" : "+v"(lane));
        const int m16 = lane & 15, kq = lane >> 4, tid = 64 * w + lane, r4 = lane >> 4, cg = lane & 15;
        const int ci = cp + hb, sh = ci >> 5, h = sh & 7, t0 = (ci & 31) * 64, row0 = (sh >> 3) * SEQ;
        if (h != h_cw) { for (int i = tid; i < 1536; i += NTHREADS) { const int p = i >> 9, j = (i >> 7) & 3, c = i & 127; CW[i] = F.conv_w()[(size_t)j * CONVD + p * 1024 + h * 128 + c]; } h_cw = h; }
        v4u xr[2][3][4];
#define P2_LOADG(buf, g_) do { const int tok_ = t0 + 16 * wl + 4 * (g_) + r4; \
            _Pragma("unroll") for (int p = 0; p < 3; ++p) _Pragma("unroll") for (int j = 0; j < 4; ++j) { const int tt = tok_ + j - 3; \
                xr[buf][p][j] = (tt >= 0) ? *(const GAS v4u*)(F.QKVB() + (size_t)(row0 + tt) * CONVD + p * 1024 + h * 128 + 8 * cg) : (v4u){0u, 0u, 0u, 0u}; } } while (0)
        P2_LOADG(0, 0);
        {
            const float* hr = F.BA() + (size_t)(row0 + t0 + lane) * 16; const float be = sigmoid_f(hr[h]), g = -__expf(F.a_log()[h]) * softplus_f(hr[8 + h] + F.dt_bias()[h]);
            float G = g;
#pragma unroll
            for (int o = 1; o < 64; o <<= 1) { const float t = __shfl_up(G, o); if (lane >= o) G += t; }
            const float G63 = __shfl(G, 63);
            SM[lane] = G; SM[64 + lane] = be; SM[128 + lane] = __expf(G); SM[192 + lane] = __expf(G63 - G);
            if (wl == 0 && lane == 0) F.EGL()[ci] = __expf(G63);
        }
        LDS_BARRIER();
#pragma unroll
        for (int g = 0; g < 4; ++g) {
            if (g + 1 < 4) P2_LOADG((g + 1) & 1, g + 1);
            const int i = 16 * wl + 4 * g + r4;
            LAS float* cwp = CW + 8 * cg; asm volatile("" : "+v"(cwp));
            float a[3][8];
#pragma unroll
            for (int p = 0; p < 3; ++p) {
                float acc[8];
#pragma unroll
                for (int c = 0; c < 8; ++c) acc[c] = 0.f;
#pragma unroll
                for (int j = 0; j < 4; ++j) {
                    const v4u xw = xr[g & 1][p][j]; float xv[8];
                    xv[0] = __uint_as_float(xw.x << 16); xv[1] = __uint_as_float(xw.x & 0xffff0000u); xv[2] = __uint_as_float(xw.y << 16); xv[3] = __uint_as_float(xw.y & 0xffff0000u);
                    xv[4] = __uint_as_float(xw.z << 16); xv[5] = __uint_as_float(xw.z & 0xffff0000u); xv[6] = __uint_as_float(xw.w << 16); xv[7] = __uint_as_float(xw.w & 0xffff0000u);
                    const f32x4 w0 = *(const LAS f32x4*)(cwp + (p * 4 + j) * 128), w1 = *(const LAS f32x4*)(cwp + (p * 4 + j) * 128 + 4);
                    acc[0] += xv[0] * w0.x; acc[1] += xv[1] * w0.y; acc[2] += xv[2] * w0.z; acc[3] += xv[3] * w0.w; acc[4] += xv[4] * w1.x; acc[5] += xv[5] * w1.y; acc[6] += xv[6] * w1.z; acc[7] += xv[7] * w1.w;
                }
#pragma unroll
                for (int c = 0; c < 8; ++c) a[p][c] = silu_f(acc[c]);
            }
            float sq = 0.f, sk = 0.f;
#pragma unroll
            for (int c = 0; c < 8; ++c) { sq += a[0][c] * a[0][c]; sk += a[1][c] * a[1][c]; }
            sq = sum16(sq); sk = sum16(sk);
            const float rq = rsqrtf(sq + 1e-6f) * 0.08838834764831845f, rk = rsqrtf(sk + 1e-6f);
            const float be = SM[64 + i], eg = SM[128 + i], ed = SM[192 + i], bg = be * eg;
            float qn[8], kn[8];
#pragma unroll
            for (int c = 0; c < 8; ++c) { qn[c] = a[0][c] * rq; kn[c] = a[1][c] * rk; }
            *(LAS v4u*)(QI + i * QS + 8 * cg) = (v4u){pk2(qn[0], qn[1]), pk2(qn[2], qn[3]), pk2(qn[4], qn[5]), pk2(qn[6], qn[7])};
            *(LAS v4u*)(KI + i * QS + 8 * cg) = (v4u){pk2(kn[0], kn[1]), pk2(kn[2], kn[3]), pk2(kn[4], kn[5]), pk2(kn[6], kn[7])};
            *(GAS v4u*)(F.QGc() + ((size_t)ci * 64 + i) * 128 + 8 * cg) = (v4u){pk2(qn[0] * eg, qn[1] * eg), pk2(qn[2] * eg, qn[3] * eg), pk2(qn[4] * eg, qn[5] * eg), pk2(qn[6] * eg, qn[7] * eg)};
#pragma unroll
            for (int c = 0; c < 8; ++c) F.KDTc()[(size_t)ci * 8192 + (8 * cg + c) * 64 + i] = (bf16)f2bf(kn[c] * ed);
            *(LAS v4u*)(R16 + i * 256 + 8 * cg) = (v4u){pk2(a[2][0] * be, a[2][1] * be), pk2(a[2][2] * be, a[2][3] * be), pk2(a[2][4] * be, a[2][5] * be), pk2(a[2][6] * be, a[2][7] * be)};
            *(LAS v4u*)(R16 + i * 256 + 128 + 8 * cg) = (v4u){pk2(kn[0] * bg, kn[1] * bg), pk2(kn[2] * bg, kn[3] * bg), pk2(kn[4] * bg, kn[5] * bg), pk2(kn[6] * bg, kn[7] * bg)};
        }
#undef P2_LOADG
        LDS_BARRIER();
        {
            const int tm = wl;
            f32x4 kk[4], kqv[4];
#pragma unroll
            for (int t4 = 0; t4 < 4; ++t4) { kk[t4] = (f32x4){0.f, 0.f, 0.f, 0.f}; kqv[t4] = (f32x4){0.f, 0.f, 0.f, 0.f}; }
#pragma unroll
            for (int ks = 0; ks < 4; ++ks) {
                const bf16x8 ak = *(const LAS bf16x8*)(KI + (16 * tm + m16) * QS + 32 * ks + 8 * kq);
#pragma unroll
                for (int t4 = 0; t4 < 4; ++t4) {
                    const bf16x8 bk = *(const LAS bf16x8*)(KI + (16 * t4 + m16) * QS + 32 * ks + 8 * kq);
                    const bf16x8 bq = *(const LAS bf16x8*)(QI + (16 * t4 + m16) * QS + 32 * ks + 8 * kq);
                    kk[t4] = __builtin_amdgcn_mfma_f32_16x16x32_bf16(ak, bk, kk[t4], 0, 0, 0);
                    kqv[t4] = __builtin_amdgcn_mfma_f32_16x16x32_bf16(ak, bq, kqv[t4], 0, 0, 0);
                }
            }
#pragma unroll
            for (int t4 = 0; t4 < 4; ++t4) {
                const int i = 16 * t4 + m16, j0 = 16 * tm + 4 * kq; const float Gi = SM[i]; float o4[4];
#pragma unroll
                for (int r = 0; r < 4; ++r) { const int j = j0 + r; o4[r] = (i >= j) ? kqv[t4][r] * __expf(Gi - SM[j]) : 0.f; }
                *(GAS unsigned long long*)(F.QKc() + ((size_t)ci * 64 + i) * 64 + j0) = (unsigned long long)pk2(o4[0], o4[1]) | ((unsigned long long)pk2(o4[2], o4[3]) << 32);
            }
            LDS_BARRIER();
#pragma unroll
            for (int t4 = 0; t4 < 4; ++t4) {
                const int j = 16 * t4 + m16; const float Gj = SM[j];
#pragma unroll
                for (int r = 0; r < 4; ++r) { const int i = 16 * tm + 4 * kq + r; Lm[i * 64 + j] = (i > j) ? SM[64 + i] * kk[t4][r] * __expf(SM[i] - Gj) : 0.f; }
            }
        }
        LDS_BARRIER();
        if (wl < 2) {
            const int c2 = 64 * wl + lane;
            LAS float* Lb = Lm; asm volatile("" : "+v"(Lb));
            f32x2 x[64];
#pragma unroll
            for (int i = 0; i < 64; ++i) { const unsigned rw = *(const LAS unsigned*)(R16 + i * 256 + 2 * c2); x[i] = (f32x2){__uint_as_float(rw << 16), __uint_as_float(rw & 0xffff0000u)}; }
#pragma unroll
            for (int i = 1; i < 64; ++i) { f32x2 a0 = {0.f, 0.f}, a1 = {0.f, 0.f};
#pragma unroll
                for (int j4 = 0; j4 < (i + 3) / 4; ++j4) { const f32x4 l = *(const LAS f32x4*)(Lb + i * 64 + 4 * j4);
                    a0 = a0 + x[4 * j4] * l.x; a1 = a1 + x[4 * j4 + 1] * l.y; a0 = a0 + x[4 * j4 + 2] * l.z; a1 = a1 + x[4 * j4 + 3] * l.w; }
                x[i] = x[i] - (a0 + a1); asm volatile("" ::: "memory"); }
            if (wl == 0) { float* up = F.UT() + (size_t)ci * 8192 + 2 * lane;
#pragma unroll
                for (int i = 0; i < 64; ++i) *(GAS f32x2*)(up + i * 128) = x[i];
            } else { bf16* wp = F.WC() + (size_t)ci * 8192 + 2 * lane;
#pragma unroll
                for (int i = 0; i < 64; ++i) *(GAS unsigned*)(wp + i * 128) = pk2(x[i].x, x[i].y); }
        }
        LDS_BARRIER();
    }
}
constexpr int G2_W = 0, G2_QG = 17408, G2_QK = 34816, G2_KDT = 44032, G2_WAVE = 62464, G2_WAVE_BYTES = 6656, G2_END = G2_WAVE + 8 * G2_WAVE_BYTES;
static_assert(G2_END <= RING_BYTES, "G2 LDS");
constexpr int N_SCAN_ITEMS = NBP * NH + NBS * NH;
__device__ __forceinline__ void gdn_scan_item(Frame& F, int item) {
    int NC, ci0, T, row0, h; const float* s0 = nullptr; float* sout;
    if (item < NBP * NH) { NC = SEQ / 64; ci0 = item * 32; T = SEQ; row0 = (item >> 3) * SEQ; h = item & 7; sout = F.out() + OUT_SSMP + (size_t)item * 16384; }
    else { const int sb = item - NBP * NH; NC = 1; ci0 = NCHUNK_P + sb; T = TS; row0 = MP + (sb >> 3) * TS; h = sb & 7; s0 = F.state_ssm() + (size_t)sb * 16384; sout = F.out() + OUT_SSMS + (size_t)sb * 16384; }
    const int s = F.wave; int lane = lane_id(); asm volatile("" : "+v"(lane));
    const int n = lane & 15, kq = lane >> 4, tid = 64 * s + lane;
    LAS unsigned char* L = F.lds;
    LAS unsigned char* Vb = L + G2_WAVE + s * G2_WAVE_BYTES; LAS unsigned char* Sb = Vb + 2304;
    f32x4 S[8];
#pragma unroll
    for (int dt = 0; dt < 8; ++dt)
#pragma unroll
        for (int r = 0; r < 4; ++r) S[dt][r] = s0 ? s0[(size_t)(16 * dt + 4 * kq + r) * 128 + 16 * s + n] : 0.f;
    v4u st[7]; f32x4 ut[4];
#define G2_LOAD(ci_) do { const size_t cb = (size_t)(ci_); \
        _Pragma("unroll") for (int q = 0; q < 2; ++q) { const int p = tid + 512 * q; st[q] = *(const GAS v4u*)(F.WC() + cb * 8192 + (p >> 4) * 128 + (p & 15) * 8); st[2 + q] = *(const GAS v4u*)(F.QGc() + cb * 8192 + (p >> 4) * 128 + (p & 15) * 8); \
            st[5 + q] = *(const GAS v4u*)(F.KDTc() + cb * 8192 + (p >> 3) * 64 + (p & 7) * 8); } \
        st[4] = *(const GAS v4u*)(F.QKc() + cb * 4096 + (tid >> 3) * 64 + (tid & 7) * 8); \
        _Pragma("unroll") for (int rt = 0; rt < 4; ++rt) _Pragma("unroll") for (int r = 0; r < 4; ++r) ut[rt][r] = F.UT()[(cb * 64 + 16 * rt + 4 * kq + r) * 128 + 16 * s + n]; } while (0)
#define G2_STORE() do { \
        _Pragma("unroll") for (int q = 0; q < 2; ++q) { const int p = tid + 512 * q; *(LAS v4u*)(L + G2_W + (p >> 4) * 272 + (p & 15) * 16) = st[q]; *(LAS v4u*)(L + G2_QG + (p >> 4) * 272 + (p & 15) * 16) = st[2 + q]; \
            *(LAS v4u*)(L + G2_KDT + (p >> 3) * 144 + (p & 7) * 16) = st[5 + q]; } \
        *(LAS v4u*)(L + G2_QK + (tid >> 3) * 144 + (tid & 7) * 16) = st[4]; } while (0)
    G2_LOAD(ci0);
    G2_STORE();
    f32x4 uc[4];
#pragma unroll
    for (int rt = 0; rt < 4; ++rt) uc[rt] = ut[rt];
#pragma unroll
    for (int dt = 0; dt < 8; ++dt) *(LAS unsigned long long*)(Sb + n * 272 + (16 * dt + 4 * kq) * 2) = (unsigned long long)pk2(S[dt][0], S[dt][1]) | ((unsigned long long)pk2(S[dt][2], S[dt][3]) << 32);
    LDS_BARRIER();
    for (int c = 0; c < NC; ++c) {
        const float egl = F.EGL()[ci0 + c];
        if (c + 1 < NC) G2_LOAD(ci0 + c + 1);
        LDS_WAIT(); asm volatile("" ::: "memory");
        bf16x8 sbf[4];
#pragma unroll
        for (int ks = 0; ks < 4; ++ks) sbf[ks] = *(const LAS bf16x8*)(Sb + n * 272 + (32 * ks + 8 * kq) * 2);
        f32x4 vn[4], oo[4];
#pragma unroll
        for (int rt = 0; rt < 4; ++rt) {
            f32x4 acc = {0.f, 0.f, 0.f, 0.f}, ao = {0.f, 0.f, 0.f, 0.f};
#pragma unroll
            for (int ks = 0; ks < 4; ++ks) {
                const bf16x8 aw = *(const LAS bf16x8*)(L + G2_W + (16 * rt + n) * 272 + (32 * ks + 8 * kq) * 2);
                const bf16x8 aq = *(const LAS bf16x8*)(L + G2_QG + (16 * rt + n) * 272 + (32 * ks + 8 * kq) * 2);
                acc = __builtin_amdgcn_mfma_f32_16x16x32_bf16(aw, sbf[ks], acc, 0, 0, 0);
                ao = __builtin_amdgcn_mfma_f32_16x16x32_bf16(aq, sbf[ks], ao, 0, 0, 0);
            }
            vn[rt] = uc[rt] - acc; oo[rt] = ao;
            *(LAS unsigned long long*)(Vb + n * 144 + (16 * rt + 4 * kq) * 2) = (unsigned long long)pk2(vn[rt][0], vn[rt][1]) | ((unsigned long long)pk2(vn[rt][2], vn[rt][3]) << 32);
        }
        LDS_WAIT(); asm volatile("" ::: "memory");
        bf16x8 vbf[2];
#pragma unroll
        for (int k2 = 0; k2 < 2; ++k2) vbf[k2] = *(const LAS bf16x8*)(Vb + n * 144 + (32 * k2 + 8 * kq) * 2);
#pragma unroll
        for (int rt = 0; rt < 4; ++rt) {
#pragma unroll
            for (int k2 = 0; k2 < 2; ++k2) { const bf16x8 a = *(const LAS bf16x8*)(L + G2_QK + (16 * rt + n) * 144 + (32 * k2 + 8 * kq) * 2); oo[rt] = __builtin_amdgcn_mfma_f32_16x16x32_bf16(a, vbf[k2], oo[rt], 0, 0, 0); }
#pragma unroll
            for (int r = 0; r < 4; ++r) { const int t = 64 * c + 16 * rt + 4 * kq + r; if (t < T) F.OG()[(size_t)(row0 + t) * 1024 + h * 128 + 16 * s + n] = (bf16)f2bf(oo[rt][r]); }
        }
#pragma unroll
        for (int dt = 0; dt < 8; ++dt) {
            f32x4 acc = S[dt] * egl;
#pragma unroll
            for (int k2 = 0; k2 < 2; ++k2) { const bf16x8 a = *(const LAS bf16x8*)(L + G2_KDT + (16 * dt + n) * 144 + (32 * k2 + 8 * kq) * 2); acc = __builtin_amdgcn_mfma_f32_16x16x32_bf16(a, vbf[k2], acc, 0, 0, 0); }
            S[dt] = acc;
            *(LAS unsigned long long*)(Sb + n * 272 + (16 * dt + 4 * kq) * 2) = (unsigned long long)pk2(acc[0], acc[1]) | ((unsigned long long)pk2(acc[2], acc[3]) << 32);
        }
        LDS_BARRIER();
        if (c + 1 < NC) { G2_STORE();
#pragma unroll
            for (int rt = 0; rt < 4; ++rt) uc[rt] = ut[rt]; }
        LDS_BARRIER();
    }
#pragma unroll
    for (int dt = 0; dt < 8; ++dt)
#pragma unroll
        for (int r = 0; r < 4; ++r) sout[(size_t)(16 * dt + 4 * kq + r) * 128 + 16 * s + n] = S[dt][r];
#undef G2_LOAD
#undef G2_STORE
}
template <bool SAMPLE> __device__ __forceinline__ void attn_row_item(Frame& F, int item, LAS float* wl) {
    typedef float f32x2 __attribute__((ext_vector_type(2)));
    const int h = item & 7, mi = item >> 3;
    int b, tq, nkeys, qrow, krow0;
    if (SAMPLE) { b = mi / TS; tq = mi % TS; nkeys = PAST + tq + 1; qrow = MP + mi; krow0 = MP + b * TS; }
    else { b = mi / SEQ; tq = mi % SEQ; nkeys = tq + 1; qrow = mi; krow0 = b * SEQ; }
    LAS float* ql = wl + 128;
    { const unsigned w = *(const GAS unsigned*)(F.QB() + (size_t)qrow * 1024 + h * 128 + 2 * F.lane);
      ql[2 * F.lane] = __uint_as_float(w << 16); ql[2 * F.lane + 1] = __uint_as_float(w & 0xffff0000u); }
    LDS_WAIT(); asm volatile("" ::: "memory");
    const float slope2 = exp2f(-(float)(h + 1)) * LOG2E;
    const int qpos = SAMPLE ? PAST + tq : tq;
    float M1 = -1e30f, M2 = -1e30f, l1 = 0.f, l2 = 0.f; f32x2 o1 = {0.f, 0.f}, o2 = {0.f, 0.f};
    for (int c0 = 0; c0 < nkeys; c0 += 64) {
        const int j = c0 + F.lane; const bool valid = j < nkeys;
        float s1 = -1e30f, s2 = -1e30f;
        if (valid) {
            float a1 = 0.f, a2 = 0.f;
            if (SAMPLE && j < PAST) {
                const int page = F.page_table()[b * NPAGES + (j >> 7)];
                const GAS f32x4* kp = (const GAS f32x4*)(F.cache_k() + ((size_t)(page * PAGE + (j & 127)) * NH + h) * 128);
#pragma unroll 4
                for (int i = 0; i < 16; ++i) { const f32x4 kv = kp[i]; const f32x4 qv = *(const LAS f32x4*)(ql + 4 * i); a1 += qv.x * kv.x + qv.y * kv.y + qv.z * kv.z + qv.w * kv.w; }
#pragma unroll 4
                for (int i = 16; i < 32; ++i) { const f32x4 kv = kp[i]; const f32x4 qv = *(const LAS f32x4*)(ql + 4 * i); a2 += qv.x * kv.x + qv.y * kv.y + qv.z * kv.z + qv.w * kv.w; }
            } else {
                const int kr = SAMPLE ? krow0 + (j - PAST) : krow0 + j;
                const GAS v4u* kp = (const GAS v4u*)(F.KB() + (size_t)kr * 1024 + h * 128);
#pragma unroll 4
                for (int i = 0; i < 16; ++i) { const v4u w = kp[i]; const f32x4 qa = *(const LAS f32x4*)(ql + 8 * i), qb = *(const LAS f32x4*)(ql + 8 * i + 4);
                    const float d = qa.x * __uint_as_float(w.x << 16) + qa.y * __uint_as_float(w.x & 0xffff0000u) + qa.z * __uint_as_float(w.y << 16) + qa.w * __uint_as_float(w.y & 0xffff0000u)
                                  + qb.x * __uint_as_float(w.z << 16) + qb.y * __uint_as_float(w.z & 0xffff0000u) + qb.z * __uint_as_float(w.w << 16) + qb.w * __uint_as_float(w.w & 0xffff0000u);
                    if (i < 8) a1 += d; else a2 += d; }
            }
            const float bias = slope2 * (float)(qpos - j);
            s1 = a1 - bias; s2 = a2 - bias;
        }
        const float n1 = fmaxf(M1, wave_max(s1)), n2 = fmaxf(M2, wave_max(s2));
        const float al1 = exp2f(M1 - n1), al2 = exp2f(M2 - n2);
        const float p1 = valid ? exp2f(s1 - n1) : 0.f, p2 = valid ? exp2f(s2 - n2) : 0.f;
        l1 = l1 * al1 + p1; l2 = l2 * al2 + p2; o1 = o1 * al1; o2 = o2 * al2; M1 = n1; M2 = n2;
        wl[F.lane] = p1; wl[64 + F.lane] = p2;
        LDS_WAIT(); asm volatile("" ::: "memory");
        const int nk = (nkeys - c0) < 64 ? (nkeys - c0) : 64;
        for (int jj = 0; jj < nk; ++jj) {
            const float pp1 = wl[jj], pp2 = wl[64 + jj]; const int jk = c0 + jj; f32x2 vv;
            if (SAMPLE && jk < PAST) { const int page = F.page_table()[b * NPAGES + (jk >> 7)];
                vv = *(const GAS f32x2*)(F.cache_v() + ((size_t)(page * PAGE + (jk & 127)) * NH + h) * 128 + 2 * F.lane); }
            else { const int kr = SAMPLE ? krow0 + (jk - PAST) : krow0 + jk; const unsigned w = *(const GAS unsigned*)(F.VB() + (size_t)kr * 1024 + h * 128 + 2 * F.lane);
                vv.x = __uint_as_float(w << 16); vv.y = __uint_as_float(w & 0xffff0000u); }
            o1 = o1 + vv * pp1; o2 = o2 + vv * pp2;
        }
        LDS_WAIT(); asm volatile("" ::: "memory");
    }
    const float L1 = 1.f / wave_sum(l1), L2 = 1.f / wave_sum(l2);
    const size_t oo = (size_t)qrow * 1024 + h * 128 + 2 * F.lane;
    *(GAS unsigned*)(F.O1b() + oo) = pk2(o1.x * L1, o1.y * L1); *(GAS unsigned*)(F.O2b() + oo) = pk2(o2.x * L2, o2.y * L2);
}
constexpr int SA_WAVE_BYTES = 16384, SA_ROW = 132, SA_PIMG = 8192, SA_PROW = 136;
__device__ __forceinline__ unsigned sa_offb(unsigned row, unsigned ch) { return 256u * row + 16u * (ch ^ (((row & 3u) << 2) | ((row >> 2) & 3u))); }
typedef short sa_v4i16 __attribute__((ext_vector_type(4)));
__device__ __forceinline__ sa_v4i16 sa_tr(const LAS unsigned char* p) { return __builtin_amdgcn_ds_read_tr16_b64_v4i16((LAS sa_v4i16*)p); }
__device__ __forceinline__ void sattn_unit(Frame& F, int unit) {
    typedef float f32x2 __attribute__((ext_vector_type(2)));
    int lane = F.lane; asm volatile("" : "+v"(lane));
    const int h = F.wave, n = lane & 15, kq = lane >> 4;
    const bool newtok = unit >= NBS * NSPLIT;
    const int b = newtok ? unit - NBS * NSPLIT : unit / NSPLIT, split = newtok ? NSPLIT : unit % NSPLIT;
    LAS unsigned char* WL = F.lds + RING_OFF + h * SA_WAVE_BYTES;
    LAS float* Ssc = (LAS float*)WL; LAS float* ALP = Ssc + 16 * SA_ROW;
    const float sl2 = exp2f(-(float)(h + 1)) * LOG2E;
    const size_t pi = (size_t)(b * NH + h) * NSP + split;
    if (!newtok) {
        bf16x8 aq[4];
#pragma unroll
        for (int ks = 0; ks < 4; ++ks) {
            const bool nz = (n < 8) == (ks < 2);
            const bf16* qp = F.QB() + (size_t)(MP + b * TS + (n & 7)) * 1024 + h * 128 + (n >> 3) * 64 + 32 * (ks & 1) + 8 * kq;
            aq[ks] = nz ? *(const GAS bf16x8*)qp : (bf16x8){0, 0, 0, 0, 0, 0, 0, 0};
        }
        f32x4 acc[8];
#pragma unroll
        for (int c = 0; c < 8; ++c) acc[c] = (f32x4){0.f, 0.f, 0.f, 0.f};
        float m_run[4], l_run[4];
#pragma unroll
        for (int r = 0; r < 4; ++r) { m_run[r] = -1e30f; l_run[r] = 0.f; }
        const int rp2 = lane >> 5, c4 = lane & 31, kr = rp2, ch = c4 >> 1, hf = c4 & 1;
        const unsigned tq_ = (lane & 15) >> 2, tp_ = lane & 3;
#pragma unroll 1
        for (int pgi = 0; pgi < PGU; ++pgi) {
            const int pg = split * PGU + pgi, phys = F.page_table()[b * NPAGES + pg];
            const float* kbase = F.cache_k() + ((size_t)phys * PAGE * NH + h) * 128;
            const float* vbase = F.cache_v() + ((size_t)phys * PAGE * NH + h) * 128;
            f32x4 sc[8];
            const unsigned roff = (unsigned)(rp2 * 1024 + 4 * c4) * 4u;
            {
                f32x4 kv[2][8];
#pragma unroll
                for (int i = 0; i < 8; ++i) kv[0][i] = __builtin_nontemporal_load((const GAS f32x4*)((const GAS char*)(kbase + (size_t)(2 * i) * 1024) + roff));
#pragma unroll
                for (int kt = 0; kt < 8; ++kt) {
                    if (kt + 1 < 8) {
#pragma unroll
                        for (int i = 0; i < 8; ++i) kv[(kt + 1) & 1][i] = __builtin_nontemporal_load((const GAS f32x4*)((const GAS char*)(kbase + (size_t)(16 * (kt + 1) + 2 * i) * 1024) + roff));
                    }
#pragma unroll
                    for (int i = 0; i < 8; ++i) { const f32x4 v = kv[kt & 1][i]; *(LAS unsigned long long*)(WL + (2 * i + rp2) * 272 + c4 * 8) = (unsigned long long)pk2(v.x, v.y) | ((unsigned long long)pk2(v.z, v.w) << 32); }
                    LDS_WAIT(); asm volatile("" ::: "memory");
                    f32x4 a4 = {0.f, 0.f, 0.f, 0.f};
#pragma unroll
                    for (int ks = 0; ks < 4; ++ks) a4 = __builtin_amdgcn_mfma_f32_16x16x32_bf16(aq[ks], *(const LAS bf16x8*)(WL + n * 272 + (32 * ks + 8 * kq) * 2), a4, 0, 0, 0);
                    LDS_WAIT(); asm volatile("" ::: "memory");
                    const int kpos = pg * PAGE + 16 * kt + n;
#pragma unroll
                    for (int r = 0; r < 4; ++r) sc[kt][r] = a4[r] - sl2 * (float)(PAST + ((4 * kq + r) & 7) - kpos);
                }
            }
            f32x4 vl[16];
#pragma unroll
            for (int i = 0; i < 16; ++i) vl[i] = __builtin_nontemporal_load((const GAS f32x4*)((const GAS char*)(vbase + (size_t)(2 * i) * 1024) + roff));
#pragma unroll
            for (int r = 0; r < 4; ++r) {
                float mx = sc[0][r];
#pragma unroll
                for (int kt = 1; kt < 8; ++kt) mx = fmaxf(mx, sc[kt][r]);
                mx = max16(mx);
                const float mn = fmaxf(m_run[r], mx), al = __builtin_amdgcn_exp2f(m_run[r] - mn); float ls = 0.f;
#pragma unroll
                for (int kt = 0; kt < 8; ++kt) { const float p = __builtin_amdgcn_exp2f(sc[kt][r] - mn); sc[kt][r] = p; ls += p; }
                ls = sum16(ls);
                l_run[r] = l_run[r] * al + ls; m_run[r] = mn;
#pragma unroll
                for (int c = 0; c < 8; ++c) acc[c][r] *= al;
            }
#pragma unroll
            for (int kt = 0; kt < 8; ++kt)
#pragma unroll
                for (int r = 0; r < 4; ++r) *(LAS bf16*)(WL + SA_PIMG + ((4 * kq + r) * SA_PROW + 16 * kt + n) * 2) = (bf16)f2bf(sc[kt][r]);
#pragma unroll 1
            for (int t32 = 0; t32 < 4; ++t32) {
                unsigned tq2 = tq_, kr2 = (unsigned)kr; asm volatile("" : "+v"(tq2), "+v"(kr2));
#pragma unroll
                for (int i = 0; i < 16; ++i) { const f32x4 v = vl[i];
                    *(LAS unsigned long long*)(WL + sa_offb(2 * i + kr2, ch) + 8 * hf) = (unsigned long long)pk2(v.x, v.y) | ((unsigned long long)pk2(v.z, v.w) << 32); }
                if (t32 + 1 < 4) {
#pragma unroll
                    for (int i = 0; i < 16; ++i) vl[i] = __builtin_nontemporal_load((const GAS f32x4*)((const GAS char*)(vbase + (size_t)(32 * (t32 + 1) + 2 * i) * 1024) + roff));
                }
                LDS_WAIT(); asm volatile("" ::: "memory");
                const bf16x8 pa = *(const LAS bf16x8*)(WL + SA_PIMG + (n * SA_PROW + 32 * t32 + 8 * kq) * 2);
#pragma unroll
                for (int c = 0; c < 8; ++c) {
                    const sa_v4i16 lo = sa_tr(WL + sa_offb(8 * kq + tq2, 2 * c + (tp_ >> 1)) + 8 * (tp_ & 1));
                    const sa_v4i16 hi = sa_tr(WL + sa_offb(8 * kq + 4 + tq2, 2 * c + (tp_ >> 1)) + 8 * (tp_ & 1));
                    const bf16x8 vb = {lo[0], lo[1], lo[2], lo[3], hi[0], hi[1], hi[2], hi[3]};
                    acc[c] = __builtin_amdgcn_mfma_f32_16x16x32_bf16(pa, vb, acc[c], 0, 0, 0);
                }
                LDS_WAIT(); asm volatile("" ::: "memory");
            }
        }
        if (n == 0) {
#pragma unroll
            for (int r = 0; r < 4; ++r) { F.PM()[pi * 16 + 4 * kq + r] = m_run[r]; F.PL()[pi * 16 + 4 * kq + r] = l_run[r]; }
        }
#pragma unroll
        for (int c = 0; c < 8; ++c)
#pragma unroll
            for (int r = 0; r < 4; ++r) F.PO()[(pi * 16 + 4 * kq + r) * 128 + 16 * c + n] = acc[c][r];
    } else {
        f32x2 o[16];
#pragma unroll
        for (int m = 0; m < 16; ++m) o[m] = (f32x2){0.f, 0.f};
        float m_run = -1e30f, l_run = 0.f;
        const size_t krow0 = (size_t)(MP + b * TS);
        const bf16* qp = F.QB() + (krow0 + (n & 7)) * 1024 + h * 128 + (n >> 3) * 64;
#pragma unroll
        for (int kk = 0; kk < 2; ++kk) {
            const int t = kq + 4 * kk; const bf16* kp = F.KB() + (krow0 + t) * 1024 + h * 128 + (n >> 3) * 64; float acc = 0.f;
            for (int d = 0; d < 64; d += 2) { const unsigned qw = *(const GAS unsigned*)(qp + d), kw = *(const GAS unsigned*)(kp + d);
                acc += __uint_as_float(qw << 16) * __uint_as_float(kw << 16) + __uint_as_float(qw & 0xffff0000u) * __uint_as_float(kw & 0xffff0000u); }
            const int tq = n & 7;
            Ssc[n * SA_ROW + t] = (t <= tq) ? acc - sl2 * (float)(tq - t) : -1e30f;
        }
        LDS_WAIT(); asm volatile("" ::: "memory");
        {
            const f32x4 s0 = *(const LAS f32x4*)(Ssc + n * SA_ROW), s1 = *(const LAS f32x4*)(Ssc + n * SA_ROW + 4);
            const float mx = fmaxf(fmaxf(fmaxf(s0.x, s0.y), fmaxf(s0.z, s0.w)), fmaxf(fmaxf(s1.x, s1.y), fmaxf(s1.z, s1.w)));
            f32x4 p0, p1; p0.x = __builtin_amdgcn_exp2f(s0.x - mx); p0.y = __builtin_amdgcn_exp2f(s0.y - mx); p0.z = __builtin_amdgcn_exp2f(s0.z - mx); p0.w = __builtin_amdgcn_exp2f(s0.w - mx); p1.x = __builtin_amdgcn_exp2f(s1.x - mx); p1.y = __builtin_amdgcn_exp2f(s1.y - mx); p1.z = __builtin_amdgcn_exp2f(s1.z - mx); p1.w = __builtin_amdgcn_exp2f(s1.w - mx);
            m_run = mx; l_run = (p0.x + p0.y) + (p0.z + p0.w) + (p1.x + p1.y) + (p1.z + p1.w);
            LDS_WAIT(); asm volatile("" ::: "memory");
            if (kq == 0) { *(LAS f32x4*)(Ssc + n * SA_ROW) = p0; *(LAS f32x4*)(Ssc + n * SA_ROW + 4) = p1; }
        }
        LDS_WAIT(); asm volatile("" ::: "memory");
#pragma unroll
        for (int t = 0; t < TS; ++t) {
            const unsigned w = *(const GAS unsigned*)(F.VB() + (krow0 + t) * 1024 + h * 128 + 2 * lane); const f32x2 v2 = {__uint_as_float(w << 16), __uint_as_float(w & 0xffff0000u)};
#pragma unroll
            for (int m = 0; m < 16; ++m) o[m] = o[m] + v2 * Ssc[m * SA_ROW + t];
        }
        LDS_WAIT(); asm volatile("" ::: "memory");
        if (kq == 0) { F.PM()[pi * 16 + n] = m_run; F.PL()[pi * 16 + n] = l_run; }
#pragma unroll
        for (int m = 0; m < 16; ++m) *(GAS f32x2*)(F.PO() + (pi * 16 + m) * 128 + 2 * lane) = o[m];
    }
}
constexpr int N_SATT_UNITS = NBS * NSPLIT + NBS;
constexpr int N_ATT_S = MS * NH, N_ATT_UNITS = NBP * NH * 2 * 2 * (SEQ / 256);
constexpr int CW_QCTR2 = 128;
__device__ __forceinline__ void flash_loop(Frame& F, int ctr) {
    for (;;) {
        __syncthreads();
        if (F.wave == 0 && lane_id() == 0) F.MISC[16] = __hip_atomic_fetch_add(F.ctl + ctr, 1u, RLX_AGENT);
        __syncthreads();
        const int uu = (int)F.MISC[16];
        if (uu >= N_ATT_UNITS * REP_FLASH) break;
        const int u = uu & (N_ATT_UNITS - 1);
        const int qb = 7 - (u >> 7), vh = u & 127, b = vh >> 5, h = (vh >> 2) & 7, map = (vh >> 1) & 1, vhalf = vh & 1;
        const attn_body::bf16* Qp = (const attn_body::bf16*)(F.QB() + h * 128 + map * 64);
        const attn_body::bf16* Kp = (const attn_body::bf16*)(F.KB() + h * 128 + map * 64);
        const attn_body::bf16* Vp = (const attn_body::bf16*)(F.VB() + h * 128 + vhalf * 64);
        attn_body::bf16* Op = (attn_body::bf16*)((map ? F.O2b() : F.O1b()) + h * 128 + vhalf * 64);
        attn_body::attn_unit<8>(b, 0, qb, Qp, Kp, Vp, Op, exp2f(-(float)(h + 1)) * LOG2E, F.lds_g + RING_OFF, F.tid);
    }
}
__device__ __forceinline__ void sattn_loop(Frame& F) {
    for (;;) {
        __syncthreads();
        if (F.wave == 0 && lane_id() == 0) F.MISC[16] = __hip_atomic_fetch_add(F.ctl + CW_QCTR, 1u, RLX_AGENT);
        __syncthreads();
        const int uq = (int)F.MISC[16];
        if (uq >= N_SATT_UNITS * REP_SATT) break;
        sattn_unit(F, REP_SATT > 1 ? uq % N_SATT_UNITS : uq);
    }
}
constexpr int N_MEM_WG = 56;
__device__ __forceinline__ void mixer_phase(Frame& F) {
#define MIX_TID() do { int t_ = F.wave * 64 + lane_id(); asm volatile("" : "+v"(t_)); F.tid = t_; F.lane = t_ & 63; } while (0)
    if ((int)blockIdx.x >= F.G - N_MEM_WG) { MIX_TID(); sattn_loop(F); }
    MIX_TID();
    for (int rp = 0; rp < REP_SCAN; ++rp) {
        const int it = (int)blockIdx.x + (F.G < N_SCAN_ITEMS ? 1 << 20 : 0);
        if (it < N_SCAN_ITEMS) {
            if (it >= NBP * NH) { gdn_chunk_prep(F, NCHUNK_P + (it - NBP * NH), NCHUNK_P + (it - NBP * NH) + 1, 1); asm volatile("s_waitcnt vmcnt(0)" ::: "memory"); __syncthreads(); }
            gdn_scan_item(F, it);
        }
    }
    MIX_TID();
    flash_loop(F, CW_QCTR2);
    MIX_TID();
    sattn_loop(F);
#undef MIX_TID
}
__device__ __forceinline__ void combine_phase(Frame& F) {
    typedef float f32x2 __attribute__((ext_vector_type(2)));
    static_assert(NSP <= 64, "one partial per lane in the sample rows' merge");
    const int lane = F.lane;
    const float lam = __expf(wave_sum(F.lq1()[lane] * F.lk1()[lane])) - __expf(wave_sum(F.lq2()[lane] * F.lk2()[lane])) + 0.2f;
    {
        const f32x2 sw = *(const GAS f32x2*)(F.subln_w() + 2 * lane), dw = *(const GAS f32x2*)(F.dnorm_w() + 2 * lane);
        for (int item = F.gw; item < MS * NH; item += F.NGW) {
            const int ms = item >> 3, h = item & 7, m = MP + ms, b = ms / TS, tq = ms % TS; const size_t p0 = (size_t)(b * NH + h) * NSP; f32x2 om[2];
#pragma unroll
            for (int mp = 0; mp < 2; ++mp) { const int r = mp * 8 + tq;
                const float pm = lane < NSP ? F.PM()[(p0 + lane) * 16 + r] : -1e30f, pl = lane < NSP ? F.PL()[(p0 + lane) * 16 + r] : 0.f;
                const float M = wave_max(pm), wgt = lane < NSP ? exp2f(pm - M) : 0.f, L = wave_sum(wgt * pl);
                f32x2 acc = {0.f, 0.f};
#pragma unroll
                for (int i = 0; i < NSP; ++i) { const float wi = __builtin_bit_cast(float, __builtin_amdgcn_readlane(__builtin_bit_cast(int, wgt), i)); acc = acc + *(const GAS f32x2*)(F.PO() + ((p0 + i) * 16 + r) * 128 + 2 * lane) * wi; }
                om[mp] = acc * (1.f / L); }
            const f32x2 d = om[0] - om[1] * lam;
            const size_t o = (size_t)m * 1024 + h * 128 + 2 * lane;
            const float rs = rsqrtf(wave_sum(d.x * d.x + d.y * d.y) * (1.f / 128.f) + EPS) * 0.8f;
            *(GAS unsigned*)(F.MIX() + (size_t)m * DM + h * 128 + 2 * lane) = pk2(d.x * rs * sw.x, d.y * rs * sw.y);
            const unsigned gw = *(const GAS unsigned*)(F.OG() + o); const f32x2 g = {__uint_as_float(gw << 16), __uint_as_float(gw & 0xffff0000u)};
            const float rg = rsqrtf(wave_sum(g.x * g.x + g.y * g.y) * (1.f / 128.f) + EPS);
            const unsigned zw = *(const GAS unsigned*)(F.Zb() + o); const f32x2 z = {__uint_as_float(zw << 16), __uint_as_float(zw & 0xffff0000u)};
            *(GAS unsigned*)(F.MIX() + (size_t)m * DM + 1024 + h * 128 + 2 * lane) = pk2(g.x * rg * dw.x * silu_f(z.x), g.y * rg * dw.y * silu_f(z.y));
        }
    }
    {
        const int hq = lane >> 4, c8 = lane & 15;
        float sw[8], dw[8];
#pragma unroll
        for (int e = 0; e < 8; ++e) { sw[e] = F.subln_w()[8 * c8 + e] * 0.8f; dw[e] = F.dnorm_w()[8 * c8 + e]; }
#define CB_LOAD(S, item_) do { const int m_ = (item_) >> 1, col_ = (((item_) & 1) * 4 + hq) * 128 + 8 * c8; \
            S##a = *(const GAS v4u*)(F.O1b() + (size_t)m_ * 1024 + col_); S##b = *(const GAS v4u*)(F.O2b() + (size_t)m_ * 1024 + col_); \
            S##z = *(const GAS v4u*)(F.Zb() + (size_t)m_ * 1024 + col_); S##g = *(const GAS v4u*)(F.OG() + (size_t)m_ * 1024 + col_); } while (0)
#define CB_PROC(S, item_) do { const int m = (item_) >> 1, col = (((item_) & 1) * 4 + hq) * 128 + 8 * c8; \
            float d[8], g[8], z[8]; \
            const unsigned w1[4] = {S##a.x, S##a.y, S##a.z, S##a.w}, w2[4] = {S##b.x, S##b.y, S##b.z, S##b.w}, wz[4] = {S##z.x, S##z.y, S##z.z, S##z.w}, wg[4] = {S##g.x, S##g.y, S##g.z, S##g.w}; \
            _Pragma("unroll") for (int e = 0; e < 4; ++e) { d[2 * e] = __uint_as_float(w1[e] << 16) - lam * __uint_as_float(w2[e] << 16); d[2 * e + 1] = __uint_as_float(w1[e] & 0xffff0000u) - lam * __uint_as_float(w2[e] & 0xffff0000u); \
                z[2 * e] = __uint_as_float(wz[e] << 16); z[2 * e + 1] = __uint_as_float(wz[e] & 0xffff0000u); g[2 * e] = __uint_as_float(wg[e] << 16); g[2 * e + 1] = __uint_as_float(wg[e] & 0xffff0000u); } \
            float sd = 0.f, sg = 0.f; \
            _Pragma("unroll") for (int e = 0; e < 8; ++e) { sd += d[e] * d[e]; sg += g[e] * g[e]; } \
            const float rs = rsqrtf(sum16(sd) * (1.f / 128.f) + EPS), rg = rsqrtf(sum16(sg) * (1.f / 128.f) + EPS); \
            *(GAS v4u*)(F.MIX() + (size_t)m * DM + col) = (v4u){pk2(d[0] * rs * sw[0], d[1] * rs * sw[1]), pk2(d[2] * rs * sw[2], d[3] * rs * sw[3]), pk2(d[4] * rs * sw[4], d[5] * rs * sw[5]), pk2(d[6] * rs * sw[6], d[7] * rs * sw[7])}; \
            _Pragma("unroll") for (int e = 0; e < 8; ++e) g[e] = g[e] * rg * dw[e] * silu_f(z[e]); \
            *(GAS v4u*)(F.MIX() + (size_t)m * DM + 1024 + col) = (v4u){pk2(g[0], g[1]), pk2(g[2], g[3]), pk2(g[4], g[5]), pk2(g[6], g[7])}; } while (0)
        {
            constexpr int TOT = 2 * MP; const int st = F.NGW;
            v4u Aa, Ab, Az, Ag, Ba, Bb, Bz, Bg, Ca, Cb, Cz, Cg;
            if (F.gw < TOT) CB_LOAD(A, F.gw);
            if (F.gw + st < TOT) CB_LOAD(B, F.gw + st);
            for (int item = F.gw; item < TOT; item += 3 * st) {
                if (item + 2 * st < TOT) CB_LOAD(C, item + 2 * st);
                CB_PROC(A, item);
                if (item + 3 * st < TOT) CB_LOAD(A, item + 3 * st);
                if (item + st < TOT) CB_PROC(B, item + st);
                if (item + 4 * st < TOT) CB_LOAD(B, item + 4 * st);
                if (item + 2 * st < TOT) CB_PROC(C, item + 2 * st);
            }
        }
#undef CB_LOAD
#undef CB_PROC
    }
}
__global__ void __launch_bounds__(NTHREADS, 2) fwd_kernel(Args args) {
    extern __shared__ __attribute__((aligned(16))) unsigned char lds[];
    Frame F(args);
    F.lds = (LAS unsigned char*)lds; F.MISC = (volatile LAS unsigned*)(F.lds + MISC_OFF); F.lds_g = (char*)lds;
    F.tid = threadIdx.x; F.lane = F.tid & 63; F.wave = __builtin_amdgcn_readfirstlane(F.tid >> 6);
    F.G = gridDim.x; F.gw = (int)blockIdx.x * NWAVES + F.wave; F.NGW = F.G * NWAVES;
    F.ctl = (gu32*)(args.ws + WS_CTL); F.z = 0; F.ws = args.ws;
    for (int u = F.tid; u < (LDS_BYTES - LDSCTL_OFF) / 4; u += NTHREADS) ((LAS unsigned*)(F.lds + LDSCTL_OFF))[u] = 0u;
    __syncthreads();
    XcdBarrier bar; bar.bar = (unsigned*)(F.ctl + CW_BAR); bar.x = 0; bar.st = nullptr;
    if (MK_N_LAUNCHES == 1) bar = xcd_barrier_post((unsigned*)(F.ctl + CW_BAR), F.MISC + 8, F.tid == 0);
    const int lo = args.ph_lo, hi = args.ph_hi;
#define IN(k) (lo <= (k) && (k) < hi)
#define PB() do { int t_ = F.wave * 64 + lane_id(); asm volatile("" : "+v"(t_)); F.tid = t_; F.lane = t_ & 63; int z_ = 0; asm volatile("" : "+s"(z_)); F.z = z_; F.ws = args.ws + z_; } while (0)
#define SEAM(k) do { if (IN(k) && IN((k) + 1)) { if (MK_N_LAUNCHES == 1) xcd_barrier(bar, F.wave == 0 && lane_id() == 0); } } while (0)
#ifndef ROT_ALL
#define ROT_ALL 0
#endif
#define GEMM_PH(EpiT, Eobj, Aptr, Bptr, N_, K_) GEMM_PHX(EpiT, Eobj, Aptr, Bptr, N_, K_, ROT_ALL)
#define GEMM_PHR(EpiT, Eobj, Aptr, Bptr, N_, K_) GEMM_PHX(EpiT, Eobj, Aptr, Bptr, N_, K_, 1)
#define GEMM_PHX(EpiT, Eobj, Aptr, Bptr, N_, K_, ROT_) do { pg8::Gemm g{Aptr, Bptr, MP, N_, K_, (ROT_) ? (((int)blockIdx.x & 7) * ((K_) / 64) / 8) & ~1 : 0}; pg8::StaticOrder S; S.init(MP, N_, F.G, (int)blockIdx.x); \
        pg8::gemm_phase<EpiT, pg8::StaticOrder, PG8_ALIGN, PG8_SP2>(F.lds + RING_OFF, g, S, Eobj, F.tid); } while (0)
    if (IN(0)) { PB(); for (int rp = 0; rp < REP_PRO; ++rp) p0_prologue(F); } SEAM(0);
#ifdef REP_BAR
    for (int rp = 0; rp < REP_BAR; ++rp) xcd_barrier(bar, F.wave == 0 && lane_id() == 0);
#endif
    if (IN(1)) { PB(); EpiAct E{F.ACT(), F.RS()}; for (int rp = 0; rp < REP_G1; ++rp) GEMM_PH(EpiAct, E, F.X0h(), F.W1GU(), GU, DM);
                 SkEpiAct SE{F.ACT() + (size_t)MP * FF, F.RS() + MP}; skinny_phase<2, 1, DM>(F, F.X0h() + (size_t)MP * DM, F.W1GU(), DM, FF / 16, SE, 128);
#if CONV_TAILS
                 convert_matrix(F, F.down1(), FF, DM, DM, F.W1D(), 0, 128);
#endif
    } SEAM(1);
    if (IN(2)) { PB(); EpiBf E{F.F16()}; GEMM_PHR(EpiBf, E, F.ACT(), F.W1D(), DM, FF);
#ifdef REP_G2
        GEMM_PHR(EpiBf, E, F.ACT(), F.W1D(), DM, FF);
#endif
 SkEpiAddF32 SE{F.Fb() + (size_t)MP * DM}; skinny_phase<1, 2, FF>(F, F.ACT() + (size_t)MP * FF, F.W1D(), FF, DM / 16, SE, 0); } SEAM(2);
    if (IN(3)) { PB(); for (int rp = 0; rp < REP_THIN; ++rp) thin_rows(F, F.X0h(), F.F16(), F.Fb(), 0.5f, F.ffn1_post(), F.X1h(), nullptr, F.RS()); } SEAM(3);
    if (IN(4)) { PB(); EpiIn E{F.QB(), F.KB(), F.VB(), F.QKVB(), F.Zb(), F.BA(), F.out(), F.RS()}; GEMM_PH(EpiIn, E, F.X1h(), F.WIN(), INW_PAD, DM);
#ifdef REP_WIN
        GEMM_PH(EpiIn, E, F.X1h(), F.WIN(), INW_PAD, DM);
#endif

                 SkEpiIn SE{F.QB() + (size_t)MP * 1024, F.KB() + (size_t)MP * 1024, F.VB() + (size_t)MP * 1024, F.QKVB() + (size_t)MP * CONVD, F.Zb() + (size_t)MP * 1024, F.BA() + (size_t)MP * 16, F.out(), F.RS() + MP};
                 skinny_phase<2, 1, DM, SkEpiIn, 16, false>(F, F.X1h() + (size_t)MP * DM, F.WIN(), DM, (INW + 31) / 32, SE, 160); } SEAM(4);
    if (IN(5)) { PB(); for (int rp = 0; rp < REP_PREP; ++rp) { const int per = 2 * ((NCHUNK_P / 2 + F.G - 1) / F.G), c0 = per * (int)blockIdx.x; gdn_chunk_prep2(F, c0 < NCHUNK_P ? c0 : NCHUNK_P, c0 + per < NCHUNK_P ? c0 + per : NCHUNK_P); } } SEAM(5);
    if (IN(6)) { PB(); mixer_phase(F); } SEAM(6);
    if (IN(7)) { PB(); combine_phase(F);
#ifdef REP_COMB
        combine_phase(F); combine_phase(F);
#endif
    } SEAM(7);
    if (IN(8)) { PB(); EpiBf E{F.F16()}; GEMM_PH(EpiBf, E, F.MIX(), F.WOUT(), DM, DM); SkEpiAddF32 SE{F.Fb() + (size_t)MP * DM}; skinny_phase<1, 2, DM>(F, F.MIX() + (size_t)MP * DM, F.WOUT(), DM, DM / 16, SE, 0); } SEAM(8);
    if (IN(9)) { PB(); thin_rows(F, F.X1h(), F.F16(), F.Fb(), 1.0f, F.mix_post(), F.X2h(), nullptr, F.RS()); } SEAM(9);
    if (IN(10)) { PB(); EpiAct E{F.ACT(), F.RS()}; GEMM_PH(EpiAct, E, F.X2h(), F.W2GU(), GU, DM);
                  SkEpiAct SE{F.ACT() + (size_t)MP * FF, F.RS() + MP}; skinny_phase<2, 1, DM>(F, F.X2h() + (size_t)MP * DM, F.W2GU(), DM, FF / 16, SE, 128);
#if CONV_TAILS
                  convert_matrix(F, F.down2(), FF, DM, DM, F.W2D(), 0, 128);
#endif
    } SEAM(10);
    if (IN(11)) { PB(); EpiBf E{F.F16()}; GEMM_PHR(EpiBf, E, F.ACT(), F.W2D(), DM, FF); SkEpiAddF32 SE{F.Fb() + (size_t)MP * DM}; skinny_phase<1, 2, FF>(F, F.ACT() + (size_t)MP * FF, F.W2D(), FF, DM / 16, SE, 0); } SEAM(11);
    if (IN(12)) { PB(); thin_rows(F, F.X2h(), F.F16(), F.Fb(), 0.5f, F.ffn2_post(), nullptr, F.out() + OUT_Y, nullptr); }
#undef IN
#undef SEAM
#undef GEMM_PH
#undef GEMM_PHR
#undef GEMM_PHX
}

extern "C" void kernel_launch(void* const* d_in, const int* in_sizes, int n_in, void* d_out, int out_size, void* d_ws, size_t ws_size, hipStream_t stream) {
    static int grid = 0;
    if (grid == 0) {
        if (n_in != 30 || ws_size < WS_END) { fprintf(stderr, "kernel_launch: unexpected shapes (n_in %d, out %d, ws %zu)\n", n_in, out_size, ws_size); grid = -1; return; }
        int dev = 0, cus = 0, per_cu = 0;
        if (hipGetDevice(&dev) != hipSuccess || hipDeviceGetAttribute(&cus, hipDeviceAttributeMultiprocessorCount, dev) != hipSuccess) { grid = -1; return; }
        if (hipFuncSetAttribute((const void*)fwd_kernel, hipFuncAttributeMaxDynamicSharedMemorySize, LDS_BYTES) != hipSuccess) { fprintf(stderr, "kernel_launch: hipFuncSetAttribute failed\n"); grid = -1; return; }
        if (hipOccupancyMaxActiveBlocksPerMultiprocessor(&per_cu, (const void*)fwd_kernel, NTHREADS, LDS_BYTES) != hipSuccess || per_cu < 1) { fprintf(stderr, "kernel_launch: occupancy query says %d\n", per_cu); }
        (void)hipGetLastError();
        grid = cus;
    }
    if (grid < 0) return;
    (void)hipMemsetAsync((char*)d_ws + WS_CTL, 0, CTL_ZERO_BYTES, stream);
    Args a{};
    for (int i = 0; i < 30; ++i) a.in[i] = d_in[i];
    a.out = (float*)d_out; a.ws = (unsigned char*)d_ws;
    if (MK_N_LAUNCHES == 1) { a.ph_lo = 0; a.ph_hi = NPHASE; hipLaunchKernelGGL(fwd_kernel, dim3(grid), dim3(NTHREADS), LDS_BYTES, stream, a); }
    else for (int p = 0; p < NPHASE; ++p) { a.ph_lo = p; a.ph_hi = p + 1; hipLaunchKernelGGL(fwd_kernel, dim3(grid), dim3(NTHREADS), LDS_BYTES, stream, a); }
}
```
